# Optimizing an MI355X kernel written in HIP

```python
import math
import jax
import jax.numpy as jnp
from jax import lax
import numpy as np

D_MODEL = 1024
BATCH = 32
SEQ = 256
DEPTH = 4
DEC_BATCH = 2
DEC_SEQ = 2048
PAST_LEN = 512

GRID_W = 64
N_MIXERS = 3
D_INNER = 2 * D_MODEL
N_S5_LAYERS = (DEPTH + 2) // 3
N_POOL_LAYERS = (DEPTH + 1) // 3
N_MLA_LAYERS = DEPTH // 3
S5_GROUP = 16
S5_GROUPS = D_INNER // S5_GROUP
S5_STATE = 64
POOL_WINDOWS = (2, 4, 8, 16)
POOL_GROUPS = len(POOL_WINDOWS)
POOL_GROUP_W = D_INNER // POOL_GROUPS
MLA_HEADS = 16
MLA_NOPE = 128
MLA_ROPE = 64
MLA_V = 128
MLA_Q_RANK = 256
MLA_KV_RANK = 128
ROPE_THETA = 10000.0
ATTN_BLOCK = 128
NORM_EPS = 1e-6

kernel_name = 'hybrid_s5_pool_mla_diffusion_step'


def _f32(t):
    return t.astype(jnp.float32)


def _rmsnorm(x, g):
    xf = _f32(x)
    y = xf * lax.rsqrt(jnp.mean(xf * xf, axis=-1, keepdims=True) + NORM_EPS)
    return (y * _f32(g)).astype(x.dtype)


def _ada(cond, w, b):
    m = jax.nn.silu(cond) @ w + b
    return jnp.split(m, 3, axis=-1)


def _lin_rec(left, right):
    a_l, b_l = left
    a_r, b_r = right
    return a_r * a_l, a_r * b_l + b_r


def _s5_mixer(h, h0_re, h0_im, w_in, lam_re, lam_im, log_step, b_re, b_im, c_re, c_im,
              d_skip, glu_w, glu_b, w_out):
    bsz, n_tok, _ = h.shape
    u, z = jnp.split(h @ w_in, 2, axis=-1)
    uf = _f32(u)
    ug = uf.reshape(bsz, n_tok, S5_GROUPS, S5_GROUP).astype(jnp.complex64)
    y = _f32(d_skip) * uf
    fin_re, fin_im = [], []
    for dirn in range(2):
        lam = lax.complex(_f32(lam_re[dirn]), _f32(lam_im[dirn]))
        step = jnp.exp(_f32(log_step[dirn]))[:, None]
        lam_bar = jnp.exp(lam * step)
        b_bar = ((lam_bar - 1.0) / lam)[..., None] * lax.complex(_f32(b_re[dirn]), _f32(b_im[dirn]))
        c_mat = lax.complex(_f32(c_re[dirn]), _f32(c_im[dirn]))
        bu = jnp.einsum('blgc,gpc->blgp', ug, b_bar)
        h0 = lax.complex(_f32(h0_re[:, dirn]), _f32(h0_im[:, dirn]))
        edge = 0 if dirn == 0 else n_tok - 1
        bu = bu.at[:, edge].add(lam_bar * h0)
        a = jnp.broadcast_to(lam_bar, (1, n_tok) + lam_bar.shape)
        _, states = lax.associative_scan(_lin_rec, (a, bu), axis=1, reverse=(dirn == 1))
        y = y + jnp.einsum('blgp,gcp->blgc', states, c_mat).real.reshape(bsz, n_tok, D_INNER)
        final = states[:, n_tok - 1 - edge]
        fin_re.append(final.real)
        fin_im.append(final.imag)
    y = jax.nn.gelu(y)
    y = y * jax.nn.sigmoid(y @ _f32(glu_w) + _f32(glu_b))
    out = (y.astype(h.dtype) * jax.nn.silu(z)) @ w_out
    return out, jnp.stack(fin_re, axis=1), jnp.stack(fin_im, axis=1)


def _pool_mixer(h, w_in, pool_w, pool_scale, w_out):
    bsz, n_tok, _ = h.shape
    u, z = jnp.split(h @ w_in, 2, axis=-1)
    ug = _f32(u).reshape(bsz, n_tok, POOL_GROUPS, POOL_GROUP_W)
    cs = jnp.concatenate([jnp.zeros_like(ug[:, :1]), jnp.cumsum(ug, axis=1)], axis=1)
    t = np.arange(n_tok)
    pooled = []
    for g, win in enumerate(POOL_WINDOWS):
        lo = win // 2
        start = np.clip(t - lo, 0, n_tok)
        end = np.clip(t - lo + win, 0, n_tok)
        cnt = (end - start).astype(np.float32)[:, None]
        csg = cs[:, :, g]
        pooled.append((csg[:, end] - csg[:, start]) / cnt - ug[:, :, g])
    p = jnp.stack(pooled, axis=2)
    m = jnp.einsum('blgc,gcd->blgd', p, _f32(pool_w)).reshape(bsz, n_tok, D_INNER)
    m = m * _f32(pool_scale)
    return (m.astype(h.dtype) * jax.nn.silu(z)) @ w_out


def _rope_2d(x, n_tok):
    rows = n_tok // GRID_W
    tok = jnp.arange(rows * GRID_W)
    row = (tok // GRID_W).astype(jnp.float32)
    col = (tok % GRID_W).astype(jnp.float32)
    axis_dim = MLA_ROPE // 2
    half = axis_dim // 2
    inv = ROPE_THETA ** (-jnp.arange(half, dtype=jnp.float32) / half)
    bshape = (n_tok,) + (1,) * (x.ndim - 3) + (half,)
    xf = _f32(x)
    out = []
    for i, pos in enumerate((row, col)):
        ang = (pos[:, None] * inv).reshape(bshape)
        cos, sin = jnp.cos(ang), jnp.sin(ang)
        seg = xf[..., i * axis_dim:(i + 1) * axis_dim]
        x1, x2 = seg[..., :half], seg[..., half:]
        out += [x1 * cos - x2 * sin, x1 * sin + x2 * cos]
    return jnp.concatenate(out, axis=-1).astype(x.dtype)


def _mla_project(h, w_in, q_norm, wq_b, kv_norm):
    bsz, n_tok, _ = h.shape
    splits = [MLA_Q_RANK, MLA_Q_RANK + MLA_KV_RANK, MLA_Q_RANK + MLA_KV_RANK + MLA_ROPE]
    q_a, ckv, kpe, z = jnp.split(h @ w_in, splits, axis=-1)
    q = (_rmsnorm(q_a, q_norm) @ wq_b).reshape(bsz, n_tok, MLA_HEADS, MLA_NOPE + MLA_ROPE)
    return q[..., :MLA_NOPE], q[..., MLA_NOPE:], _rmsnorm(ckv, kv_norm), kpe, z


def _mla_expand(ckv_n, wkv_b):
    bsz, n_tok, _ = ckv_n.shape
    kv = (ckv_n @ wkv_b).reshape(bsz, n_tok, MLA_HEADS, MLA_NOPE + MLA_V)
    return kv[..., :MLA_NOPE], kv[..., MLA_NOPE:]


def _mla_attend(q_nope, q_pe, k_nope, k_pe, v):
    bsz, n_q, n_h, _ = q_nope.shape
    qb = math.gcd(n_q, ATTN_BLOCK)
    nb = n_q // qb
    scale = (MLA_NOPE + MLA_ROPE) ** -0.5

    def to_blocks(t):
        return t.reshape((bsz, nb, qb) + t.shape[2:]).swapaxes(0, 1)

    def block(qs):
        qn, qp = qs
        s = jnp.einsum('bqhd,bkhd->bhqk', qn, k_nope) + jnp.einsum('bqhr,bkr->bhqk', qp, k_pe)
        p = jax.nn.softmax(_f32(s) * scale, axis=-1)
        return jnp.einsum('bhqk,bkhd->bqhd', p.astype(v.dtype), v)

    o = lax.map(block, (to_blocks(q_nope), to_blocks(q_pe)))
    return o.swapaxes(0, 1).reshape(bsz, n_q, n_h * MLA_V)


def _mla_context(h, w_in, q_norm, wq_b, kv_norm, wkv_b, w_out):
    q_nope, q_pe, ckv_n, kpe, z = _mla_project(h, w_in, q_norm, wq_b, kv_norm)
    k_nope, v = _mla_expand(ckv_n, wkv_b)
    o = _mla_attend(q_nope, q_pe, k_nope, kpe, v)
    return (o * jax.nn.silu(z)) @ w_out, ckv_n, kpe


def _mla_latent(h, ctx_ckv, ctx_kpe, w_in, q_norm, wq_b, kv_norm, wkv_b, w_out):
    n_tok = h.shape[1]
    q_nope, q_pe, ckv_n, kpe, z = _mla_project(h, w_in, q_norm, wq_b, kv_norm)
    q_pe = _rope_2d(q_pe, n_tok)
    kpe = _rope_2d(kpe, n_tok)
    k_nope, v = _mla_expand(jnp.concatenate([ctx_ckv.astype(ckv_n.dtype), ckv_n], axis=1), wkv_b)
    k_pe = jnp.concatenate([ctx_kpe.astype(kpe.dtype), kpe], axis=1)
    o = _mla_attend(q_nope, q_pe, k_nope, k_pe, v)
    return (o * jax.nn.silu(z)) @ w_out


def setup_inputs(seed: int = 0) -> dict:
    key = jax.random.key(seed)
    ks = iter(jax.random.split(key, 48))

    def nrm(shape, scale=1.0):
        return scale * jax.random.normal(next(ks), shape, jnp.float32)

    def gain(shape):
        return 1.0 + nrm(shape, 0.02)

    G, P, W, D = S5_GROUPS, S5_STATE, D_INNER, D_MODEL
    s5_lam_im = jnp.pi * jnp.arange(P, dtype=jnp.float32) + nrm((N_S5_LAYERS, 2, G, P), 0.01)
    s5_log_step = jax.random.uniform(next(ks), (N_S5_LAYERS, 2, G), jnp.float32,
                                     math.log(1e-3), math.log(1e-1))
    mla_in = MLA_Q_RANK + MLA_KV_RANK + MLA_ROPE + W
    return {
        'x_prompt': nrm((BATCH, SEQ, D)),
        'x_sample': nrm((DEC_BATCH, DEC_SEQ, D)),
        'state_s5_re': nrm((DEC_BATCH, N_S5_LAYERS, 2, G, P), 0.1),
        'state_s5_im': nrm((DEC_BATCH, N_S5_LAYERS, 2, G, P), 0.1),
        'cache_ckv': nrm((DEC_BATCH, N_MLA_LAYERS, PAST_LEN, MLA_KV_RANK)),
        'cache_kpe': nrm((DEC_BATCH, N_MLA_LAYERS, PAST_LEN, MLA_ROPE)),
        'c': nrm((DEC_BATCH, D)),
        'c_ctx': nrm((D,)),
        'norm_g': gain((DEPTH, D)),
        'ada_w': nrm((DEPTH, D, 3 * D), 0.5 * D ** -0.5),
        'ada_b': nrm((DEPTH, 3 * D), 0.02),
        'final_norm_g': gain((D,)),
        's5_w_in': nrm((N_S5_LAYERS, D, 2 * W), D ** -0.5),
        's5_lam_re': -0.5 + nrm((N_S5_LAYERS, 2, G, P), 0.01),
        's5_lam_im': s5_lam_im,
        's5_log_step': s5_log_step,
        's5_b_re': nrm((N_S5_LAYERS, 2, G, P, S5_GROUP), (2 * S5_GROUP) ** -0.5),
        's5_b_im': nrm((N_S5_LAYERS, 2, G, P, S5_GROUP), (2 * S5_GROUP) ** -0.5),
        's5_c_re': nrm((N_S5_LAYERS, 2, G, S5_GROUP, P), (2 * P) ** -0.5),
        's5_c_im': nrm((N_S5_LAYERS, 2, G, S5_GROUP, P), (2 * P) ** -0.5),
        's5_d': nrm((N_S5_LAYERS, W)),
        's5_glu_w': nrm((N_S5_LAYERS, W, W), W ** -0.5),
        's5_glu_b': nrm((N_S5_LAYERS, W), 0.02),
        's5_w_out': nrm((N_S5_LAYERS, W, D), W ** -0.5),
        'pool_w_in': nrm((N_POOL_LAYERS, D, 2 * W), D ** -0.5),
        'pool_w': nrm((N_POOL_LAYERS, POOL_GROUPS, POOL_GROUP_W, POOL_GROUP_W), POOL_GROUP_W ** -0.5),
        'pool_scale': 1.0 + nrm((N_POOL_LAYERS, W), 0.1),
        'pool_w_out': nrm((N_POOL_LAYERS, W, D), W ** -0.5),
        'mla_w_in': nrm((N_MLA_LAYERS, D, mla_in), D ** -0.5),
        'mla_q_norm': gain((N_MLA_LAYERS, MLA_Q_RANK)),
        'mla_wq_b': nrm((N_MLA_LAYERS, MLA_Q_RANK, MLA_HEADS * (MLA_NOPE + MLA_ROPE)), MLA_Q_RANK ** -0.5),
        'mla_kv_norm': gain((N_MLA_LAYERS, MLA_KV_RANK)),
        'mla_wkv_b': nrm((N_MLA_LAYERS, MLA_KV_RANK, MLA_HEADS * (MLA_NOPE + MLA_V)), MLA_KV_RANK ** -0.5),
        'mla_w_out': nrm((N_MLA_LAYERS, MLA_HEADS * MLA_V, D), (MLA_HEADS * MLA_V) ** -0.5),
    }


def reference(x_prompt, x_sample, state_s5_re, state_s5_im, cache_ckv, cache_kpe, c, c_ctx,
              norm_g, ada_w, ada_b, final_norm_g,
              s5_w_in, s5_lam_re, s5_lam_im, s5_log_step, s5_b_re, s5_b_im, s5_c_re, s5_c_im,
              s5_d, s5_glu_w, s5_glu_b, s5_w_out,
              pool_w_in, pool_w, pool_scale, pool_w_out,
              mla_w_in, mla_q_norm, mla_wq_b, mla_kv_norm, mla_wkv_b, mla_w_out):
    xp, xs = x_prompt, x_sample
    zero_state = jnp.zeros((xp.shape[0], 2, S5_GROUPS, S5_STATE), jnp.float32)
    new_re, new_im, new_ckv, new_kpe = [], [], [], []
    for layer in range(DEPTH):
        kind = layer % N_MIXERS
        j = layer // N_MIXERS
        sh_p, sc_p, g_p = _ada(c_ctx, ada_w[layer], ada_b[layer])
        sh_s, sc_s, g_s = [t[:, None] for t in _ada(c, ada_w[layer], ada_b[layer])]
        hp = _rmsnorm(xp, norm_g[layer]) * (1 + sc_p) + sh_p
        hs = _rmsnorm(xs, norm_g[layer]) * (1 + sc_s) + sh_s
        if kind == 0:
            prm = (s5_w_in[j], s5_lam_re[j], s5_lam_im[j], s5_log_step[j], s5_b_re[j], s5_b_im[j],
                   s5_c_re[j], s5_c_im[j], s5_d[j], s5_glu_w[j], s5_glu_b[j], s5_w_out[j])
            yp, fin_re, fin_im = _s5_mixer(hp, zero_state, zero_state, *prm)
            ys, _, _ = _s5_mixer(hs, state_s5_re[:, j], state_s5_im[:, j], *prm)
            new_re.append(fin_re)
            new_im.append(fin_im)
        elif kind == 1:
            prm = (pool_w_in[j], pool_w[j], pool_scale[j], pool_w_out[j])
            yp = _pool_mixer(hp, *prm)
            ys = _pool_mixer(hs, *prm)
        else:
            prm = (mla_w_in[j], mla_q_norm[j], mla_wq_b[j], mla_kv_norm[j], mla_wkv_b[j], mla_w_out[j])
            yp, ckv_n, kpe = _mla_context(hp, *prm)
            ys = _mla_latent(hs, cache_ckv[:, j], cache_kpe[:, j], *prm)
            new_ckv.append(ckv_n)
            new_kpe.append(kpe)
        xp = xp + g_p * yp
        xs = xs + g_s * ys
    y_prompt = _rmsnorm(xp, final_norm_g)
    y_sample = _rmsnorm(xs, final_norm_g)
    new_s5_re = jnp.stack(new_re, axis=1)
    new_s5_im = jnp.stack(new_im, axis=1)
    new_ckv_s = jnp.stack(new_ckv, axis=1)
    new_kpe_s = jnp.stack(new_kpe, axis=1)
    return (y_prompt, y_sample, new_s5_re, new_s5_im, new_ckv_s, new_kpe_s)
```

```cpp
#include <hip/hip_runtime.h>
#include <hip/hip_cooperative_groups.h>
#include <cstdio>
namespace cg = cooperative_groups;

#ifndef MK_SINGLE
#define MK_SINGLE 1
#endif

typedef unsigned short u16;
using bf16x8 = __attribute__((ext_vector_type(8))) short;
using f32x4  = __attribute__((ext_vector_type(4))) float;
using u16x4  = __attribute__((ext_vector_type(4))) unsigned short;
using u16x8  = __attribute__((ext_vector_type(8))) unsigned short;

struct Params {
  const float *x_prompt, *x_sample, *st_re, *st_im, *cache_ckv, *cache_kpe, *c, *c_ctx;
  const float *norm_g, *ada_w, *ada_b, *final_g;
  const float *s5_w_in, *s5_lam_re, *s5_lam_im, *s5_log_step, *s5_b_re, *s5_b_im, *s5_c_re, *s5_c_im;
  const float *s5_d, *s5_glu_w, *s5_glu_b, *s5_w_out;
  const float *pool_w_in, *pool_w, *pool_scale, *pool_w_out;
  const float *mla_w_in, *mla_q_norm, *mla_wq_b, *mla_kv_norm, *mla_wkv_b, *mla_w_out;
  float* out;
  char* ws;
};

constexpr size_t MiB = 1ull << 20;
constexpr size_t OFF_W = 0, OFF_A = 20 * MiB, OFF_B = 116 * MiB, OFF_C = 164 * MiB, OFF_M = 212 * MiB,
                 OFF_H = 228 * MiB;
constexpr size_t OFF_MOD = OFF_M, OFF_QAN = OFF_M + 1 * MiB, OFF_KB = OFF_M + 7 * MiB, OFF_VT = OFF_M + 12 * MiB;
constexpr size_t W_WIN = OFF_W, W_GLU = OFF_W + 8 * MiB, W_POOLW = OFF_W + 8 * MiB, W_WQ = OFF_W + 6 * MiB,
                 W_WUV = OFF_W + 8 * MiB, W_WOUT = OFF_W + 16 * MiB;
constexpr size_t A_QA = OFF_A + 72 * MiB, A_CKVF = OFF_A + 84 * MiB, A_KPEF = OFF_A + 90 * MiB;
constexpr size_t B_WST = OFF_B, B_WBIG = OFF_B + 16 * MiB;

constexpr int OUT_RE = 12582912, OUT_IM = 13631488, OUT_CKV = 14680064, OUT_KPE = 15728640;

#define NT_TOK 12288
#define LDS_BYTES 98304

__device__ __forceinline__ u16 f2bf(float f) {
  unsigned u = __float_as_uint(f);
  u += 0x7fffu + ((u >> 16) & 1u);
  return (u16)(u >> 16);
}
__device__ __forceinline__ float bf2f(u16 h) { return __uint_as_float(((unsigned)h) << 16); }
__device__ __forceinline__ float fsigmoid(float x) { return 1.f / (1.f + __expf(-x)); }
__device__ __forceinline__ float fsilu(float x) { return x * fsigmoid(x); }
__device__ __forceinline__ float fgelu(float x) {
  float y = 0.7978845608028654f * (x + 0.044715f * x * x * x);
  float t = 1.f - 2.f / (__expf(2.f * y) + 1.f);
  return 0.5f * x * (1.f + t);
}
__device__ __forceinline__ float2 cis_rev(double rev) {
  double f = rev - rint(rev);
  float ff = (float)f;
  return make_float2(__builtin_amdgcn_cosf(ff), __builtin_amdgcn_sinf(ff));
}
__device__ __forceinline__ float wave_sum(float v) {
#pragma unroll
  for (int o = 32; o > 0; o >>= 1) v += __shfl_xor(v, o);
  return v;
}
__device__ __forceinline__ int cond_of_row(int row) { return row < 8192 ? 0 : 1 + ((row - 8192) >> 11); }
__device__ __forceinline__ u16x4 pack4(f32x4 v) {
  u16x4 r;
  r[0] = f2bf(v[0]); r[1] = f2bf(v[1]); r[2] = f2bf(v[2]); r[3] = f2bf(v[3]);
  return r;
}

#define WAIT_VM(n) asm volatile("s_waitcnt vmcnt(" #n ")" ::: "memory")
#define BARRIER()                        \
  do {                                   \
    asm volatile("" ::: "memory");       \
    __builtin_amdgcn_s_barrier();        \
    asm volatile("" ::: "memory");       \
  } while (0)

__device__ __forceinline__ void glds16(const void* g, char* l) {
  __builtin_amdgcn_global_load_lds((const unsigned*)g, (unsigned*)l, 16, 0, 0);
}

template <int WM, int WN, class AF, class BF>
__device__ __forceinline__ void gemm_loop(char* lds, int nk, AF af, BF bf, f32x4 (&acc)[4][4]) {
  constexpr int BM = WM * 64, BN = WN * 64;
  constexpr int STG = (BM + BN) * 128;
  const int tid = threadIdx.x, lane = tid & 63, wid = tid >> 6;
  const int wr = wid / WN, wc = wid % WN, fr = lane & 15, fq = lane >> 4;
  const int srow = tid >> 3;
  const int skc = ((tid & 7) ^ (srow & 7)) * 8;
#pragma unroll
  for (int mi = 0; mi < 4; ++mi)
#pragma unroll
    for (int ni = 0; ni < 4; ++ni) acc[mi][ni] = f32x4{0.f, 0.f, 0.f, 0.f};

  auto stage = [&](int kt, int buf) {
    char* base = lds + buf * STG + tid * 16;
#pragma unroll
    for (int i = 0; i < BM / 64; ++i) glds16(af(srow + i * 64, kt * 64 + skc), base + i * 8192);
#pragma unroll
    for (int i = 0; i < BN / 64; ++i) glds16(bf(srow + i * 64, kt * 64 + skc), base + BM * 128 + i * 8192);
  };
  stage(0, 0);
  for (int kt = 0; kt < nk; ++kt) {
    const int cur = kt & 1;
    if (kt + 1 < nk) {
      stage(kt + 1, cur ^ 1);
      WAIT_VM(6);
    } else {
      WAIT_VM(0);
    }
    BARRIER();
    const char* sa = lds + cur * STG + (wr * 64 + fr) * 128;
    const char* sb = lds + cur * STG + BM * 128 + (wc * 64 + fr) * 128;
#pragma unroll
    for (int ks = 0; ks < 2; ++ks) {
      const int off = ((ks * 4 + fq) ^ (fr & 7)) << 4;
      bf16x8 a[4], b[4];
#pragma unroll
      for (int mi = 0; mi < 4; ++mi) a[mi] = *(const bf16x8*)(sa + mi * 2048 + off);
#pragma unroll
      for (int ni = 0; ni < 4; ++ni) b[ni] = *(const bf16x8*)(sb + ni * 2048 + off);
#pragma unroll
      for (int mi = 0; mi < 4; ++mi)
#pragma unroll
        for (int ni = 0; ni < 4; ++ni)
          acc[mi][ni] = __builtin_amdgcn_mfma_f32_16x16x32_bf16(b[ni], a[mi], acc[mi][ni], 0, 0, 0);
    }
    BARRIER();
  }
}

#define EPI_LOOP(WM_, WN_)                                                       \
  const int _lane = threadIdx.x & 63, _wid = threadIdx.x >> 6;                   \
  const int _wr = _wid / (WN_), _wc = _wid % (WN_), _fr = _lane & 15, _fq = _lane >> 4; \
  _Pragma("unroll") for (int mi = 0; mi < 4; ++mi) _Pragma("unroll") for (int ni = 0; ni < 4; ++ni)
#define EPI_ROW(m0) ((m0) + _wr * 64 + mi * 16 + _fr)
#define EPI_COL(n0) ((n0) + _wc * 64 + ni * 16 + _fq * 4)

__device__ __forceinline__ void ada_item(const Params& p, int item, char* lds) {
  const int tid = threadIdx.x;
  const int layer = item / 48, n0 = (item % 48) * 64;
  float* sc = (float*)lds;
  float* red = sc + 3072;
  for (int i = tid; i < 3072; i += 512) {
    int cond = i >> 10, k = i & 1023;
    float v = cond == 0 ? p.c_ctx[k] : p.c[(cond - 1) * 1024 + k];
    sc[i] = fsilu(v);
  }
  __syncthreads();
  const int n = tid & 63, kg = tid >> 6;
  float a0 = 0.f, a1 = 0.f, a2 = 0.f;
  const float* w = p.ada_w + (size_t)layer * 1024 * 3072 + n0 + n;
#pragma unroll 8
  for (int k = kg * 128; k < kg * 128 + 128; ++k) {
    float wv = w[(size_t)k * 3072];
    a0 += sc[k] * wv; a1 += sc[1024 + k] * wv; a2 += sc[2048 + k] * wv;
  }
  red[(kg * 3 + 0) * 64 + n] = a0;
  red[(kg * 3 + 1) * 64 + n] = a1;
  red[(kg * 3 + 2) * 64 + n] = a2;
  __syncthreads();
  if (tid < 192) {
    int cond = tid >> 6, nn = tid & 63;
    float s = 0.f;
#pragma unroll
    for (int g = 0; g < 8; ++g) s += red[(g * 3 + cond) * 64 + nn];
    s += p.ada_b[layer * 3072 + n0 + nn];
    ((float*)(p.ws + OFF_MOD))[(layer * 3 + cond) * 3072 + n0 + nn] = s;
  }
  __syncthreads();
}

__device__ __forceinline__ void conv_tile(const float* src, int ld, int k0, int n0, u16* dst, int ldd, int drow0, char* lds) {
  float* t = (float*)lds;
  const int tid = threadIdx.x;
#pragma unroll
  for (int i = 0; i < 2; ++i) {
    int kk = (tid >> 4) + i * 32, n4 = (tid & 15) * 4;
    float4 v = *(const float4*)(src + (size_t)(k0 + kk) * ld + n0 + n4);
    t[kk * 65 + n4 + 0] = v.x; t[kk * 65 + n4 + 1] = v.y; t[kk * 65 + n4 + 2] = v.z; t[kk * 65 + n4 + 3] = v.w;
  }
  __syncthreads();
  {
    int i = tid >> 3, kc = (tid & 7) * 8;
    u16x8 o;
#pragma unroll
    for (int q = 0; q < 8; ++q) o[q] = f2bf(t[(kc + q) * 65 + i]);
    *(u16x8*)(dst + (size_t)(drow0 + i) * ldd + k0 + kc) = o;
  }
  __syncthreads();
}

__device__ __forceinline__ void conv_item(const Params& p, int layer, int it, char* lds) {
  const int kind = layer % 3, j = layer / 3;
  if (kind == 0) {
    if (it < 1024) {
      int kt = it >> 6, nt = it & 63;
      conv_tile(p.s5_w_in + (size_t)j * 1024 * 4096, 4096, kt * 64, nt * 64, (u16*)(p.ws + W_WIN), 1024, nt * 64, lds);
    } else if (it < 2048) {
      int t = it - 1024, kt = t >> 5, nt = t & 31;
      conv_tile(p.s5_glu_w + (size_t)j * 2048 * 2048, 2048, kt * 64, nt * 64, (u16*)(p.ws + W_GLU), 2048, nt * 64, lds);
    } else {
      int t = it - 2048, kt = t >> 4, nt = t & 15;
      conv_tile(p.s5_w_out + (size_t)j * 2048 * 1024, 1024, kt * 64, nt * 64, (u16*)(p.ws + W_WOUT), 2048, nt * 64, lds);
    }
  } else if (kind == 1) {
    if (it < 1024) {
      int kt = it >> 6, nt = it & 63;
      conv_tile(p.pool_w_in + (size_t)j * 1024 * 4096, 4096, kt * 64, nt * 64, (u16*)(p.ws + W_WIN), 1024, nt * 64, lds);
    } else if (it < 1280) {
      int t = it - 1024, g = t >> 6, r = t & 63, kt = r >> 3, nt = r & 7;
      conv_tile(p.pool_w + ((size_t)j * 4 + g) * 512 * 512, 512, kt * 64, nt * 64, (u16*)(p.ws + W_POOLW), 512,
                g * 512 + nt * 64, lds);
    } else {
      int t = it - 1280, kt = t >> 4, nt = t & 15;
      conv_tile(p.pool_w_out + (size_t)j * 2048 * 1024, 1024, kt * 64, nt * 64, (u16*)(p.ws + W_WOUT), 2048, nt * 64, lds);
    }
  } else {
    if (it < 624) {
      int kt = it / 39, nt = it % 39;
      conv_tile(p.mla_w_in + (size_t)j * 1024 * 2496, 2496, kt * 64, nt * 64, (u16*)(p.ws + W_WIN), 1024, nt * 64, lds);
    } else if (it < 688) {
      int t = it - 624, kt = t >> 4, h = t & 15, nt = h * 3 + 2;
      conv_tile(p.mla_wq_b + (size_t)j * 256 * 3072, 3072, kt * 64, nt * 64, (u16*)(p.ws + W_WQ), 256, nt * 64, lds);
    } else if (it < 752) {
      int t = it - 688, kt = t >> 5, q = t & 31, h = q >> 1, half = q & 1, nt = h * 4 + 2 + half;
      conv_tile(p.mla_wkv_b + (size_t)j * 128 * 4096, 4096, kt * 64, nt * 64, (u16*)(p.ws + W_WUV), 128,
                h * 128 + half * 64, lds);
    } else {
      int t = it - 752, kt = t >> 4, nt = t & 15;
      conv_tile(p.mla_w_out + (size_t)j * 2048 * 1024, 1024, kt * 64, nt * 64, (u16*)(p.ws + W_WOUT), 2048, nt * 64, lds);
    }
  }
}
__device__ __forceinline__ int conv_count(int layer) {
  const int kind = layer % 3;
  return kind == 0 ? 2560 : (kind == 1 ? 1792 : 1264);
}

__device__ __forceinline__ const float* x_row(const Params& p, int layer, int row) {
  if (layer == 0) return row < 8192 ? p.x_prompt + (size_t)row * 1024 : p.x_sample + (size_t)(row - 8192) * 1024;
  return p.out + (size_t)row * 1024;
}

__device__ __forceinline__ void norm_item(const Params& p, int layer, int item, char* lds) {
  const int tid = threadIdx.x, lane = tid & 63, wid = tid >> 6;
  float* ma = (float*)lds;
  float* mb = ma + 1024;
  const int row0 = item * 32;
  const int cond = cond_of_row(row0);
  const float* mod = (const float*)(p.ws + OFF_MOD) + (size_t)(layer * 3 + cond) * 3072;
  for (int i = tid; i < 1024; i += 512) {
    ma[i] = p.norm_g[layer * 1024 + i] * (1.f + mod[1024 + i]);
    mb[i] = mod[i];
  }
  __syncthreads();
  u16* h = (u16*)(p.ws + OFF_H);
#pragma unroll 1
  for (int i = 0; i < 4; ++i) {
    const int row = row0 + wid * 4 + i;
    const float* x = x_row(p, layer, row);
    float4 v[4];
    float ss = 0.f;
#pragma unroll
    for (int q = 0; q < 4; ++q) {
      v[q] = *(const float4*)(x + q * 256 + lane * 4);
      ss += v[q].x * v[q].x + v[q].y * v[q].y + v[q].z * v[q].z + v[q].w * v[q].w;
    }
    ss = wave_sum(ss);
    const float rstd = rsqrtf(ss * (1.f / 1024.f) + 1e-6f);
#pragma unroll
    for (int q = 0; q < 4; ++q) {
      const int c = q * 256 + lane * 4;
      float4 a = *(const float4*)(ma + c), b = *(const float4*)(mb + c);
      u16x4 o;
      o[0] = f2bf(v[q].x * rstd * a.x + b.x);
      o[1] = f2bf(v[q].y * rstd * a.y + b.y);
      o[2] = f2bf(v[q].z * rstd * a.z + b.z);
      o[3] = f2bf(v[q].w * rstd * a.w + b.w);
      *(u16x4*)(h + (size_t)row * 1024 + c) = o;
    }
  }
  __syncthreads();
}

__device__ __forceinline__ void derive_item(const Params& p, int j, int g, char* lds) {
  const int tid = threadIdx.x;
  float2* pw = (float2*)lds;
  float2* bb = pw + 2 * 17 * 64;
  float2* cc = bb + 2 * 64 * 16;
  float* kt = (float*)(cc + 2 * 16 * 64);
  for (int i = tid; i < 2 * 17 * 64; i += 512) {
    int pp = i & 63, k = (i >> 6) % 17, dir = i / (17 * 64);
    int li = ((j * 2 + dir) * 128 + g) * 64 + pp;
    float lr = p.s5_lam_re[li], lim = p.s5_lam_im[li];
    float st = __expf(p.s5_log_step[(j * 2 + dir) * 128 + g]);
    float mag = __expf((float)k * lr * st);
    float2 cs = cis_rev((double)k * (double)lim * (double)st * 0.15915494309189535);
    pw[i] = make_float2(mag * cs.x, mag * cs.y);
  }
  for (int i = tid; i < 2 * 16 * 64; i += 512) {
    int pp = i & 63, c = (i >> 6) & 15, dir = i >> 10;
    size_t ci = ((size_t)((j * 2 + dir) * 128 + g) * 16 + c) * 64 + pp;
    cc[i] = make_float2(p.s5_c_re[ci], p.s5_c_im[ci]);
  }
  __syncthreads();
  for (int i = tid; i < 2 * 64 * 16; i += 512) {
    int c = i & 15, pp = (i >> 4) & 63, dir = i >> 10;
    int li = ((j * 2 + dir) * 128 + g) * 64 + pp;
    float lr = p.s5_lam_re[li], lim = p.s5_lam_im[li];
    float2 lb = pw[(dir * 17 + 1) * 64 + pp];
    float nr = lb.x - 1.f, ni = lb.y;
    float den = 1.f / (lr * lr + lim * lim);
    float cr = (nr * lr + ni * lim) * den, ci = (ni * lr - nr * lim) * den;
    size_t bi = ((size_t)li) * 16 + c;
    float br = p.s5_b_re[bi], bim = p.s5_b_im[bi];
    bb[i] = make_float2(cr * br - ci * bim, cr * bim + ci * br);
  }
  __syncthreads();
  for (int o = tid; o < 8192; o += 512) {
    int c2 = o & 15, c = (o >> 4) & 15, lag = (o >> 8) & 15, dir = o >> 12;
    float acc = 0.f;
    for (int pp = 0; pp < 64; ++pp) {
      float2 C = cc[(dir * 16 + c) * 64 + pp], P = pw[(dir * 17 + lag) * 64 + pp], B = bb[(dir * 64 + pp) * 16 + c2];
      float cpx = C.x * P.x - C.y * P.y, cpy = C.x * P.y + C.y * P.x;
      acc += cpx * B.x - cpy * B.y;
    }
    kt[o] = acc;
  }
  __syncthreads();
  u16* wbig = (u16*)(p.ws + B_WBIG) + (size_t)g * 256 * 512;
  for (int q = tid; q < 256 * 64; q += 512) {
    int o = q >> 6, k0 = (q & 63) * 8;
    int t = o >> 4, c = o & 15;
    u16x8 v;
    if (k0 < 256) {
      int s = k0 >> 4, c20 = k0 & 15;
      float dsk = p.s5_d[j * 2048 + g * 16 + c];
#pragma unroll
      for (int e = 0; e < 8; ++e) {
        int c2 = c20 + e;
        float val = 0.f;
        if (s <= t) val += kt[((0 * 16 + (t - s)) * 16 + c) * 16 + c2];
        if (s >= t) val += kt[((1 * 16 + (s - t)) * 16 + c) * 16 + c2];
        if (s == t && c2 == c) val += dsk;
        v[e] = f2bf(val);
      }
    } else {
      int dir = k0 >= 384 ? 1 : 0;
      int kk = k0 - 256 - dir * 128;
      int ri = kk >> 6, p0 = kk & 63;
      int e_pow = dir == 0 ? t + 1 : 16 - t;
#pragma unroll
      for (int e = 0; e < 8; ++e) {
        int pp = p0 + e;
        float2 C = cc[(dir * 16 + c) * 64 + pp], P = pw[(dir * 17 + e_pow) * 64 + pp];
        float val = ri == 0 ? (C.x * P.x - C.y * P.y) : -(C.x * P.y + C.y * P.x);
        v[e] = f2bf(val);
      }
    }
    *(u16x8*)(wbig + (size_t)o * 512 + k0) = v;
  }
  u16* wst = (u16*)(p.ws + B_WST) + (size_t)g * 256 * 256;
  for (int q = tid; q < 256 * 32; q += 512) {
    int o = q >> 5, k0 = (q & 31) * 8;
    int dir = o >> 7, ri = (o >> 6) & 1, pp = o & 63;
    int s = k0 >> 4, c20 = k0 & 15;
    int e_pow = dir == 0 ? 15 - s : s;
    float2 P = pw[(dir * 17 + e_pow) * 64 + pp];
    u16x8 v;
#pragma unroll
    for (int e = 0; e < 8; ++e) {
      float2 B = bb[(dir * 64 + pp) * 16 + c20 + e];
      float val = ri == 0 ? (P.x * B.x - P.y * B.y) : (P.x * B.y + P.y * B.x);
      v[e] = f2bf(val);
    }
    *(u16x8*)(wst + (size_t)o * 256 + k0) = v;
  }
  __syncthreads();
}

__device__ __forceinline__ void wqabs_item(const Params& p, int item, char* lds) {
  const int tid = threadIdx.x;
  const int h = item >> 3, l0 = (item & 7) * 16;
  float* bs = (float*)lds;
  {
    int li = tid >> 5, d4 = (tid & 31) * 4;
    *(float4*)(bs + li * 128 + d4) = *(const float4*)(p.mla_wkv_b + (size_t)(l0 + li) * 4096 + h * 256 + d4);
  }
  __syncthreads();
  const int r = tid & 255, lh = tid >> 8;
  float acc[8];
#pragma unroll
  for (int i = 0; i < 8; ++i) acc[i] = 0.f;
  const float* arow = p.mla_wq_b + (size_t)r * 3072 + h * 192;
  for (int d4 = 0; d4 < 32; ++d4) {
    float4 a = *(const float4*)(arow + d4 * 4);
#pragma unroll
    for (int i = 0; i < 8; ++i) {
      float4 b = *(const float4*)(bs + (lh * 8 + i) * 128 + d4 * 4);
      acc[i] += a.x * b.x + a.y * b.y + a.z * b.z + a.w * b.w;
    }
  }
  u16* wq = (u16*)(p.ws + W_WQ);
#pragma unroll
  for (int i = 0; i < 8; ++i) wq[(size_t)(h * 192 + l0 + lh * 8 + i) * 256 + r] = f2bf(acc[i]);
  __syncthreads();
}

__device__ __forceinline__ void ph_prep(const Params& p, int layer, bool with_ada, bool with_norm, char* lds, int bid, int nb) {
  const int kind = layer % 3, j = layer / 3;
  const int n_special = (kind == 0 || kind == 2) ? 128 : 0;
  const int n_ada = with_ada ? 192 : 0;
  const int n_conv = conv_count(layer);
  const int n_norm = with_norm ? 384 : 0;
  const int total = n_special + n_ada + n_conv + n_norm;
  for (int it = bid; it < total; it += nb) {
    int t = it;
    if (t < n_special) {
      if (kind == 0) derive_item(p, j, t, lds); else wqabs_item(p, t, lds);
      continue;
    }
    t -= n_special;
    if (t < n_ada) { ada_item(p, t, lds); continue; }
    t -= n_ada;
    if (t < n_norm) { norm_item(p, layer, t, lds); continue; }
    t -= n_norm;
    conv_item(p, layer, t, lds);
  }
}
__device__ __forceinline__ void ph_norm(const Params& p, int layer, char* lds, int bid, int nb) {
  for (int it = bid; it < 384; it += nb) norm_item(p, layer, it, lds);
}

__device__ __forceinline__ void tile_mn(int t, int MT, int NT, int& mt, int& nt) {
  int per = 8 * NT;
  int grp = t / per, r = t % per;
  int gm = MT - grp * 8; gm = gm > 8 ? 8 : gm;
  mt = grp * 8 + r % gm; nt = r / gm;
}

__device__ __forceinline__ void ph_inproj(const Params& p, char* lds, int bid, int nb) {
  const u16* h = (const u16*)(p.ws + OFF_H);
  const u16* w = (const u16*)(p.ws + W_WIN);
  u16* uz = (u16*)(p.ws + OFF_A);
  for (int t = bid; t < 48 * 32; t += nb) {
    int mt, nt; tile_mn(t, 48, 32, mt, nt);
    const int m0 = mt * 256, n0 = nt * 128;
    f32x4 acc[4][4];
    gemm_loop<4, 2>(lds, 16,
        [&](int r, int k) { return h + (size_t)(m0 + r) * 1024 + k; },
        [&](int r, int k) { return w + (size_t)(n0 + r) * 1024 + k; }, acc);
    EPI_LOOP(4, 2) {
      const int row = EPI_ROW(m0), col = EPI_COL(n0);
      f32x4 v = acc[mi][ni];
      if (col >= 2048) { v[0] = fsilu(v[0]); v[1] = fsilu(v[1]); v[2] = fsilu(v[2]); v[3] = fsilu(v[3]); }
      *(u16x4*)(uz + (size_t)row * 4096 + col) = pack4(v);
    }
  }
}

__device__ __forceinline__ void ph_s5g1(const Params& p, char* lds, int bid, int nb) {
  const u16* uz = (const u16*)(p.ws + OFF_A);
  u16* X = (u16*)(p.ws + OFF_C);
  for (int t = bid; t < 768; t += nb) {
    const int g = t / 6, mt = (t % 6) >> 1, nt = t & 1;
    const int m0 = mt * 256, n0 = nt * 128;
    const u16* w = (const u16*)(p.ws + B_WST) + (size_t)g * 65536;
    f32x4 acc[4][4];
    gemm_loop<4, 2>(lds, 4,
        [&](int r, int k) { return uz + (size_t)((m0 + r) * 16 + (k >> 4)) * 4096 + g * 16 + (k & 15); },
        [&](int r, int k) { return w + (size_t)(n0 + r) * 256 + k; }, acc);
    EPI_LOOP(4, 2) {
      const int row = EPI_ROW(m0), col = EPI_COL(n0);
      *(u16x4*)(X + ((size_t)row * 128 + g) * 256 + col) = pack4(acc[mi][ni]);
    }
  }
}

__device__ __forceinline__ void ph_scan(const Params& p, int j, int bid, int nb) {
  const int tid = threadIdx.x;
  u16* X = (u16*)(p.ws + OFF_C);
  for (int it = bid; it < 1088; it += nb) {
    int b, gq, r0, nc; bool sample;
    if (it < 64) { sample = true; b = it >> 5; gq = it & 31; r0 = 512 + b * 128; nc = 128; }
    else { int q = it - 64; sample = false; b = q >> 5; gq = q & 31; r0 = b * 16; nc = 16; }
    const int g = gq * 4 + (tid >> 7), dir = (tid >> 6) & 1, pp = tid & 63;
    const int li = ((j * 2 + dir) * 128 + g) * 64 + pp;
    const float lr = p.s5_lam_re[li], lim = p.s5_lam_im[li];
    const float st = __expf(p.s5_log_step[(j * 2 + dir) * 128 + g]);
    const float mag = __expf(16.f * lr * st);
    const float2 cs = cis_rev(16.0 * (double)lim * (double)st * 0.15915494309189535);
    const float ar = mag * cs.x, ai = mag * cs.y;
    float pr = 0.f, pi = 0.f;
    if (sample) {
      size_t si = ((size_t)((b * 2 + j) * 2 + dir) * 128 + g) * 64 + pp;
      pr = p.st_re[si]; pi = p.st_im[si];
    }
    u16* base = X + ((size_t)r0 * 128 + g) * 256 + dir * 128 + pp;
    const size_t cstride = (size_t)128 * 256;
    if (dir == 0) {
#pragma unroll 8
      for (int c = 0; c < nc; ++c) {
        u16* q = base + (size_t)c * cstride;
        float sr = bf2f(q[0]), si = bf2f(q[64]);
        q[0] = f2bf(pr); q[64] = f2bf(pi);
        float nr = ar * pr - ai * pi + sr, ni = ar * pi + ai * pr + si;
        pr = nr; pi = ni;
      }
    } else {
#pragma unroll 8
      for (int c = nc - 1; c >= 0; --c) {
        u16* q = base + (size_t)c * cstride;
        float sr = bf2f(q[0]), si = bf2f(q[64]);
        q[0] = f2bf(pr); q[64] = f2bf(pi);
        float nr = ar * pr - ai * pi + sr, ni = ar * pi + ai * pr + si;
        pr = nr; pi = ni;
      }
    }
    if (!sample) {
      size_t oi = ((size_t)((b * 2 + j) * 2 + dir) * 128 + g) * 64 + pp;
      p.out[OUT_RE + oi] = pr;
      p.out[OUT_IM + oi] = pi;
    }
  }
}

__device__ __forceinline__ void ph_s5g3(const Params& p, char* lds, int bid, int nb) {
  u16* uz = (u16*)(p.ws + OFF_A);
  const u16* X = (const u16*)(p.ws + OFF_C);
  for (int t = bid; t < 768; t += nb) {
    const int g = t / 6, mt = t % 6;
    const int m0 = mt * 128;
    const u16* w = (const u16*)(p.ws + B_WBIG) + (size_t)g * 131072;
    f32x4 acc[4][4];
    gemm_loop<2, 4>(lds, 8,
        [&](int r, int k) {
          return k < 256 ? (const u16*)(uz + (size_t)((m0 + r) * 16 + (k >> 4)) * 4096 + g * 16 + (k & 15))
                         : X + ((size_t)(m0 + r) * 128 + g) * 256 + (k - 256);
        },
        [&](int r, int k) { return w + (size_t)r * 512 + k; }, acc);
    EPI_LOOP(2, 4) {
      const int row = EPI_ROW(m0), col = EPI_COL(0);
      f32x4 v = acc[mi][ni];
      v[0] = fgelu(v[0]); v[1] = fgelu(v[1]); v[2] = fgelu(v[2]); v[3] = fgelu(v[3]);
      *(u16x4*)(uz + (size_t)(row * 16 + (col >> 4)) * 4096 + g * 16 + (col & 15)) = pack4(v);
    }
  }
}

__device__ __forceinline__ void ph_glu(const Params& p, int j, char* lds, int bid, int nb) {
  const u16* uz = (const u16*)(p.ws + OFF_A);
  const u16* w = (const u16*)(p.ws + W_GLU);
  u16* m = (u16*)(p.ws + OFF_C);
  for (int t = bid; t < 48 * 16; t += nb) {
    int mt, nt; tile_mn(t, 48, 16, mt, nt);
    const int m0 = mt * 256, n0 = nt * 128;
    f32x4 acc[4][4];
    gemm_loop<4, 2>(lds, 32,
        [&](int r, int k) { return uz + (size_t)(m0 + r) * 4096 + k; },
        [&](int r, int k) { return w + (size_t)(n0 + r) * 2048 + k; }, acc);
    EPI_LOOP(4, 2) {
      const int row = EPI_ROW(m0), col = EPI_COL(n0);
      f32x4 v = acc[mi][ni];
      float4 gb = *(const float4*)(p.s5_glu_b + j * 2048 + col);
      u16x4 yv = *(const u16x4*)(uz + (size_t)row * 4096 + col);
      u16x4 zv = *(const u16x4*)(uz + (size_t)row * 4096 + 2048 + col);
      f32x4 o;
      o[0] = bf2f(yv[0]) * fsigmoid(v[0] + gb.x) * bf2f(zv[0]);
      o[1] = bf2f(yv[1]) * fsigmoid(v[1] + gb.y) * bf2f(zv[1]);
      o[2] = bf2f(yv[2]) * fsigmoid(v[2] + gb.z) * bf2f(zv[2]);
      o[3] = bf2f(yv[3]) * fsigmoid(v[3] + gb.w) * bf2f(zv[3]);
      *(u16x4*)(m + (size_t)row * 2048 + col) = pack4(o);
    }
  }
}

__device__ __forceinline__ void ph_out(const Params& p, int layer, const u16* m, char* lds, int bid, int nb) {
  const u16* w = (const u16*)(p.ws + W_WOUT);
  const float* mod = (const float*)(p.ws + OFF_MOD);
  for (int t = bid; t < 48 * 8; t += nb) {
    int mt, nt; tile_mn(t, 48, 8, mt, nt);
    const int m0 = mt * 256, n0 = nt * 128;
    f32x4 acc[4][4];
    gemm_loop<4, 2>(lds, 32,
        [&](int r, int k) { return m + (size_t)(m0 + r) * 2048 + k; },
        [&](int r, int k) { return w + (size_t)(n0 + r) * 2048 + k; }, acc);
    const int cond = cond_of_row(m0);
    const float* gate = mod + (size_t)(layer * 3 + cond) * 3072 + 2048;
    EPI_LOOP(4, 2) {
      const int row = EPI_ROW(m0), col = EPI_COL(n0);
      f32x4 v = acc[mi][ni];
      float4 gt = *(const float4*)(gate + col);
      float4 xo = *(const float4*)(x_row(p, layer, row) + col);
      float4 o;
      o.x = xo.x + gt.x * v[0]; o.y = xo.y + gt.y * v[1]; o.z = xo.z + gt.z * v[2]; o.w = xo.w + gt.w * v[3];
      *(float4*)(p.out + (size_t)row * 1024 + col) = o;
    }
  }
}

__device__ __forceinline__ void ph_pool(const Params& p, int bid, int nb) {
  const u16* uz = (const u16*)(p.ws + OFF_A);
  u16* pb = (u16*)(p.ws + OFF_B);
  for (int idx = bid * 512 + threadIdx.x; idx < NT_TOK * 256; idx += nb * 512) {
    const int tok = idx >> 8, ch0 = (idx & 255) * 8;
    const int gi = ch0 >> 9, win = 2 << gi, lo = win >> 1;
    int t, L, base;
    if (tok < 8192) { L = 256; t = tok & 255; base = tok - t; }
    else { L = 2048; t = (tok - 8192) & 2047; base = tok - t; }
    int s0 = t - lo; if (s0 < 0) s0 = 0;
    int s1 = t - lo + win; if (s1 > L) s1 = L;
    float acc[8];
#pragma unroll
    for (int e = 0; e < 8; ++e) acc[e] = 0.f;
    for (int s = s0; s < s1; ++s) {
      u16x8 v = *(const u16x8*)(uz + (size_t)(base + s) * 4096 + ch0);
#pragma unroll
      for (int e = 0; e < 8; ++e) acc[e] += bf2f(v[e]);
    }
    const float inv = 1.f / (float)(s1 - s0);
    u16x8 self = *(const u16x8*)(uz + (size_t)tok * 4096 + ch0);
    u16x8 o;
#pragma unroll
    for (int e = 0; e < 8; ++e) o[e] = f2bf(acc[e] * inv - bf2f(self[e]));
    *(u16x8*)(pb + (size_t)tok * 2048 + ch0) = o;
  }
}

__device__ __forceinline__ void ph_poolmm(const Params& p, int j, char* lds, int bid, int nb) {
  const u16* pb = (const u16*)(p.ws + OFF_B);
  const u16* w = (const u16*)(p.ws + W_POOLW);
  const u16* uz = (const u16*)(p.ws + OFF_A);
  u16* m = (u16*)(p.ws + OFF_C);
  for (int t = bid; t < 48 * 16; t += nb) {
    int mt, nt; tile_mn(t, 48, 16, mt, nt);
    const int m0 = mt * 256, n0 = nt * 128, gi = n0 >> 9;
    f32x4 acc[4][4];
    gemm_loop<4, 2>(lds, 8,
        [&](int r, int k) { return pb + (size_t)(m0 + r) * 2048 + gi * 512 + k; },
        [&](int r, int k) { return w + (size_t)(n0 + r) * 512 + k; }, acc);
    EPI_LOOP(4, 2) {
      const int row = EPI_ROW(m0), col = EPI_COL(n0);
      f32x4 v = acc[mi][ni];
      float4 sc = *(const float4*)(p.pool_scale + j * 2048 + col);
      u16x4 zv = *(const u16x4*)(uz + (size_t)row * 4096 + 2048 + col);
      f32x4 o;
      o[0] = v[0] * sc.x * bf2f(zv[0]); o[1] = v[1] * sc.y * bf2f(zv[1]);
      o[2] = v[2] * sc.z * bf2f(zv[2]); o[3] = v[3] * sc.w * bf2f(zv[3]);
      *(u16x4*)(m + (size_t)row * 2048 + col) = pack4(o);
    }
  }
}

__device__ __forceinline__ void ph_inproj_mla(const Params& p, char* lds, int bid, int nb) {
  const u16* h = (const u16*)(p.ws + OFF_H);
  const u16* w = (const u16*)(p.ws + W_WIN);
  float* qa = (float*)(p.ws + A_QA);
  float* ckvf = (float*)(p.ws + A_CKVF);
  float* kpef = (float*)(p.ws + A_KPEF);
  u16* zb = (u16*)(p.ws + OFF_B);
  for (int t = bid; t < 48 * 20; t += nb) {
    int mt, nt; tile_mn(t, 48, 20, mt, nt);
    const int m0 = mt * 256, n0 = nt * 128;
    f32x4 acc[4][4];
    gemm_loop<4, 2>(lds, 16,
        [&](int r, int k) { return h + (size_t)(m0 + r) * 1024 + k; },
        [&](int r, int k) { int n = n0 + r; n = n > 2495 ? 2495 : n; return w + (size_t)n * 1024 + k; }, acc);
    EPI_LOOP(4, 2) {
      const int row = EPI_ROW(m0), col = EPI_COL(n0);
      f32x4 v = acc[mi][ni];
      if (col < 256) {
        *(f32x4*)(qa + (size_t)row * 256 + col) = v;
      } else if (col < 384) {
        *(f32x4*)(ckvf + (size_t)row * 128 + (col - 256)) = v;
      } else if (col < 448) {
        *(f32x4*)(kpef + (size_t)row * 64 + (col - 384)) = v;
      } else if (col < 2496) {
        v[0] = fsilu(v[0]); v[1] = fsilu(v[1]); v[2] = fsilu(v[2]); v[3] = fsilu(v[3]);
        *(u16x4*)(zb + (size_t)row * 2048 + (col - 448)) = pack4(v);
      }
    }
  }
}

__device__ __forceinline__ int vt_slot(int pos) {
  int k = pos & 31;
  return (pos & ~31) | (((k >> 2) & 3) * 8 + (k >> 4) * 4 + (k & 3));
}

__device__ __forceinline__ void ph_mlanorm(const Params& p, int j, char* lds, int bid, int nb) {
  const int tid = threadIdx.x, lane = tid & 63, wid = tid >> 6;
  const float* qa = (const float*)(p.ws + A_QA);
  const float* ckvf = (const float*)(p.ws + A_CKVF);
  const float* kpef = (const float*)(p.ws + A_KPEF);
  u16* qan = (u16*)(p.ws + OFF_QAN);
  u16* Kb = (u16*)(p.ws + OFF_KB);
  u16* VT = (u16*)(p.ws + OFF_VT);
  u16* tile = (u16*)lds;
  for (int it = bid; it < 208; it += nb) {
    const bool cache = it >= 192;
    int kvrow0, pos0, Lk; size_t vtbase;
    int tok0 = 0, cb = 0, ci0 = 0;
    bool sample = false;
    if (!cache) {
      tok0 = it * 64;
      if (tok0 < 8192) { int b = tok0 >> 8; pos0 = tok0 & 255; kvrow0 = tok0; Lk = 256; vtbase = (size_t)b * 128 * 256; }
      else { sample = true; int b = (tok0 - 8192) >> 11; int t0 = (tok0 - 8192) & 2047; pos0 = 512 + t0;
             kvrow0 = 8192 + b * 2560 + pos0; Lk = 2560; vtbase = (size_t)32 * 128 * 256 + (size_t)b * 128 * 2560; }
    } else {
      int q = it - 192; cb = q >> 3; ci0 = (q & 7) * 64; pos0 = ci0;
      kvrow0 = 8192 + cb * 2560 + pos0; Lk = 2560; vtbase = (size_t)32 * 128 * 256 + (size_t)cb * 128 * 2560;
    }
#pragma unroll 1
    for (int i = 0; i < 8; ++i) {
      const int rl = wid * 8 + i;
      float c0, c1, kp;
      if (!cache) {
        const int tok = tok0 + rl;
        float4 qv = *(const float4*)(qa + (size_t)tok * 256 + lane * 4);
        float ss = wave_sum(qv.x * qv.x + qv.y * qv.y + qv.z * qv.z + qv.w * qv.w);
        float rs = rsqrtf(ss * (1.f / 256.f) + 1e-6f);
        float4 qg = *(const float4*)(p.mla_q_norm + j * 256 + lane * 4);
        u16x4 qo;
        qo[0] = f2bf(qv.x * rs * qg.x); qo[1] = f2bf(qv.y * rs * qg.y);
        qo[2] = f2bf(qv.z * rs * qg.z); qo[3] = f2bf(qv.w * rs * qg.w);
        *(u16x4*)(qan + (size_t)tok * 256 + lane * 4) = qo;
        float2 cv = *(const float2*)(ckvf + (size_t)tok * 128 + lane * 2);
        float s2 = wave_sum(cv.x * cv.x + cv.y * cv.y);
        float r2 = rsqrtf(s2 * (1.f / 128.f) + 1e-6f);
        float2 kg = *(const float2*)(p.mla_kv_norm + j * 128 + lane * 2);
        c0 = cv.x * r2 * kg.x; c1 = cv.y * r2 * kg.y;
        float x = kpef[(size_t)tok * 64 + lane];
        if (!sample) {
          *(float2*)(p.out + OUT_CKV + (size_t)tok * 128 + lane * 2) = make_float2(c0, c1);
          p.out[OUT_KPE + (size_t)tok * 64 + lane] = x;
          kp = x;
        } else {
          const int tpos = (tok - 8192) & 2047;
          const int axis = lane >> 5, within = lane & 31, fi = within & 15, isx2 = within >> 4;
          float xp = __shfl_xor(x, 16);
          float posf = (float)(axis == 0 ? (tpos >> 6) : (tpos & 63));
          float inv = __builtin_amdgcn_exp2f(-(float)fi * 0.830482023721841f);
          float rev = posf * inv * 0.15915494309189535f;
          rev -= rintf(rev);
          float cs = __builtin_amdgcn_cosf(rev), sn = __builtin_amdgcn_sinf(rev);
          float x1 = isx2 ? xp : x, x2 = isx2 ? x : xp;
          kp = isx2 ? (x1 * sn + x2 * cs) : (x1 * cs - x2 * sn);
        }
      } else {
        const size_t ci = (size_t)(cb * 1 + j) * 512 + ci0 + rl;
        float2 cv = *(const float2*)(p.cache_ckv + ci * 128 + lane * 2);
        c0 = cv.x; c1 = cv.y;
        kp = p.cache_kpe[ci * 64 + lane];
      }
      const size_t kr = (size_t)(kvrow0 + rl);
      unsigned pk = (unsigned)f2bf(c0) | ((unsigned)f2bf(c1) << 16);
      *(unsigned*)(Kb + kr * 192 + lane * 2) = pk;
      Kb[kr * 192 + 128 + lane] = f2bf(kp);
      *(unsigned*)(tile + rl * 136 + lane * 2) = pk;
    }
    __syncthreads();
    {
      const int d = tid >> 2, part = tid & 3;
      u16x8 o0, o1;
#pragma unroll
      for (int e = 0; e < 16; ++e) {
        int s = part * 16 + e;
        int blk = s >> 5, sl = s & 31;
        int kgq = sl >> 3, sub = (sl >> 2) & 1, jj = sl & 3;
        int kap = sub * 16 + kgq * 4 + jj;
        u16 v = tile[(blk * 32 + kap) * 136 + d];
        if (e < 8) o0[e] = v; else o1[e - 8] = v;
      }
      u16* dst = VT + vtbase + (size_t)d * Lk + pos0 + part * 16;
      *(u16x8*)(dst) = o0;
      *(u16x8*)(dst + 8) = o1;
    }
    __syncthreads();
  }
}

__device__ __forceinline__ void ph_qgemm(const Params& p, char* lds, int bid, int nb) {
  const u16* qan = (const u16*)(p.ws + OFF_QAN);
  const u16* w = (const u16*)(p.ws + W_WQ);
  u16* q = (u16*)(p.ws + OFF_A);
  const float SC = 0.07216878364870322f * 1.4426950408889634f;
  for (int t = bid; t < 48 * 24; t += nb) {
    int mt, nt; tile_mn(t, 48, 24, mt, nt);
    const int m0 = mt * 256, n0 = nt * 128;
    f32x4 acc[4][4];
    gemm_loop<4, 2>(lds, 4,
        [&](int r, int k) { return qan + (size_t)(m0 + r) * 256 + k; },
        [&](int r, int k) { return w + (size_t)(n0 + r) * 256 + k; }, acc);
    const int lane = threadIdx.x & 63, wid = threadIdx.x >> 6;
    const int wr = wid >> 1, wc = wid & 1, fr = lane & 15, fq = lane >> 4;
    const int cb = n0 + wc * 64;
    const bool rope = (m0 >= 8192) && ((cb % 192) == 128);
#pragma unroll
    for (int mi = 0; mi < 4; ++mi) {
      const int row = m0 + wr * 64 + mi * 16 + fr;
      f32x4 v[4];
#pragma unroll
      for (int ni = 0; ni < 4; ++ni) v[ni] = acc[mi][ni];
      if (rope) {
        const int tpos = (row - 8192) & 2047;
#pragma unroll
        for (int ax = 0; ax < 2; ++ax) {
          const float posf = (float)(ax == 0 ? (tpos >> 6) : (tpos & 63));
#pragma unroll
          for (int jj = 0; jj < 4; ++jj) {
            const int fi = fq * 4 + jj;
            float inv = __builtin_amdgcn_exp2f(-(float)fi * 0.830482023721841f);
            float rev = posf * inv * 0.15915494309189535f;
            rev -= rintf(rev);
            float cs = __builtin_amdgcn_cosf(rev), sn = __builtin_amdgcn_sinf(rev);
            float x1 = v[ax * 2][jj], x2 = v[ax * 2 + 1][jj];
            v[ax * 2][jj] = x1 * cs - x2 * sn;
            v[ax * 2 + 1][jj] = x1 * sn + x2 * cs;
          }
        }
      }
#pragma unroll
      for (int ni = 0; ni < 4; ++ni) {
        f32x4 o = v[ni];
        o[0] *= SC; o[1] *= SC; o[2] *= SC; o[3] *= SC;
        *(u16x4*)(q + (size_t)row * 3072 + cb + ni * 16 + fq * 4) = pack4(o);
      }
    }
  }
}

__device__ __forceinline__ void ph_attn(const Params& p, char* lds, int bid, int nb) {
  const int tid = threadIdx.x, lane = tid & 63, wid = tid >> 6, fr = lane & 15, fq = lane >> 4;
  const u16* q = (const u16*)(p.ws + OFF_A);
  const u16* Kb = (const u16*)(p.ws + OFF_KB);
  const u16* VT = (const u16*)(p.ws + OFF_VT);
  u16* ol = (u16*)(p.ws + OFF_C);
  for (int it = bid; it < 768; it += nb) {
    int h, tokq0, kvbase, Lk; size_t vtbase;
    if (it < 256) { int b = it >> 7, qt = (it >> 4) & 7; h = it & 15; tokq0 = 8192 + b * 2048 + qt * 256;
                    kvbase = 8192 + b * 2560; Lk = 2560; vtbase = (size_t)32 * 128 * 256 + (size_t)b * 128 * 2560; }
    else { int r = it - 256; int b = r >> 4; h = r & 15; tokq0 = b * 256; kvbase = b * 256; Lk = 256;
           vtbase = (size_t)b * 128 * 256; }
    const int nkt = Lk >> 6;
    const u16* vt = VT + vtbase;
    bf16x8 qf[2][6];
#pragma unroll
    for (int qs = 0; qs < 2; ++qs)
#pragma unroll
      for (int ks = 0; ks < 6; ++ks)
        qf[qs][ks] = *(const bf16x8*)(q + (size_t)(tokq0 + wid * 32 + qs * 16 + fr) * 3072 + h * 192 + ks * 32 + fq * 8);
    f32x4 O[8][2];
#pragma unroll
    for (int d = 0; d < 8; ++d) { O[d][0] = f32x4{0, 0, 0, 0}; O[d][1] = f32x4{0, 0, 0, 0}; }
    float mrun[2] = {-1e30f, -1e30f}, lrun[2] = {0.f, 0.f};

    auto stage = [&](int kt, int buf) {
      char* base = lds + buf * 40960;
#pragma unroll
      for (int i = 0; i < 3; ++i) {
        int idx = tid + i * 512;
        int r = idx / 24, pos = idx - r * 24;
        int kc = (pos & ~7) | ((pos ^ r) & 7);
        glds16(Kb + (size_t)(kvbase + kt * 64 + r) * 192 + kc * 8, base + idx * 16);
      }
#pragma unroll
      for (int i = 0; i < 2; ++i) {
        int idx = tid + i * 512;
        int d = idx >> 3, pos = idx & 7;
        int kc = pos ^ (d & 7);
        glds16(vt + (size_t)d * Lk + kt * 64 + kc * 8, base + 24576 + idx * 16);
      }
    };
    stage(0, 0);
    for (int kt = 0; kt < nkt; ++kt) {
      const int cur = kt & 1;
      if (kt + 1 < nkt) { stage(kt + 1, cur ^ 1); WAIT_VM(5); } else { WAIT_VM(0); }
      BARRIER();
      const char* kb = lds + cur * 40960;
      const char* vb = kb + 24576;
      f32x4 s[4][2];
#pragma unroll
      for (int sub = 0; sub < 4; ++sub) { s[sub][0] = f32x4{0, 0, 0, 0}; s[sub][1] = f32x4{0, 0, 0, 0}; }
#pragma unroll
      for (int ks = 0; ks < 6; ++ks) {
        const int coff = ((ks >> 1) * 8 + ((((ks & 1) * 4 + fq) ^ fr) & 7)) * 16;
#pragma unroll
        for (int sub = 0; sub < 4; ++sub) {
          bf16x8 kf = *(const bf16x8*)(kb + (sub * 16 + fr) * 384 + coff);
          s[sub][0] = __builtin_amdgcn_mfma_f32_16x16x32_bf16(kf, qf[0][ks], s[sub][0], 0, 0, 0);
          s[sub][1] = __builtin_amdgcn_mfma_f32_16x16x32_bf16(kf, qf[1][ks], s[sub][1], 0, 0, 0);
        }
      }
      bf16x8 pf[2][2];
#pragma unroll
      for (int qs = 0; qs < 2; ++qs) {
        float mx = s[0][qs][0];
#pragma unroll
        for (int sub = 0; sub < 4; ++sub)
#pragma unroll
          for (int jj = 0; jj < 4; ++jj) mx = fmaxf(mx, s[sub][qs][jj]);
        mx = fmaxf(mx, __shfl_xor(mx, 16));
        mx = fmaxf(mx, __shfl_xor(mx, 32));
        const float mnew = fmaxf(mrun[qs], mx);
        const float alpha = __builtin_amdgcn_exp2f(mrun[qs] - mnew);
        mrun[qs] = mnew;
        float ps = 0.f;
#pragma unroll
        for (int sub = 0; sub < 4; ++sub)
#pragma unroll
          for (int jj = 0; jj < 4; ++jj) {
            float e = __builtin_amdgcn_exp2f(s[sub][qs][jj] - mnew);
            s[sub][qs][jj] = e;
            ps += e;
          }
        lrun[qs] = lrun[qs] * alpha + ps;
#pragma unroll
        for (int d = 0; d < 8; ++d) { O[d][qs][0] *= alpha; O[d][qs][1] *= alpha; O[d][qs][2] *= alpha; O[d][qs][3] *= alpha; }
#pragma unroll
        for (int kbk = 0; kbk < 2; ++kbk) {
          bf16x8 f;
#pragma unroll
          for (int jj = 0; jj < 4; ++jj) {
            f[jj] = (short)f2bf(s[kbk * 2][qs][jj]);
            f[4 + jj] = (short)f2bf(s[kbk * 2 + 1][qs][jj]);
          }
          pf[kbk][qs] = f;
        }
      }
#pragma unroll
      for (int d = 0; d < 8; ++d)
#pragma unroll
        for (int kbk = 0; kbk < 2; ++kbk) {
          bf16x8 vf = *(const bf16x8*)(vb + (d * 16 + fr) * 128 + (((kbk * 4 + fq) ^ (fr & 7)) << 4));
          O[d][0] = __builtin_amdgcn_mfma_f32_16x16x32_bf16(vf, pf[kbk][0], O[d][0], 0, 0, 0);
          O[d][1] = __builtin_amdgcn_mfma_f32_16x16x32_bf16(vf, pf[kbk][1], O[d][1], 0, 0, 0);
        }
      BARRIER();
    }
#pragma unroll
    for (int qs = 0; qs < 2; ++qs) {
      float l = lrun[qs];
      l += __shfl_xor(l, 16);
      l += __shfl_xor(l, 32);
      const float il = 1.f / l;
      const int tok = tokq0 + wid * 32 + qs * 16 + fr;
#pragma unroll
      for (int d = 0; d < 8; ++d) {
        f32x4 o = O[d][qs];
        o[0] *= il; o[1] *= il; o[2] *= il; o[3] *= il;
        *(u16x4*)(ol + (size_t)tok * 2048 + h * 128 + d * 16 + fq * 4) = pack4(o);
      }
    }
  }
}

__device__ __forceinline__ void ph_oexp(const Params& p, char* lds, int bid, int nb) {
  const u16* ol = (const u16*)(p.ws + OFF_C);
  const u16* w = (const u16*)(p.ws + W_WUV);
  u16* zb = (u16*)(p.ws + OFF_B);
  for (int t = bid; t < 48 * 16; t += nb) {
    int mt, nt; tile_mn(t, 48, 16, mt, nt);
    const int m0 = mt * 256, n0 = nt * 128;
    f32x4 acc[4][4];
    gemm_loop<4, 2>(lds, 2,
        [&](int r, int k) { return ol + (size_t)(m0 + r) * 2048 + n0 + k; },
        [&](int r, int k) { return w + (size_t)(n0 + r) * 128 + k; }, acc);
    EPI_LOOP(4, 2) {
      const int row = EPI_ROW(m0), col = EPI_COL(n0);
      f32x4 v = acc[mi][ni];
      u16x4 zv = *(const u16x4*)(zb + (size_t)row * 2048 + col);
      v[0] *= bf2f(zv[0]); v[1] *= bf2f(zv[1]); v[2] *= bf2f(zv[2]); v[3] *= bf2f(zv[3]);
      *(u16x4*)(zb + (size_t)row * 2048 + col) = pack4(v);
    }
  }
}

__device__ __forceinline__ void ph_final(const Params& p, int bid, int nb) {
  const int lane = threadIdx.x & 63, wid = threadIdx.x >> 6;
  for (int row = bid * 8 + wid; row < NT_TOK; row += nb * 8) {
    float* x = p.out + (size_t)row * 1024;
    float4 v[4];
    float ss = 0.f;
#pragma unroll
    for (int q = 0; q < 4; ++q) {
      v[q] = *(const float4*)(x + q * 256 + lane * 4);
      ss += v[q].x * v[q].x + v[q].y * v[q].y + v[q].z * v[q].z + v[q].w * v[q].w;
    }
    ss = wave_sum(ss);
    const float rstd = rsqrtf(ss * (1.f / 1024.f) + 1e-6f);
#pragma unroll
    for (int q = 0; q < 4; ++q) {
      float4 g = *(const float4*)(p.final_g + q * 256 + lane * 4);
      float4 o;
      o.x = v[q].x * rstd * g.x; o.y = v[q].y * rstd * g.y; o.z = v[q].z * rstd * g.z; o.w = v[q].w * rstd * g.w;
      *(float4*)(x + q * 256 + lane * 4) = o;
    }
  }
}

#define N_PHASES 28
template <int ph>
__device__ __forceinline__ void run_phase(const Params& p, char* lds, int bid, int nb) {
  switch (ph) {
    case 0: ph_prep(p, 0, true, false, lds, bid, nb); break;
    case 1: ph_norm(p, 0, lds, bid, nb); break;
    case 2: ph_inproj(p, lds, bid, nb); break;
    case 3: ph_s5g1(p, lds, bid, nb); break;
    case 4: ph_scan(p, 0, bid, nb); break;
    case 5: ph_s5g3(p, lds, bid, nb); break;
    case 6: ph_glu(p, 0, lds, bid, nb); break;
    case 7: ph_out(p, 0, (const u16*)(p.ws + OFF_C), lds, bid, nb); break;
    case 8: ph_prep(p, 1, false, true, lds, bid, nb); break;
    case 9: ph_inproj(p, lds, bid, nb); break;
    case 10: ph_pool(p, bid, nb); break;
    case 11: ph_poolmm(p, 0, lds, bid, nb); break;
    case 12: ph_out(p, 1, (const u16*)(p.ws + OFF_C), lds, bid, nb); break;
    case 13: ph_prep(p, 2, false, true, lds, bid, nb); break;
    case 14: ph_inproj_mla(p, lds, bid, nb); break;
    case 15: ph_mlanorm(p, 0, lds, bid, nb); break;
    case 16: ph_qgemm(p, lds, bid, nb); break;
    case 17: ph_attn(p, lds, bid, nb); break;
    case 18: ph_oexp(p, lds, bid, nb); break;
    case 19: ph_out(p, 2, (const u16*)(p.ws + OFF_B), lds, bid, nb); break;
    case 20: ph_prep(p, 3, false, true, lds, bid, nb); break;
    case 21: ph_inproj(p, lds, bid, nb); break;
    case 22: ph_s5g1(p, lds, bid, nb); break;
    case 23: ph_scan(p, 1, bid, nb); break;
    case 24: ph_s5g3(p, lds, bid, nb); break;
    case 25: ph_glu(p, 1, lds, bid, nb); break;
    case 26: ph_out(p, 3, (const u16*)(p.ws + OFF_C), lds, bid, nb); break;
    case 27: ph_final(p, bid, nb); break;
    default: break;
  }
}

template <int PH>
__device__ __forceinline__ void run_all(const Params& p, char* lds, cg::grid_group& grid, int bid, int nb) {
  if constexpr (PH < N_PHASES) {
    run_phase<PH>(p, lds, bid, nb);
    if constexpr (PH + 1 < N_PHASES) {
      grid.sync();
      run_all<PH + 1>(p, lds, grid, bid, nb);
    }
  }
}

#if MK_SINGLE
__global__ void __launch_bounds__(512) k_mega(Params p) {
  __shared__ __attribute__((aligned(16))) char lds[LDS_BYTES];
  cg::grid_group grid = cg::this_grid();
  run_all<0>(p, lds, grid, blockIdx.x, gridDim.x);
}
#else
template <int PH>
__global__ void __launch_bounds__(512) __attribute__((amdgpu_waves_per_eu(2, 2))) k_phase(Params p) {
  __shared__ __attribute__((aligned(16))) char lds[LDS_BYTES];
  run_phase<PH>(p, lds, blockIdx.x, gridDim.x);
}
template <int PH>
static void launch_all(const Params& p, hipStream_t stream) {
  if constexpr (PH < N_PHASES) {
    k_phase<PH><<<256, 512, 0, stream>>>(p);
    launch_all<PH + 1>(p, stream);
  }
}
#endif

extern "C" void kernel_launch(void* const* d_in, const int* in_sizes, int n_in, void* d_out, int out_size,
                              void* d_ws, size_t ws_size, hipStream_t stream) {
  Params p{};
  const float** f = (const float**)&p;
  for (int i = 0; i < 34; ++i) f[i] = (const float*)d_in[i];
  p.out = (float*)d_out;
  p.ws = (char*)d_ws;
#if MK_SINGLE
  static int grid_blocks = 0;
  if (!grid_blocks) {
    int dev = 0, cus = 0, per_cu = 0;
    (void)hipGetDevice(&dev);
    (void)hipDeviceGetAttribute(&cus, hipDeviceAttributeMultiprocessorCount, dev);
    (void)hipOccupancyMaxActiveBlocksPerMultiprocessor(&per_cu, k_mega, 512, 0);
    if (per_cu > 1) per_cu = 1;
    grid_blocks = cus * per_cu;
    if (grid_blocks <= 0) grid_blocks = 256;
  }
  void* args[] = {&p};
  hipError_t e = hipLaunchCooperativeKernel((void*)k_mega, dim3(grid_blocks), dim3(512), args, 0, stream);
  if (e != hipSuccess) fprintf(stderr, "cooperative launch failed: %s (grid %d)\n", hipGetErrorString(e), grid_blocks);
#else
  launch_all<0>(p, stream);
#endif
}
```

```cpp
#include <hip/hip_runtime.h>
#include <hip/hip_cooperative_groups.h>
#include <cstdio>
namespace cg = cooperative_groups;

#ifndef MK_SINGLE
#define MK_SINGLE 1
#endif

typedef unsigned short u16;
using bf16x8 = __attribute__((ext_vector_type(8))) short;
using f32x4  = __attribute__((ext_vector_type(4))) float;
using u16x4  = __attribute__((ext_vector_type(4))) unsigned short;
using u16x8  = __attribute__((ext_vector_type(8))) unsigned short;

struct Params {
  const float *x_prompt, *x_sample, *st_re, *st_im, *cache_ckv, *cache_kpe, *c, *c_ctx;
  const float *norm_g, *ada_w, *ada_b, *final_g;
  const float *s5_w_in, *s5_lam_re, *s5_lam_im, *s5_log_step, *s5_b_re, *s5_b_im, *s5_c_re, *s5_c_im;
  const float *s5_d, *s5_glu_w, *s5_glu_b, *s5_w_out;
  const float *pool_w_in, *pool_w, *pool_scale, *pool_w_out;
  const float *mla_w_in, *mla_q_norm, *mla_wq_b, *mla_kv_norm, *mla_wkv_b, *mla_w_out;
  float* out;
  char* ws;
};

constexpr size_t MiB = 1ull << 20;
constexpr size_t OFF_W = 0, OFF_A = 20 * MiB, OFF_B = 116 * MiB, OFF_C = 164 * MiB, OFF_M = 212 * MiB,
                 OFF_H = 228 * MiB;
constexpr size_t OFF_BAR = OFF_M + 512 * 1024;
constexpr size_t OFF_MOD = OFF_M, OFF_QAN = OFF_M + 1 * MiB, OFF_KB = OFF_M + 7 * MiB, OFF_VT = OFF_M + 12 * MiB;
constexpr size_t W_WIN = OFF_W, W_GLU = OFF_W + 8 * MiB, W_POOLW = OFF_W + 8 * MiB, W_WQ = OFF_W + 6 * MiB,
                 W_WUV = OFF_W + 8 * MiB, W_WOUT = OFF_W + 16 * MiB;
constexpr size_t A_QA = OFF_A + 72 * MiB, A_CKVF = OFF_A + 84 * MiB, A_KPEF = OFF_A + 90 * MiB;
constexpr size_t B_WST = OFF_B, B_WBIG = OFF_B + 16 * MiB;

constexpr int OUT_RE = 12582912, OUT_IM = 13631488, OUT_CKV = 14680064, OUT_KPE = 15728640;

#define NT_TOK 12288
#define LDS_BYTES 147456

__device__ __forceinline__ u16 f2bf(float f) {
  unsigned u = __float_as_uint(f);
  u += 0x7fffu + ((u >> 16) & 1u);
  return (u16)(u >> 16);
}
__device__ __forceinline__ float bf2f(u16 h) { return __uint_as_float(((unsigned)h) << 16); }
__device__ __forceinline__ float fsigmoid(float x) { return 1.f / (1.f + __expf(-x)); }
__device__ __forceinline__ float fsilu(float x) { return x * fsigmoid(x); }
__device__ __forceinline__ float fgelu(float x) {
  float y = 0.7978845608028654f * (x + 0.044715f * x * x * x);
  float t = 1.f - 2.f / (__expf(2.f * y) + 1.f);
  return 0.5f * x * (1.f + t);
}
__device__ __forceinline__ float2 cis_rev(double rev) {
  double f = rev - rint(rev);
  float ff = (float)f;
  return make_float2(__builtin_amdgcn_cosf(ff), __builtin_amdgcn_sinf(ff));
}
__device__ __forceinline__ float wave_sum(float v) {
#pragma unroll
  for (int o = 32; o > 0; o >>= 1) v += __shfl_xor(v, o);
  return v;
}
__device__ __forceinline__ int cond_of_row(int row) { return row < 8192 ? 0 : 1 + ((row - 8192) >> 11); }
__device__ __forceinline__ u16x4 pack4(f32x4 v) {
  u16x4 r;
  r[0] = f2bf(v[0]); r[1] = f2bf(v[1]); r[2] = f2bf(v[2]); r[3] = f2bf(v[3]);
  return r;
}

__device__ __forceinline__ size_t blkA(int row, int k, int KT) { return ((size_t)((row >> 8) * KT + (k >> 6)) * 256 + (row & 255)) * 64 + (k & 63); }
__device__ __forceinline__ size_t blkB(int n, int k, int KT) { return ((size_t)((n >> 7) * KT + (k >> 6)) * 128 + (n & 127)) * 64 + (k & 63); }
__device__ __forceinline__ size_t ugaddr(int tok, int ch) { return ((size_t)((ch >> 4) * 768 + (tok >> 4))) * 256 + (tok & 15) * 16 + (ch & 15); }
__device__ __forceinline__ size_t xaddr(int row, int g, int col) { return ((((size_t)g * 6 + (row >> 7)) * 4 + (col >> 6)) * 128 + (row & 127)) * 64 + (col & 63); }

#define WAIT_VM(n) asm volatile("s_waitcnt vmcnt(" #n ")" ::: "memory")
#define BARRIER()                        \
  do {                                   \
    asm volatile("" ::: "memory");       \
    __builtin_amdgcn_s_barrier();        \
    asm volatile("" ::: "memory");       \
  } while (0)

__device__ __forceinline__ void glds16(const void* g, char* l) {
  __builtin_amdgcn_global_load_lds((const unsigned*)g, (unsigned*)l, 16, 0, 0);
}

template <int WM, int WN, bool LINA, bool LINB, class AF, class BF>
__device__ __forceinline__ void gemm_loop(char* lds, int nk, AF af, BF bf, f32x4 (&acc)[4][4], int ksa = 64, int ksb = 64) {
  constexpr int BM = WM * 64, BN = WN * 64;
  constexpr int STG = (BM + BN) * 128;
  const int tid = threadIdx.x, lane = tid & 63, wid = tid >> 6;
  const int wr = wid / WN, wc = wid % WN, fr = lane & 15, fq = lane >> 4;
  const int srow = tid >> 3;
  const int skc = ((tid & 7) ^ (srow & 7)) * 8;
#pragma unroll
  for (int mi = 0; mi < 4; ++mi)
#pragma unroll
    for (int ni = 0; ni < 4; ++ni) acc[mi][ni] = f32x4{0.f, 0.f, 0.f, 0.f};

  const u16* pa[BM / 64];
  const u16* pb[BN / 64];
  if constexpr (LINA) {
#pragma unroll
    for (int i = 0; i < BM / 64; ++i) pa[i] = af(srow + i * 64, skc);
  }
  if constexpr (LINB) {
#pragma unroll
    for (int i = 0; i < BN / 64; ++i) pb[i] = bf(srow + i * 64, skc);
  }
  auto glds_one = [&](int i, int kt, char* base) {
    if (i < BM / 64)
      glds16(LINA ? pa[i] + kt * ksa : af(srow + i * 64, kt * 64 + skc), base + i * 8192);
    else
      glds16(LINB ? pb[i - BM / 64] + kt * ksb : bf(srow + (i - BM / 64) * 64, kt * 64 + skc),
             base + BM * 128 + (i - BM / 64) * 8192);
  };
  auto stage = [&](int kt, int buf) {
    char* base = lds + buf * STG + tid * 16;
#pragma unroll
    for (int i = 0; i < 6; ++i) glds_one(i, kt, base);
  };
  stage(0, 0);
  if (nk > 1) stage(1, 1);
  int cur = 0;
  for (int kt = 0; kt < nk; ++kt) {
    if (kt + 1 < nk) { WAIT_VM(6); } else { WAIT_VM(0); }
    BARRIER();
    const bool pf = kt + 2 < nk;
    char* nbase = lds + (cur >= 1 ? cur - 1 : 2) * STG + tid * 16;
    const char* sa = lds + cur * STG + (wr * 64 + fr) * 128;
    const char* sb = lds + cur * STG + BM * 128 + (wc * 64 + fr) * 128;
    const int off0 = ((0 + fq) ^ (fr & 7)) << 4, off1 = ((4 + fq) ^ (fr & 7)) << 4;
    bf16x8 a0[4], b0[4], a1[4], b1[4];
#pragma unroll
    for (int mi = 0; mi < 4; ++mi) a0[mi] = *(const bf16x8*)(sa + mi * 2048 + off0);
#pragma unroll
    for (int ni = 0; ni < 4; ++ni) b0[ni] = *(const bf16x8*)(sb + ni * 2048 + off0);
    __builtin_amdgcn_sched_barrier(0);
#pragma unroll
    for (int mi = 0; mi < 4; ++mi) {
#pragma unroll
      for (int ni = 0; ni < 4; ++ni)
        acc[mi][ni] = __builtin_amdgcn_mfma_f32_16x16x32_bf16(b0[ni], a0[mi], acc[mi][ni], 0, 0, 0);
      __builtin_amdgcn_sched_barrier(0);
      if (mi < 3) { if (pf) glds_one(mi, kt + 2, nbase); }
      else {
#pragma unroll
        for (int m2 = 0; m2 < 4; ++m2) a1[m2] = *(const bf16x8*)(sa + m2 * 2048 + off1);
#pragma unroll
        for (int n2 = 0; n2 < 4; ++n2) b1[n2] = *(const bf16x8*)(sb + n2 * 2048 + off1);
      }
      __builtin_amdgcn_sched_barrier(0);
    }
#pragma unroll
    for (int mi = 0; mi < 4; ++mi) {
#pragma unroll
      for (int ni = 0; ni < 4; ++ni)
        acc[mi][ni] = __builtin_amdgcn_mfma_f32_16x16x32_bf16(b1[ni], a1[mi], acc[mi][ni], 0, 0, 0);
      __builtin_amdgcn_sched_barrier(0);
      if (mi < 3) { if (pf) glds_one(3 + mi, kt + 2, nbase); }
      __builtin_amdgcn_sched_barrier(0);
    }
    cur = cur == 2 ? 0 : cur + 1;
  }
  BARRIER();
}

#define EPI_LOOP(WM_, WN_)                                                       \
  const int _lane = threadIdx.x & 63, _wid = threadIdx.x >> 6;                   \
  const int _wr = _wid / (WN_), _wc = _wid % (WN_), _fr = _lane & 15, _fq = _lane >> 4; \
  _Pragma("unroll") for (int mi = 0; mi < 4; ++mi) _Pragma("unroll") for (int ni = 0; ni < 4; ++ni)
#define EPI_ROW(m0) ((m0) + _wr * 64 + mi * 16 + _fr)
#define EPI_COL(n0) ((n0) + _wc * 64 + ni * 16 + _fq * 4)

__device__ __forceinline__ void ada_item(const Params& p, int item, char* lds) {
  const int tid = threadIdx.x;
  const int layer = item / 48, n0 = (item % 48) * 64;
  float* sc = (float*)lds;
  float* red = sc + 3072;
  for (int i = tid; i < 3072; i += 512) {
    int cond = i >> 10, k = i & 1023;
    float v = cond == 0 ? p.c_ctx[k] : p.c[(cond - 1) * 1024 + k];
    sc[i] = fsilu(v);
  }
  __syncthreads();
  const int cq = tid & 15, kg = tid >> 4;
  float a[3][4];
#pragma unroll
  for (int c = 0; c < 3; ++c)
#pragma unroll
    for (int e = 0; e < 4; ++e) a[c][e] = 0.f;
  const float* w = p.ada_w + (size_t)layer * 1024 * 3072 + (size_t)(kg * 32) * 3072 + n0 + cq * 4;
#pragma unroll 8
  for (int k = 0; k < 32; ++k) {
    float4 wv = *(const float4*)(w + (size_t)k * 3072);
#pragma unroll
    for (int c = 0; c < 3; ++c) {
      float s = sc[c * 1024 + kg * 32 + k];
      a[c][0] += s * wv.x; a[c][1] += s * wv.y; a[c][2] += s * wv.z; a[c][3] += s * wv.w;
    }
  }
#pragma unroll
  for (int c = 0; c < 3; ++c)
#pragma unroll
    for (int e = 0; e < 4; ++e) red[(kg * 3 + c) * 64 + cq * 4 + e] = a[c][e];
  __syncthreads();
  if (tid < 192) {
    int cond = tid >> 6, nn = tid & 63;
    float sum = 0.f;
#pragma unroll 8
    for (int g = 0; g < 32; ++g) sum += red[(g * 3 + cond) * 64 + nn];
    sum += p.ada_b[layer * 3072 + n0 + nn];
    ((float*)(p.ws + OFF_MOD))[(layer * 3 + cond) * 3072 + n0 + nn] = sum;
  }
  __syncthreads();
}

template <int KR>
__device__ __forceinline__ void conv_tile(const float* src, int ld, int k0, int n0, u16* dst, int ldd, int drow0, char* lds, int blkKT = 0) {
  float* t = (float*)lds;
  const int tid = threadIdx.x;
  float4 v[KR / 32];
#pragma unroll
  for (int i = 0; i < KR / 32; ++i) {
    int kk = (tid >> 4) + i * 32, n4 = (tid & 15) * 4;
    v[i] = *(const float4*)(src + (size_t)(k0 + kk) * ld + n0 + n4);
  }
#pragma unroll
  for (int i = 0; i < KR / 32; ++i) {
    int kk = (tid >> 4) + i * 32, n4 = (tid & 15) * 4;
    t[kk * 65 + n4 + 0] = v[i].x; t[kk * 65 + n4 + 1] = v[i].y; t[kk * 65 + n4 + 2] = v[i].z; t[kk * 65 + n4 + 3] = v[i].w;
  }
  __syncthreads();
#pragma unroll
  for (int r = 0; r < KR / 64; ++r) {
    int i = tid >> 3, kc = (tid & 7) * 8 + r * 64;
    u16x8 o;
#pragma unroll
    for (int q = 0; q < 8; ++q) o[q] = f2bf(t[(kc + q) * 65 + i]);
    if (blkKT) {
      const int n = drow0 + i;
      *(u16x8*)(dst + ((size_t)((n >> 7) * blkKT + ((k0 + kc) >> 6)) * 128 + (n & 127)) * 64 + (kc & 63)) = o;
    } else {
      *(u16x8*)(dst + (size_t)(drow0 + i) * ldd + k0 + kc) = o;
    }
  }
  __syncthreads();
}

__device__ __forceinline__ void conv_item(const Params& p, int layer, int it, char* lds) {
  const int kind = layer % 3, j = layer / 3;
  if (kind == 0) {
    if (it < 256) {
      int kt = it >> 6, nt = it & 63;
      conv_tile<256>(p.s5_w_in + (size_t)j * 1024 * 4096, 4096, kt * 256, nt * 64, (u16*)(p.ws + W_WIN), 1024, nt * 64, lds, 16);
    } else if (it < 512) {
      int t = it - 256, kt = t >> 5, nt = t & 31;
      conv_tile<256>(p.s5_glu_w + (size_t)j * 2048 * 2048, 2048, kt * 256, nt * 64, (u16*)(p.ws + W_GLU), 2048, nt * 64, lds, 32);
    } else {
      int t = it - 512, kt = t >> 4, nt = t & 15;
      conv_tile<256>(p.s5_w_out + (size_t)j * 2048 * 1024, 1024, kt * 256, nt * 64, (u16*)(p.ws + W_WOUT), 2048, nt * 64, lds, 32);
    }
  } else if (kind == 1) {
    if (it < 256) {
      int kt = it >> 6, nt = it & 63;
      conv_tile<256>(p.pool_w_in + (size_t)j * 1024 * 4096, 4096, kt * 256, nt * 64, (u16*)(p.ws + W_WIN), 1024, nt * 64, lds, 16);
    } else if (it < 320) {
      int t = it - 256, g = t >> 4, r = t & 15, kt = r >> 3, nt = r & 7;
      conv_tile<256>(p.pool_w + ((size_t)j * 4 + g) * 512 * 512, 512, kt * 256, nt * 64, (u16*)(p.ws + W_POOLW), 512,
                g * 512 + nt * 64, lds, 8);
    } else {
      int t = it - 320, kt = t >> 4, nt = t & 15;
      conv_tile<256>(p.pool_w_out + (size_t)j * 2048 * 1024, 1024, kt * 256, nt * 64, (u16*)(p.ws + W_WOUT), 2048, nt * 64, lds, 32);
    }
  } else {
    if (it < 156) {
      int kt = it / 39, nt = it % 39;
      conv_tile<256>(p.mla_w_in + (size_t)j * 1024 * 2496, 2496, kt * 256, nt * 64, (u16*)(p.ws + W_WIN), 1024, nt * 64, lds, 16);
    } else if (it < 172) {
      int h = it - 156, nt = h * 3 + 2;
      conv_tile<256>(p.mla_wq_b + (size_t)j * 256 * 3072, 3072, 0, nt * 64, (u16*)(p.ws + W_WQ), 256, nt * 64, lds, 4);
    } else if (it < 204) {
      int q = it - 172, h = q >> 1, half = q & 1, nt = h * 4 + 2 + half;
      conv_tile<128>(p.mla_wkv_b + (size_t)j * 128 * 4096, 4096, 0, nt * 64, (u16*)(p.ws + W_WUV), 128,
                h * 128 + half * 64, lds, 2);
    } else {
      int t = it - 204, kt = t >> 4, nt = t & 15;
      conv_tile<256>(p.mla_w_out + (size_t)j * 2048 * 1024, 1024, kt * 256, nt * 64, (u16*)(p.ws + W_WOUT), 2048, nt * 64, lds, 32);
    }
  }
}
__device__ __forceinline__ int conv_count(int layer) {
  const int kind = layer % 3;
  return kind == 0 ? 640 : (kind == 1 ? 448 : 332);
}

__device__ __forceinline__ const float* x_row(const Params& p, int layer, int row) {
  if (layer == 0) return row < 8192 ? p.x_prompt + (size_t)row * 1024 : p.x_sample + (size_t)(row - 8192) * 1024;
  return p.out + (size_t)row * 1024;
}

__device__ __forceinline__ void norm_item(const Params& p, int layer, int item, char* lds) {
  const int tid = threadIdx.x, lane = tid & 63, wid = tid >> 6;
  float* ma = (float*)lds;
  float* mb = ma + 1024;
  const int row0 = item * 32;
  const int cond = cond_of_row(row0);
  const float* mod = (const float*)(p.ws + OFF_MOD) + (size_t)(layer * 3 + cond) * 3072;
  for (int i = tid; i < 1024; i += 512) {
    ma[i] = p.norm_g[layer * 1024 + i] * (1.f + mod[1024 + i]);
    mb[i] = mod[i];
  }
  __syncthreads();
  u16* h = (u16*)(p.ws + OFF_H);
#pragma unroll 1
  for (int i = 0; i < 4; ++i) {
    const int row = row0 + wid * 4 + i;
    const float* x = x_row(p, layer, row);
    float4 v[4];
    float ss = 0.f;
#pragma unroll
    for (int q = 0; q < 4; ++q) {
      v[q] = *(const float4*)(x + q * 256 + lane * 4);
      ss += v[q].x * v[q].x + v[q].y * v[q].y + v[q].z * v[q].z + v[q].w * v[q].w;
    }
    ss = wave_sum(ss);
    const float rstd = rsqrtf(ss * (1.f / 1024.f) + 1e-6f);
#pragma unroll
    for (int q = 0; q < 4; ++q) {
      const int c = q * 256 + lane * 4;
      float4 a = *(const float4*)(ma + c), b = *(const float4*)(mb + c);
      u16x4 o;
      o[0] = f2bf(v[q].x * rstd * a.x + b.x);
      o[1] = f2bf(v[q].y * rstd * a.y + b.y);
      o[2] = f2bf(v[q].z * rstd * a.z + b.z);
      o[3] = f2bf(v[q].w * rstd * a.w + b.w);
      *(u16x4*)(h + ((size_t)((row >> 8) * 16 + (c >> 6)) * 256 + (row & 255)) * 64 + (c & 63)) = o;
    }
  }
  __syncthreads();
}

__device__ __forceinline__ void derive_item(const Params& p, int j, int g, char* lds) {
  const int tid = threadIdx.x;
  float2* pw = (float2*)lds;
  float2* bb = pw + 2 * 17 * 64;
  float2* cc = bb + 2 * 64 * 16;
  float* kt = (float*)(cc + 2 * 16 * 64);
  for (int i = tid; i < 2 * 17 * 64; i += 512) {
    int pp = i & 63, k = (i >> 6) % 17, dir = i / (17 * 64);
    int li = ((j * 2 + dir) * 128 + g) * 64 + pp;
    float lr = p.s5_lam_re[li], lim = p.s5_lam_im[li];
    float st = __expf(p.s5_log_step[(j * 2 + dir) * 128 + g]);
    float mag = __expf((float)k * lr * st);
    float2 cs = cis_rev((double)k * (double)lim * (double)st * 0.15915494309189535);
    pw[i] = make_float2(mag * cs.x, mag * cs.y);
  }
  for (int i = tid; i < 2 * 16 * 64; i += 512) {
    int pp = i & 63, c = (i >> 6) & 15, dir = i >> 10;
    size_t ci = ((size_t)((j * 2 + dir) * 128 + g) * 16 + c) * 64 + pp;
    cc[i] = make_float2(p.s5_c_re[ci], p.s5_c_im[ci]);
  }
  __syncthreads();
  for (int i = tid; i < 2 * 64 * 16; i += 512) {
    int c = i & 15, pp = (i >> 4) & 63, dir = i >> 10;
    int li = ((j * 2 + dir) * 128 + g) * 64 + pp;
    float lr = p.s5_lam_re[li], lim = p.s5_lam_im[li];
    float2 lb = pw[(dir * 17 + 1) * 64 + pp];
    float nr = lb.x - 1.f, ni = lb.y;
    float den = 1.f / (lr * lr + lim * lim);
    float cr = (nr * lr + ni * lim) * den, ci = (ni * lr - nr * lim) * den;
    size_t bi = ((size_t)li) * 16 + c;
    float br = p.s5_b_re[bi], bim = p.s5_b_im[bi];
    bb[i] = make_float2(cr * br - ci * bim, cr * bim + ci * br);
  }
  __syncthreads();
  for (int o = tid; o < 8192; o += 512) {
    int c2 = o & 15, c = (o >> 4) & 15, lag = (o >> 8) & 15, dir = o >> 12;
    float acc = 0.f;
    for (int pp = 0; pp < 64; ++pp) {
      float2 C = cc[(dir * 16 + c) * 64 + pp], P = pw[(dir * 17 + lag) * 64 + pp], B = bb[(dir * 64 + pp) * 16 + c2];
      float cpx = C.x * P.x - C.y * P.y, cpy = C.x * P.y + C.y * P.x;
      acc += cpx * B.x - cpy * B.y;
    }
    kt[o] = acc;
  }
  __syncthreads();
  u16* wbig = (u16*)(p.ws + B_WBIG) + (size_t)g * 256 * 512;
  for (int q = tid; q < 256 * 64; q += 512) {
    int o = q >> 6, k0 = (q & 63) * 8;
    int t = o >> 4, c = o & 15;
    u16x8 v;
    if (k0 < 256) {
      int s = k0 >> 4, c20 = k0 & 15;
      float dsk = p.s5_d[j * 2048 + g * 16 + c];
#pragma unroll
      for (int e = 0; e < 8; ++e) {
        int c2 = c20 + e;
        float val = 0.f;
        if (s <= t) val += kt[((0 * 16 + (t - s)) * 16 + c) * 16 + c2];
        if (s >= t) val += kt[((1 * 16 + (s - t)) * 16 + c) * 16 + c2];
        if (s == t && c2 == c) val += dsk;
        v[e] = f2bf(val);
      }
    } else {
      int dir = k0 >= 384 ? 1 : 0;
      int kk = k0 - 256 - dir * 128;
      int ri = kk >> 6, p0 = kk & 63;
      int e_pow = dir == 0 ? t + 1 : 16 - t;
#pragma unroll
      for (int e = 0; e < 8; ++e) {
        int pp = p0 + e;
        float2 C = cc[(dir * 16 + c) * 64 + pp], P = pw[(dir * 17 + e_pow) * 64 + pp];
        float val = ri == 0 ? (C.x * P.x - C.y * P.y) : -(C.x * P.y + C.y * P.x);
        v[e] = f2bf(val);
      }
    }
    *(u16x8*)(wbig + blkB(o, k0, 8)) = v;
  }
  u16* wst = (u16*)(p.ws + B_WST) + (size_t)g * 256 * 256;
  for (int q = tid; q < 256 * 32; q += 512) {
    int o = q >> 5, k0 = (q & 31) * 8;
    int dir = o >> 7, ri = (o >> 6) & 1, pp = o & 63;
    int s = k0 >> 4, c20 = k0 & 15;
    int e_pow = dir == 0 ? 15 - s : s;
    float2 P = pw[(dir * 17 + e_pow) * 64 + pp];
    u16x8 v;
#pragma unroll
    for (int e = 0; e < 8; ++e) {
      float2 B = bb[(dir * 64 + pp) * 16 + c20 + e];
      float val = ri == 0 ? (P.x * B.x - P.y * B.y) : (P.x * B.y + P.y * B.x);
      v[e] = f2bf(val);
    }
    *(u16x8*)(wst + blkB(o, k0, 4)) = v;
  }
  __syncthreads();
}

__device__ __forceinline__ void wqabs_item(const Params& p, int item, char* lds) {
  const int tid = threadIdx.x;
  const int h = item >> 3, l0 = (item & 7) * 16;
  float* bs = (float*)lds;
  {
    int li = tid >> 5, d4 = (tid & 31) * 4;
    *(float4*)(bs + li * 128 + d4) = *(const float4*)(p.mla_wkv_b + (size_t)(l0 + li) * 4096 + h * 256 + d4);
  }
  __syncthreads();
  const int r = tid & 255, lh = tid >> 8;
  float acc[8];
#pragma unroll
  for (int i = 0; i < 8; ++i) acc[i] = 0.f;
  const float* arow = p.mla_wq_b + (size_t)r * 3072 + h * 192;
  for (int d4 = 0; d4 < 32; ++d4) {
    float4 a = *(const float4*)(arow + d4 * 4);
#pragma unroll
    for (int i = 0; i < 8; ++i) {
      float4 b = *(const float4*)(bs + (lh * 8 + i) * 128 + d4 * 4);
      acc[i] += a.x * b.x + a.y * b.y + a.z * b.z + a.w * b.w;
    }
  }
  u16* wq = (u16*)(p.ws + W_WQ);
#pragma unroll
  for (int i = 0; i < 8; ++i) wq[blkB(h * 192 + l0 + lh * 8 + i, r, 4)] = f2bf(acc[i]);
  __syncthreads();
}

__device__ __forceinline__ void ph_prep(const Params& p, int layer, bool with_ada, bool with_norm, char* lds, int bid, int nb) {
  const int kind = layer % 3, j = layer / 3;
  const int n_special = (kind == 0 || kind == 2) ? 128 : 0;
  const int n_ada = with_ada ? 192 : 0;
  const int n_conv = conv_count(layer);
  const int n_norm = with_norm ? 384 : 0;
  const int total = n_special + n_ada + n_conv + n_norm;
  for (int it = bid; it < total; it += nb) {
    int t = it;
    if (t < n_special) {
      if (kind == 0) derive_item(p, j, t, lds); else wqabs_item(p, t, lds);
      continue;
    }
    t -= n_special;
    if (t < n_ada) { ada_item(p, t, lds); continue; }
    t -= n_ada;
    if (t < n_norm) { norm_item(p, layer, t, lds); continue; }
    t -= n_norm;
    conv_item(p, layer, t, lds);
  }
}
__device__ __forceinline__ void ph_norm(const Params& p, int layer, char* lds, int bid, int nb) {
  for (int it = bid; it < 384; it += nb) norm_item(p, layer, it, lds);
}

__device__ __forceinline__ void tile_mn(int t, int MT, int NT, int& mt, int& nt) {
  int per = 8 * NT;
  int grp = t / per, r = t % per;
  int gm = MT - grp * 8; gm = gm > 8 ? 8 : gm;
  mt = grp * 8 + r % gm; nt = r / gm;
}

__device__ __forceinline__ void ph_inproj(const Params& p, char* lds, int bid, int nb) {
  const u16* h = (const u16*)(p.ws + OFF_H);
  const u16* w = (const u16*)(p.ws + W_WIN);
  u16* uz = (u16*)(p.ws + OFF_A);
  for (int l = (bid >> 3); l < 48 * 4; l += (nb >> 3)) {
    const int mt = l / 4, nt = (bid & 7) * 4 + l % 4;
    const int m0 = mt * 256, n0 = nt * 128;
    f32x4 acc[4][4];
    gemm_loop<4, 2, true, true>(lds, 16,
        [&](int r, int k) { return h + ((size_t)(mt * 16) * 256 + r) * 64 + k; },
        [&](int r, int k) { return w + ((size_t)(nt * 16) * 128 + r) * 64 + k; }, acc, 256 * 64, 128 * 64);
    EPI_LOOP(4, 2) {
      const int row = EPI_ROW(m0), col = EPI_COL(n0);
      f32x4 v = acc[mi][ni];
      if (col >= 2048) {
        v[0] = fsilu(v[0]); v[1] = fsilu(v[1]); v[2] = fsilu(v[2]); v[3] = fsilu(v[3]);
        *(u16x4*)(uz + (size_t)NT_TOK * 2048 + (size_t)row * 2048 + (col - 2048)) = pack4(v);
      } else {
        *(u16x4*)(uz + ugaddr(row, col)) = pack4(v);
      }
    }
  }
}

__device__ __forceinline__ void ph_s5g1(const Params& p, char* lds, int bid, int nb) {
  const u16* uz = (const u16*)(p.ws + OFF_A);
  u16* X = (u16*)(p.ws + OFF_C);
  for (int t = bid; t < 768; t += nb) {
    const int g = t / 6, mt = (t % 6) >> 1, nt = t & 1;
    const int m0 = mt * 256, n0 = nt * 128;
    const u16* w = (const u16*)(p.ws + B_WST) + (size_t)g * 65536;
    f32x4 acc[4][4];
    gemm_loop<4, 2, true, true>(lds, 4,
        [&](int r, int k) { return uz + ((size_t)(g * 768 + m0 + r)) * 256 + k; },
        [&](int r, int k) { return w + ((size_t)(nt * 4) * 128 + r) * 64 + k; }, acc, 64, 128 * 64);
    EPI_LOOP(4, 2) {
      const int row = EPI_ROW(m0), col = EPI_COL(n0);
      *(u16x4*)(X + xaddr(row, g, col)) = pack4(acc[mi][ni]);
    }
  }
}

__device__ __forceinline__ void ph_scan(const Params& p, int j, int bid, int nb) {
  const int tid = threadIdx.x;
  u16* X = (u16*)(p.ws + OFF_C);
  for (int it = bid; it < 1088; it += nb) {
    int b, gq, r0, nc; bool sample;
    if (it < 64) { sample = true; b = it >> 5; gq = it & 31; r0 = 512 + b * 128; nc = 128; }
    else { int q = it - 64; sample = false; b = q >> 5; gq = q & 31; r0 = b * 16; nc = 16; }
    const int g = gq * 4 + (tid >> 7), dir = (tid >> 6) & 1, pp = tid & 63;
    const int li = ((j * 2 + dir) * 128 + g) * 64 + pp;
    const float lr = p.s5_lam_re[li], lim = p.s5_lam_im[li];
    const float st = __expf(p.s5_log_step[(j * 2 + dir) * 128 + g]);
    const float mag = __expf(16.f * lr * st);
    const float2 cs = cis_rev(16.0 * (double)lim * (double)st * 0.15915494309189535);
    const float ar = mag * cs.x, ai = mag * cs.y;
    float pr = 0.f, pi = 0.f;
    if (sample) {
      size_t si = ((size_t)((b * 2 + j) * 2 + dir) * 128 + g) * 64 + pp;
      pr = p.st_re[si]; pi = p.st_im[si];
    }
    u16* base = X + xaddr(r0, g, dir * 128 + pp);
    const size_t cstride = 64;
    if (dir == 0) {
#pragma unroll 8
      for (int c = 0; c < nc; ++c) {
        u16* q = base + (size_t)c * cstride;
        float sr = bf2f(q[0]), si = bf2f(q[8192]);
        q[0] = f2bf(pr); q[8192] = f2bf(pi);
        float nr = ar * pr - ai * pi + sr, ni = ar * pi + ai * pr + si;
        pr = nr; pi = ni;
      }
    } else {
#pragma unroll 8
      for (int c = nc - 1; c >= 0; --c) {
        u16* q = base + (size_t)c * cstride;
        float sr = bf2f(q[0]), si = bf2f(q[8192]);
        q[0] = f2bf(pr); q[8192] = f2bf(pi);
        float nr = ar * pr - ai * pi + sr, ni = ar * pi + ai * pr + si;
        pr = nr; pi = ni;
      }
    }
    if (!sample) {
      size_t oi = ((size_t)((b * 2 + j) * 2 + dir) * 128 + g) * 64 + pp;
      p.out[OUT_RE + oi] = pr;
      p.out[OUT_IM + oi] = pi;
    }
  }
}

__device__ __forceinline__ void ph_s5g3(const Params& p, char* lds, int bid, int nb) {
  u16* uz = (u16*)(p.ws + OFF_A);
  const u16* X = (const u16*)(p.ws + OFF_C);
  for (int t = bid; t < 768; t += nb) {
    const int g = t / 6, mt = t % 6;
    const int m0 = mt * 128;
    const u16* w = (const u16*)(p.ws + B_WBIG) + (size_t)g * 131072;
    f32x4 acc[4][4];
    gemm_loop<2, 4, false, true>(lds, 8,
        [&](int r, int k) {
          return k < 256 ? (const u16*)(uz + ((size_t)(g * 768 + m0 + r)) * 256 + k)
                         : X + xaddr(m0 + r, g, k - 256);
        },
        [&](int r, int k) { return w + ((size_t)((r >> 7) * 8) * 128 + (r & 127)) * 64 + k; }, acc, 64, 128 * 64);
    EPI_LOOP(2, 4) {
      const int row = EPI_ROW(m0), col = EPI_COL(0);
      f32x4 v = acc[mi][ni];
      v[0] = fgelu(v[0]); v[1] = fgelu(v[1]); v[2] = fgelu(v[2]); v[3] = fgelu(v[3]);
      *(u16x4*)(uz + ((size_t)(g * 768 + row)) * 256 + col) = pack4(v);
    }
  }
}

__device__ __forceinline__ void ph_glu(const Params& p, int j, char* lds, int bid, int nb) {
  const u16* uz = (const u16*)(p.ws + OFF_A);
  const u16* w = (const u16*)(p.ws + W_GLU);
  u16* m = (u16*)(p.ws + OFF_C);
  for (int l = (bid >> 3); l < 48 * 2; l += (nb >> 3)) {
    const int mt = l / 2, nt = (bid & 7) * 2 + l % 2;
    const int m0 = mt * 256, n0 = nt * 128;
    f32x4 acc[4][4];
    gemm_loop<4, 2, true, true>(lds, 32,
        [&](int r, int k) { return uz + ugaddr(m0 + r, k); },
        [&](int r, int k) { return w + ((size_t)(nt * 32) * 128 + r) * 64 + k; }, acc, 4 * 768 * 256, 128 * 64);
    EPI_LOOP(4, 2) {
      const int row = EPI_ROW(m0), col = EPI_COL(n0);
      f32x4 v = acc[mi][ni];
      float4 gb = *(const float4*)(p.s5_glu_b + j * 2048 + col);
      u16x4 yv = *(const u16x4*)(uz + ugaddr(row, col));
      u16x4 zv = *(const u16x4*)(uz + (size_t)NT_TOK * 2048 + (size_t)row * 2048 + col);
      f32x4 o;
      o[0] = bf2f(yv[0]) * fsigmoid(v[0] + gb.x) * bf2f(zv[0]);
      o[1] = bf2f(yv[1]) * fsigmoid(v[1] + gb.y) * bf2f(zv[1]);
      o[2] = bf2f(yv[2]) * fsigmoid(v[2] + gb.z) * bf2f(zv[2]);
      o[3] = bf2f(yv[3]) * fsigmoid(v[3] + gb.w) * bf2f(zv[3]);
      *(u16x4*)(m + blkA(row, col, 32)) = pack4(o);
    }
  }
}

__device__ __forceinline__ void ph_out(const Params& p, int layer, const u16* m, char* lds, int bid, int nb) {
  const u16* w = (const u16*)(p.ws + W_WOUT);
  const float* mod = (const float*)(p.ws + OFF_MOD);
  for (int l = (bid >> 3); l < 48 * 1; l += (nb >> 3)) {
    const int mt = l / 1, nt = (bid & 7) * 1 + l % 1;
    const int m0 = mt * 256, n0 = nt * 128;
    f32x4 acc[4][4];
    gemm_loop<4, 2, true, true>(lds, 32,
        [&](int r, int k) { return m + ((size_t)(mt * 32) * 256 + r) * 64 + k; },
        [&](int r, int k) { return w + ((size_t)(nt * 32) * 128 + r) * 64 + k; }, acc, 256 * 64, 128 * 64);
    const int cond = cond_of_row(m0);
    const float* gate = mod + (size_t)(layer * 3 + cond) * 3072 + 2048;
    EPI_LOOP(4, 2) {
      const int row = EPI_ROW(m0), col = EPI_COL(n0);
      f32x4 v = acc[mi][ni];
      float4 gt = *(const float4*)(gate + col);
      float4 xo = *(const float4*)(x_row(p, layer, row) + col);
      float4 o;
      o.x = xo.x + gt.x * v[0]; o.y = xo.y + gt.y * v[1]; o.z = xo.z + gt.z * v[2]; o.w = xo.w + gt.w * v[3];
      *(float4*)(p.out + (size_t)row * 1024 + col) = o;
    }
  }
}

__device__ __forceinline__ void ph_pool(const Params& p, int bid, int nb) {
  const u16* uz = (const u16*)(p.ws + OFF_A);
  u16* pb = (u16*)(p.ws + OFF_B);
  for (int idx = bid * 512 + threadIdx.x; idx < NT_TOK * 256; idx += nb * 512) {
    const int tok = idx >> 8, ch0 = (idx & 255) * 8;
    const int gi = ch0 >> 9, win = 2 << gi, lo = win >> 1;
    int t, L, base;
    if (tok < 8192) { L = 256; t = tok & 255; base = tok - t; }
    else { L = 2048; t = (tok - 8192) & 2047; base = tok - t; }
    int s0 = t - lo; if (s0 < 0) s0 = 0;
    int s1 = t - lo + win; if (s1 > L) s1 = L;
    float acc[8];
#pragma unroll
    for (int e = 0; e < 8; ++e) acc[e] = 0.f;
    for (int s = s0; s < s1; ++s) {
      u16x8 v = *(const u16x8*)(uz + ugaddr(base + s, ch0));
#pragma unroll
      for (int e = 0; e < 8; ++e) acc[e] += bf2f(v[e]);
    }
    const float inv = 1.f / (float)(s1 - s0);
    u16x8 self = *(const u16x8*)(uz + ugaddr(tok, ch0));
    u16x8 o;
#pragma unroll
    for (int e = 0; e < 8; ++e) o[e] = f2bf(acc[e] * inv - bf2f(self[e]));
    *(u16x8*)(pb + blkA(tok, ch0, 32)) = o;
  }
}

__device__ __forceinline__ void ph_poolmm(const Params& p, int j, char* lds, int bid, int nb) {
  const u16* pb = (const u16*)(p.ws + OFF_B);
  const u16* w = (const u16*)(p.ws + W_POOLW);
  const u16* uz = (const u16*)(p.ws + OFF_A);
  u16* m = (u16*)(p.ws + OFF_C);
  for (int l = (bid >> 3); l < 48 * 2; l += (nb >> 3)) {
    const int mt = l / 2, nt = (bid & 7) * 2 + l % 2;
    const int m0 = mt * 256, n0 = nt * 128, gi = n0 >> 9;
    f32x4 acc[4][4];
    gemm_loop<4, 2, true, true>(lds, 8,
        [&](int r, int k) { return pb + ((size_t)(mt * 32 + gi * 8) * 256 + r) * 64 + k; },
        [&](int r, int k) { return w + ((size_t)(nt * 8) * 128 + r) * 64 + k; }, acc, 256 * 64, 128 * 64);
    EPI_LOOP(4, 2) {
      const int row = EPI_ROW(m0), col = EPI_COL(n0);
      f32x4 v = acc[mi][ni];
      float4 sc = *(const float4*)(p.pool_scale + j * 2048 + col);
      u16x4 zv = *(const u16x4*)(uz + (size_t)NT_TOK * 2048 + (size_t)row * 2048 + col);
      f32x4 o;
      o[0] = v[0] * sc.x * bf2f(zv[0]); o[1] = v[1] * sc.y * bf2f(zv[1]);
      o[2] = v[2] * sc.z * bf2f(zv[2]); o[3] = v[3] * sc.w * bf2f(zv[3]);
      *(u16x4*)(m + blkA(row, col, 32)) = pack4(o);
    }
  }
}

__device__ __forceinline__ void ph_inproj_mla(const Params& p, char* lds, int bid, int nb) {
  const u16* h = (const u16*)(p.ws + OFF_H);
  const u16* w = (const u16*)(p.ws + W_WIN);
  float* qa = (float*)(p.ws + A_QA);
  float* ckvf = (float*)(p.ws + A_CKVF);
  float* kpef = (float*)(p.ws + A_KPEF);
  u16* zb = (u16*)(p.ws + OFF_B);
  for (int t = bid; t < 48 * 20; t += nb) {
    int mt, nt; tile_mn(t, 48, 20, mt, nt);
    const int m0 = mt * 256, n0 = nt * 128;
    f32x4 acc[4][4];
    gemm_loop<4, 2, true, true>(lds, 16,
        [&](int r, int k) { return h + ((size_t)(mt * 16) * 256 + r) * 64 + k; },
        [&](int r, int k) { int n = n0 + r; n = n > 2495 ? 2495 : n; return w + ((size_t)((n >> 7) * 16) * 128 + (n & 127)) * 64 + k; }, acc, 256 * 64, 128 * 64);
    EPI_LOOP(4, 2) {
      const int row = EPI_ROW(m0), col = EPI_COL(n0);
      f32x4 v = acc[mi][ni];
      if (col < 256) {
        *(f32x4*)(qa + (size_t)row * 256 + col) = v;
      } else if (col < 384) {
        *(f32x4*)(ckvf + (size_t)row * 128 + (col - 256)) = v;
      } else if (col < 448) {
        *(f32x4*)(kpef + (size_t)row * 64 + (col - 384)) = v;
      } else if (col < 2496) {
        v[0] = fsilu(v[0]); v[1] = fsilu(v[1]); v[2] = fsilu(v[2]); v[3] = fsilu(v[3]);
        *(u16x4*)(zb + (size_t)row * 2048 + (col - 448)) = pack4(v);
      }
    }
  }
}

__device__ __forceinline__ int vt_slot(int pos) {
  int k = pos & 31;
  return (pos & ~31) | (((k >> 2) & 3) * 8 + (k >> 4) * 4 + (k & 3));
}

__device__ __forceinline__ void ph_mlanorm(const Params& p, int j, char* lds, int bid, int nb) {
  const int tid = threadIdx.x, lane = tid & 63, wid = tid >> 6;
  const float* qa = (const float*)(p.ws + A_QA);
  const float* ckvf = (const float*)(p.ws + A_CKVF);
  const float* kpef = (const float*)(p.ws + A_KPEF);
  u16* qan = (u16*)(p.ws + OFF_QAN);
  u16* Kb = (u16*)(p.ws + OFF_KB);
  u16* VT = (u16*)(p.ws + OFF_VT);
  u16* tile = (u16*)lds;
  for (int it = bid; it < 208; it += nb) {
    const bool cache = it >= 192;
    int kvrow0, pos0, Lk; size_t vtbase;
    int tok0 = 0, cb = 0, ci0 = 0;
    bool sample = false;
    if (!cache) {
      tok0 = it * 64;
      if (tok0 < 8192) { int b = tok0 >> 8; pos0 = tok0 & 255; kvrow0 = tok0; Lk = 256; vtbase = (size_t)b * 128 * 256; }
      else { sample = true; int b = (tok0 - 8192) >> 11; int t0 = (tok0 - 8192) & 2047; pos0 = 512 + t0;
             kvrow0 = 8192 + b * 2560 + pos0; Lk = 2560; vtbase = (size_t)32 * 128 * 256 + (size_t)b * 128 * 2560; }
    } else {
      int q = it - 192; cb = q >> 3; ci0 = (q & 7) * 64; pos0 = ci0;
      kvrow0 = 8192 + cb * 2560 + pos0; Lk = 2560; vtbase = (size_t)32 * 128 * 256 + (size_t)cb * 128 * 2560;
    }
#pragma unroll 1
    for (int i = 0; i < 8; ++i) {
      const int rl = wid * 8 + i;
      float c0, c1, kp;
      if (!cache) {
        const int tok = tok0 + rl;
        float4 qv = *(const float4*)(qa + (size_t)tok * 256 + lane * 4);
        float ss = wave_sum(qv.x * qv.x + qv.y * qv.y + qv.z * qv.z + qv.w * qv.w);
        float rs = rsqrtf(ss * (1.f / 256.f) + 1e-6f);
        float4 qg = *(const float4*)(p.mla_q_norm + j * 256 + lane * 4);
        u16x4 qo;
        qo[0] = f2bf(qv.x * rs * qg.x); qo[1] = f2bf(qv.y * rs * qg.y);
        qo[2] = f2bf(qv.z * rs * qg.z); qo[3] = f2bf(qv.w * rs * qg.w);
        *(u16x4*)(qan + blkA(tok, lane * 4, 4)) = qo;
        float2 cv = *(const float2*)(ckvf + (size_t)tok * 128 + lane * 2);
        float s2 = wave_sum(cv.x * cv.x + cv.y * cv.y);
        float r2 = rsqrtf(s2 * (1.f / 128.f) + 1e-6f);
        float2 kg = *(const float2*)(p.mla_kv_norm + j * 128 + lane * 2);
        c0 = cv.x * r2 * kg.x; c1 = cv.y * r2 * kg.y;
        float x = kpef[(size_t)tok * 64 + lane];
        if (!sample) {
          *(float2*)(p.out + OUT_CKV + (size_t)tok * 128 + lane * 2) = make_float2(c0, c1);
          p.out[OUT_KPE + (size_t)tok * 64 + lane] = x;
          kp = x;
        } else {
          const int tpos = (tok - 8192) & 2047;
          const int axis = lane >> 5, within = lane & 31, fi = within & 15, isx2 = within >> 4;
          float xp = __shfl_xor(x, 16);
          float posf = (float)(axis == 0 ? (tpos >> 6) : (tpos & 63));
          float inv = __builtin_amdgcn_exp2f(-(float)fi * 0.830482023721841f);
          float rev = posf * inv * 0.15915494309189535f;
          rev -= rintf(rev);
          float cs = __builtin_amdgcn_cosf(rev), sn = __builtin_amdgcn_sinf(rev);
          float x1 = isx2 ? xp : x, x2 = isx2 ? x : xp;
          kp = isx2 ? (x1 * sn + x2 * cs) : (x1 * cs - x2 * sn);
        }
      } else {
        const size_t ci = (size_t)(cb * 1 + j) * 512 + ci0 + rl;
        float2 cv = *(const float2*)(p.cache_ckv + ci * 128 + lane * 2);
        c0 = cv.x; c1 = cv.y;
        kp = p.cache_kpe[ci * 64 + lane];
      }
      const size_t kr = (size_t)(kvrow0 + rl);
      unsigned pk = (unsigned)f2bf(c0) | ((unsigned)f2bf(c1) << 16);
      *(unsigned*)(Kb + kr * 192 + lane * 2) = pk;
      Kb[kr * 192 + 128 + lane] = f2bf(kp);
      *(unsigned*)(tile + rl * 136 + lane * 2) = pk;
    }
    __syncthreads();
    {
      const int d = tid >> 2, part = tid & 3;
      u16x8 o0, o1;
#pragma unroll
      for (int e = 0; e < 16; ++e) {
        int s = part * 16 + e;
        int blk = s >> 5, sl = s & 31;
        int kgq = sl >> 3, sub = (sl >> 2) & 1, jj = sl & 3;
        int kap = sub * 16 + kgq * 4 + jj;
        u16 v = tile[(blk * 32 + kap) * 136 + d];
        if (e < 8) o0[e] = v; else o1[e - 8] = v;
      }
      u16* dst = VT + vtbase + ((size_t)(pos0 >> 6) * 128 + d) * 64 + part * 16;
      *(u16x8*)(dst) = o0;
      *(u16x8*)(dst + 8) = o1;
    }
    __syncthreads();
  }
}

__device__ __forceinline__ void ph_qgemm(const Params& p, char* lds, int bid, int nb) {
  const u16* qan = (const u16*)(p.ws + OFF_QAN);
  const u16* w = (const u16*)(p.ws + W_WQ);
  u16* q = (u16*)(p.ws + OFF_A);
  const float SC = 0.07216878364870322f * 1.4426950408889634f;
  for (int l = (bid >> 3); l < 48 * 3; l += (nb >> 3)) {
    const int mt = l / 3, nt = (bid & 7) * 3 + l % 3;
    const int m0 = mt * 256, n0 = nt * 128;
    f32x4 acc[4][4];
    gemm_loop<4, 2, true, true>(lds, 4,
        [&](int r, int k) { return qan + ((size_t)(mt * 4) * 256 + r) * 64 + k; },
        [&](int r, int k) { return w + ((size_t)(nt * 4) * 128 + r) * 64 + k; }, acc, 256 * 64, 128 * 64);
    const int lane = threadIdx.x & 63, wid = threadIdx.x >> 6;
    const int wr = wid >> 1, wc = wid & 1, fr = lane & 15, fq = lane >> 4;
    const int cb = n0 + wc * 64;
    const bool rope = (m0 >= 8192) && ((cb % 192) == 128);
#pragma unroll
    for (int mi = 0; mi < 4; ++mi) {
      const int row = m0 + wr * 64 + mi * 16 + fr;
      f32x4 v[4];
#pragma unroll
      for (int ni = 0; ni < 4; ++ni) v[ni] = acc[mi][ni];
      if (rope) {
        const int tpos = (row - 8192) & 2047;
#pragma unroll
        for (int ax = 0; ax < 2; ++ax) {
          const float posf = (float)(ax == 0 ? (tpos >> 6) : (tpos & 63));
#pragma unroll
          for (int jj = 0; jj < 4; ++jj) {
            const int fi = fq * 4 + jj;
            float inv = __builtin_amdgcn_exp2f(-(float)fi * 0.830482023721841f);
            float rev = posf * inv * 0.15915494309189535f;
            rev -= rintf(rev);
            float cs = __builtin_amdgcn_cosf(rev), sn = __builtin_amdgcn_sinf(rev);
            float x1 = v[ax * 2][jj], x2 = v[ax * 2 + 1][jj];
            v[ax * 2][jj] = x1 * cs - x2 * sn;
            v[ax * 2 + 1][jj] = x1 * sn + x2 * cs;
          }
        }
      }
#pragma unroll
      for (int ni = 0; ni < 4; ++ni) {
        f32x4 o = v[ni];
        o[0] *= SC; o[1] *= SC; o[2] *= SC; o[3] *= SC;
        *(u16x4*)(q + (size_t)row * 3072 + cb + ni * 16 + fq * 4) = pack4(o);
      }
    }
  }
}

__device__ __forceinline__ void ph_attn(const Params& p, char* lds, int bid, int nb) {
  const int tid = threadIdx.x, lane = tid & 63, wid = tid >> 6, fr = lane & 15, fq = lane >> 4;
  const u16* q = (const u16*)(p.ws + OFF_A);
  const u16* Kb = (const u16*)(p.ws + OFF_KB);
  const u16* VT = (const u16*)(p.ws + OFF_VT);
  u16* ol = (u16*)(p.ws + OFF_C);
  for (int it = bid; it < 768; it += nb) {
    int h, tokq0, kvbase, Lk; size_t vtbase;
    if (it < 256) { int b = it >> 7, qt = (it >> 4) & 7; h = it & 15; tokq0 = 8192 + b * 2048 + qt * 256;
                    kvbase = 8192 + b * 2560; Lk = 2560; vtbase = (size_t)32 * 128 * 256 + (size_t)b * 128 * 2560; }
    else { int r = it - 256; int b = r >> 4; h = r & 15; tokq0 = b * 256; kvbase = b * 256; Lk = 256;
           vtbase = (size_t)b * 128 * 256; }
    const int nkt = Lk >> 6;
    const u16* vt = VT + vtbase;
    bf16x8 qf[2][6];
#pragma unroll
    for (int qs = 0; qs < 2; ++qs)
#pragma unroll
      for (int ks = 0; ks < 6; ++ks)
        qf[qs][ks] = *(const bf16x8*)(q + (size_t)(tokq0 + wid * 32 + qs * 16 + fr) * 3072 + h * 192 + ks * 32 + fq * 8);
    f32x4 O[8][2];
#pragma unroll
    for (int d = 0; d < 8; ++d) { O[d][0] = f32x4{0, 0, 0, 0}; O[d][1] = f32x4{0, 0, 0, 0}; }
    float mrun[2] = {-1e30f, -1e30f}, lrun[2] = {0.f, 0.f};

    int koff[3], voff[2];
#pragma unroll
    for (int i = 0; i < 3; ++i) {
      int idx = tid + i * 512;
      int r = idx / 24, pos = idx - r * 24;
      int kc = (pos & ~7) | ((pos ^ r) & 7);
      koff[i] = r * 192 + kc * 8;
    }
#pragma unroll
    for (int i = 0; i < 2; ++i) {
      int idx = tid + i * 512;
      int d = idx >> 3, pos = idx & 7;
      voff[i] = d * 64 + ((pos ^ (d & 7)) * 8);
    }
    const u16* kbase = Kb + (size_t)kvbase * 192;
    auto stage = [&](int kt, int buf) {
      char* base = lds + buf * 40960 + tid * 16;
      const u16* kp = kbase + kt * (64 * 192);
      const u16* vp = vt + kt * (128 * 64);
#pragma unroll
      for (int i = 0; i < 3; ++i) glds16(kp + koff[i], base + i * 8192);
#pragma unroll
      for (int i = 0; i < 2; ++i) glds16(vp + voff[i], base + 24576 + i * 8192);
    };
    stage(0, 0);
    for (int kt = 0; kt < nkt; ++kt) {
      const int cur = kt & 1;
      if (kt + 1 < nkt) { stage(kt + 1, cur ^ 1); WAIT_VM(5); } else { WAIT_VM(0); }
      BARRIER();
      const char* kb = lds + cur * 40960;
      const char* vb = kb + 24576;
      f32x4 s[4][2];
#pragma unroll
      for (int sub = 0; sub < 4; ++sub) { s[sub][0] = f32x4{0, 0, 0, 0}; s[sub][1] = f32x4{0, 0, 0, 0}; }
#pragma unroll
      for (int ks = 0; ks < 6; ++ks) {
        const int coff = ((ks >> 1) * 8 + ((((ks & 1) * 4 + fq) ^ fr) & 7)) * 16;
#pragma unroll
        for (int sub = 0; sub < 4; ++sub) {
          bf16x8 kf = *(const bf16x8*)(kb + (sub * 16 + fr) * 384 + coff);
          s[sub][0] = __builtin_amdgcn_mfma_f32_16x16x32_bf16(kf, qf[0][ks], s[sub][0], 0, 0, 0);
          s[sub][1] = __builtin_amdgcn_mfma_f32_16x16x32_bf16(kf, qf[1][ks], s[sub][1], 0, 0, 0);
        }
      }
      bf16x8 pf[2][2];
#pragma unroll
      for (int qs = 0; qs < 2; ++qs) {
        float mx = s[0][qs][0];
#pragma unroll
        for (int sub = 0; sub < 4; ++sub)
#pragma unroll
          for (int jj = 0; jj < 4; ++jj) mx = fmaxf(mx, s[sub][qs][jj]);
        mx = fmaxf(mx, __shfl_xor(mx, 16));
        mx = fmaxf(mx, __shfl_xor(mx, 32));
        const float mnew = fmaxf(mrun[qs], mx);
        const float alpha = __builtin_amdgcn_exp2f(mrun[qs] - mnew);
        mrun[qs] = mnew;
        float ps = 0.f;
#pragma unroll
        for (int sub = 0; sub < 4; ++sub)
#pragma unroll
          for (int jj = 0; jj < 4; ++jj) {
            float e = __builtin_amdgcn_exp2f(s[sub][qs][jj] - mnew);
            s[sub][qs][jj] = e;
            ps += e;
          }
        lrun[qs] = lrun[qs] * alpha + ps;
#pragma unroll
        for (int d = 0; d < 8; ++d) { O[d][qs][0] *= alpha; O[d][qs][1] *= alpha; O[d][qs][2] *= alpha; O[d][qs][3] *= alpha; }
#pragma unroll
        for (int kbk = 0; kbk < 2; ++kbk) {
          bf16x8 f;
#pragma unroll
          for (int jj = 0; jj < 4; ++jj) {
            f[jj] = (short)f2bf(s[kbk * 2][qs][jj]);
            f[4 + jj] = (short)f2bf(s[kbk * 2 + 1][qs][jj]);
          }
          pf[kbk][qs] = f;
        }
      }
#pragma unroll
      for (int d = 0; d < 8; ++d)
#pragma unroll
        for (int kbk = 0; kbk < 2; ++kbk) {
          bf16x8 vf = *(const bf16x8*)(vb + (d * 16 + fr) * 128 + (((kbk * 4 + fq) ^ (fr & 7)) << 4));
          O[d][0] = __builtin_amdgcn_mfma_f32_16x16x32_bf16(vf, pf[kbk][0], O[d][0], 0, 0, 0);
          O[d][1] = __builtin_amdgcn_mfma_f32_16x16x32_bf16(vf, pf[kbk][1], O[d][1], 0, 0, 0);
        }
      BARRIER();
    }
#pragma unroll
    for (int qs = 0; qs < 2; ++qs) {
      float l = lrun[qs];
      l += __shfl_xor(l, 16);
      l += __shfl_xor(l, 32);
      const float il = 1.f / l;
      const int tok = tokq0 + wid * 32 + qs * 16 + fr;
#pragma unroll
      for (int d = 0; d < 8; ++d) {
        f32x4 o = O[d][qs];
        o[0] *= il; o[1] *= il; o[2] *= il; o[3] *= il;
        *(u16x4*)(ol + blkA(tok, h * 128 + d * 16 + fq * 4, 32)) = pack4(o);
      }
    }
  }
}

__device__ __forceinline__ void ph_oexp(const Params& p, char* lds, int bid, int nb) {
  const u16* ol = (const u16*)(p.ws + OFF_C);
  const u16* w = (const u16*)(p.ws + W_WUV);
  const u16* zb = (const u16*)(p.ws + OFF_B);
  u16* mo = (u16*)(p.ws + OFF_A);
  for (int l = (bid >> 3); l < 48 * 2; l += (nb >> 3)) {
    const int mt = l / 2, nt = (bid & 7) * 2 + l % 2;
    const int m0 = mt * 256, n0 = nt * 128;
    f32x4 acc[4][4];
    gemm_loop<4, 2, true, true>(lds, 2,
        [&](int r, int k) { return ol + ((size_t)(mt * 32 + nt * 2) * 256 + r) * 64 + k; },
        [&](int r, int k) { return w + ((size_t)(nt * 2) * 128 + r) * 64 + k; }, acc, 256 * 64, 128 * 64);
    EPI_LOOP(4, 2) {
      const int row = EPI_ROW(m0), col = EPI_COL(n0);
      f32x4 v = acc[mi][ni];
      u16x4 zv = *(const u16x4*)(zb + (size_t)row * 2048 + col);
      v[0] *= bf2f(zv[0]); v[1] *= bf2f(zv[1]); v[2] *= bf2f(zv[2]); v[3] *= bf2f(zv[3]);
      *(u16x4*)(mo + blkA(row, col, 32)) = pack4(v);
    }
  }
}

__device__ __forceinline__ void ph_final(const Params& p, int bid, int nb) {
  const int lane = threadIdx.x & 63, wid = threadIdx.x >> 6;
  for (int row = bid * 8 + wid; row < NT_TOK; row += nb * 8) {
    float* x = p.out + (size_t)row * 1024;
    float4 v[4];
    float ss = 0.f;
#pragma unroll
    for (int q = 0; q < 4; ++q) {
      v[q] = *(const float4*)(x + q * 256 + lane * 4);
      ss += v[q].x * v[q].x + v[q].y * v[q].y + v[q].z * v[q].z + v[q].w * v[q].w;
    }
    ss = wave_sum(ss);
    const float rstd = rsqrtf(ss * (1.f / 1024.f) + 1e-6f);
#pragma unroll
    for (int q = 0; q < 4; ++q) {
      float4 g = *(const float4*)(p.final_g + q * 256 + lane * 4);
      float4 o;
      o.x = v[q].x * rstd * g.x; o.y = v[q].y * rstd * g.y; o.z = v[q].z * rstd * g.z; o.w = v[q].w * rstd * g.w;
      *(float4*)(x + q * 256 + lane * 4) = o;
    }
  }
}

#define XB_TMO      128
#define XB_XCNT(j)  (256  + 64 * (j))
#define XB_XSUB(j)  (1280 + 64 * (j))
#define XB_XGEN(j)  (2304 + 64 * (j))
#define XB_TOP      3328
#define XB_TOPGEN   3392
#define XCD_BAR_WORDS 3456
#define XB_SPIN_CAP (1u << 18)
#define LAS __attribute__((address_space(3)))

__device__ __forceinline__ unsigned xb_ld(unsigned* p)              { return __hip_atomic_load(p, __ATOMIC_RELAXED, __HIP_MEMORY_SCOPE_AGENT); }
__device__ __forceinline__ unsigned xb_add(unsigned* p, unsigned v) { return __hip_atomic_fetch_add(p, v, __ATOMIC_RELAXED, __HIP_MEMORY_SCOPE_AGENT); }
__device__ __forceinline__ unsigned xb_xcc_id() { return (unsigned)__builtin_amdgcn_s_getreg((3 << 11) | 20) & 0xFu; }
#define XB_SPIN(cond, bar) do { unsigned _sp = 0; while (cond) { __builtin_amdgcn_s_sleep(1); \
    if ((++_sp & 255u) == 0u) { if (xb_ld(&(bar)[XB_TMO])) break; if (_sp > XB_SPIN_CAP) { atomicAdd(&(bar)[XB_TMO], 1u); break; } } } } while (0)

struct XcdBarrier {
    unsigned* bar; unsigned x;
    volatile LAS unsigned* st;
};

__device__ __forceinline__ XcdBarrier xcd_barrier_post(unsigned* bar, volatile LAS unsigned* st) {
    XcdBarrier b; b.bar = bar; b.x = xb_xcc_id(); b.st = st;
    if (threadIdx.x == 0) (void)xb_add(&bar[XB_XCNT(b.x)], 1u);
    return b;
}
__device__ __forceinline__ void xcd_barrier_complete(unsigned* bar, unsigned x, unsigned& nloc, unsigned& nx) {
    const unsigned G = gridDim.x * gridDim.y * gridDim.z;
    unsigned sum, cnt, mine, sp = 0u;
    for (;;) {
        sum = 0u; cnt = 0u; mine = 0u;
#pragma unroll
        for (unsigned j = 0; j < 16; ++j) { const unsigned c = xb_ld(&bar[XB_XCNT(j)]); sum += c; cnt += (c > 0u) ? 1u : 0u; mine = (j == x) ? c : mine; }
        if (sum == G) break;
        __builtin_amdgcn_s_sleep(1);
        if ((++sp & 255u) == 0u) { if (xb_ld(&bar[XB_TMO])) break; if (sp > XB_SPIN_CAP) { atomicAdd(&bar[XB_TMO], 1u); break; } }
    }
    nloc = mine > 0u ? mine : 1u; nx = cnt > 0u ? cnt : 1u;
}

__device__ __forceinline__ void xcd_barrier(const XcdBarrier& b) {
    asm volatile("s_waitcnt vmcnt(0)" ::: "memory");
    __syncthreads();
    if (threadIdx.x == 0) {
        unsigned* bar = b.bar;
        __builtin_amdgcn_s_waitcnt(0);
        unsigned nloc = b.st[0], nx = b.st[1];
        if (nloc == 0u) { xcd_barrier_complete(bar, b.x, nloc, nx); b.st[0] = nloc; b.st[1] = nx; }
        const unsigned old = xb_add(&bar[XB_XSUB(b.x)], 1u);
        const unsigned gen = old / nloc;
        if (old + 1u == (gen + 1u) * nloc) {
            __builtin_amdgcn_fence(__ATOMIC_RELEASE, "agent");
            asm volatile("s_waitcnt vmcnt(0)" ::: "memory");
            const unsigned og = xb_add(&bar[XB_TOP], 1u);
            const unsigned tg = og / nx;
            if (og + 1u == (tg + 1u) * nx) xb_add(&bar[XB_TOPGEN], 1u);
            else XB_SPIN(xb_ld(&bar[XB_TOPGEN]) == tg, bar);
            __builtin_amdgcn_fence(__ATOMIC_ACQUIRE, "agent");
            xb_add(&bar[XB_XGEN(b.x)], 1u);
            asm volatile("s_waitcnt vmcnt(0)" ::: "memory");
        } else {
            XB_SPIN(xb_ld(&bar[XB_XGEN(b.x)]) == gen, bar);
            __builtin_amdgcn_fence(__ATOMIC_ACQUIRE, "agent");
            asm volatile("s_waitcnt vmcnt(0)" ::: "memory");
        }
    }
    __syncthreads();
}


#define N_PHASES 28
template <int ph>
__device__ __forceinline__ void run_phase(const Params& p, char* lds, int bid, int nb) {
  switch (ph) {
    case 0: ph_prep(p, 0, true, false, lds, bid, nb); break;
    case 1: ph_norm(p, 0, lds, bid, nb); break;
    case 2: ph_inproj(p, lds, bid, nb); break;
    case 3: ph_s5g1(p, lds, bid, nb); break;
    case 4: ph_scan(p, 0, bid, nb); break;
    case 5: ph_s5g3(p, lds, bid, nb); break;
    case 6: ph_glu(p, 0, lds, bid, nb); break;
    case 7: ph_out(p, 0, (const u16*)(p.ws + OFF_C), lds, bid, nb); break;
    case 8: ph_prep(p, 1, false, true, lds, bid, nb); break;
    case 9: ph_inproj(p, lds, bid, nb); break;
    case 10: ph_pool(p, bid, nb); break;
    case 11: ph_poolmm(p, 0, lds, bid, nb); break;
    case 12: ph_out(p, 1, (const u16*)(p.ws + OFF_C), lds, bid, nb); break;
    case 13: ph_prep(p, 2, false, true, lds, bid, nb); break;
    case 14: ph_inproj_mla(p, lds, bid, nb); break;
    case 15: ph_mlanorm(p, 0, lds, bid, nb); break;
    case 16: ph_qgemm(p, lds, bid, nb); break;
    case 17: ph_attn(p, lds, bid, nb); break;
    case 18: ph_oexp(p, lds, bid, nb); break;
    case 19: ph_out(p, 2, (const u16*)(p.ws + OFF_A), lds, bid, nb); break;
    case 20: ph_prep(p, 3, false, true, lds, bid, nb); break;
    case 21: ph_inproj(p, lds, bid, nb); break;
    case 22: ph_s5g1(p, lds, bid, nb); break;
    case 23: ph_scan(p, 1, bid, nb); break;
    case 24: ph_s5g3(p, lds, bid, nb); break;
    case 25: ph_glu(p, 1, lds, bid, nb); break;
    case 26: ph_out(p, 3, (const u16*)(p.ws + OFF_C), lds, bid, nb); break;
    case 27: ph_final(p, bid, nb); break;
    default: break;
  }
}

template <int PH>
__device__ __forceinline__ void run_all(const Params& p, char* lds, cg::grid_group& grid, const XcdBarrier& xb, int bid, int nb) {
  if constexpr (PH < N_PHASES) {
    run_phase<PH>(p, lds, bid, nb);
#ifdef DUP_PHASE
    if constexpr (PH == DUP_PHASE) { xcd_barrier(xb); run_phase<PH>(p, lds, bid, nb); }
#endif
    if constexpr (PH + 1 < N_PHASES) {
      if constexpr (PH == 0) grid.sync(); else xcd_barrier(xb);
      run_all<PH + 1>(p, lds, grid, xb, bid, nb);
    }
  }
}

#if MK_SINGLE
__global__ void __launch_bounds__(512) k_mega(Params p) {
  __shared__ __attribute__((aligned(16))) char lds[LDS_BYTES];
  __shared__ uint4 xb_words;
  cg::grid_group grid = cg::this_grid();
  if (threadIdx.x == 0) xb_words = make_uint4(0u, 0u, 0u, 0u);
  __syncthreads();
  XcdBarrier xb = xcd_barrier_post((unsigned*)(p.ws + OFF_BAR), (volatile LAS unsigned*)&xb_words);
  run_all<0>(p, lds, grid, xb, blockIdx.x, gridDim.x);
}
#else
template <int PH>
__global__ void __launch_bounds__(512) __attribute__((amdgpu_waves_per_eu(2, 2))) k_phase(Params p) {
  __shared__ __attribute__((aligned(16))) char lds[LDS_BYTES];
  run_phase<PH>(p, lds, blockIdx.x, gridDim.x);
}
template <int PH>
static void launch_all(const Params& p, hipStream_t stream) {
  if constexpr (PH < N_PHASES) {
    k_phase<PH><<<256, 512, 0, stream>>>(p);
    launch_all<PH + 1>(p, stream);
  }
}
#endif

extern "C" void kernel_launch(void* const* d_in, const int* in_sizes, int n_in, void* d_out, int out_size,
                              void* d_ws, size_t ws_size, hipStream_t stream) {
  Params p{};
  const float** f = (const float**)&p;
  for (int i = 0; i < 34; ++i) f[i] = (const float*)d_in[i];
  p.out = (float*)d_out;
  p.ws = (char*)d_ws;
#if MK_SINGLE
  static int grid_blocks = 0;
  if (!grid_blocks) {
    int dev = 0, cus = 0, per_cu = 0;
    (void)hipGetDevice(&dev);
    (void)hipDeviceGetAttribute(&cus, hipDeviceAttributeMultiprocessorCount, dev);
    (void)hipOccupancyMaxActiveBlocksPerMultiprocessor(&per_cu, k_mega, 512, 0);
    if (per_cu > 1) per_cu = 1;
    grid_blocks = cus * per_cu;
    if (grid_blocks <= 0) grid_blocks = 256;
  }
  (void)hipMemsetAsync((char*)d_ws + OFF_BAR, 0, XCD_BAR_WORDS * 4, stream);
  void* args[] = {&p};
  hipError_t e = hipLaunchCooperativeKernel((void*)k_mega, dim3(grid_blocks), dim3(512), args, 0, stream);
  if (e != hipSuccess) fprintf(stderr, "cooperative launch failed: %s (grid %d)\n", hipGetErrorString(e), grid_blocks);
#else
  launch_all<0>(p, stream);
#endif
}
```

```cpp
#include <hip/hip_runtime.h>
#include <hip/hip_cooperative_groups.h>
#include <cstdio>
namespace cg = cooperative_groups;

#ifndef MK_SINGLE
#define MK_SINGLE 1
#endif

typedef unsigned short u16;
using bf16x8 = __attribute__((ext_vector_type(8))) short;
using f32x4  = __attribute__((ext_vector_type(4))) float;
using u16x4  = __attribute__((ext_vector_type(4))) unsigned short;
using u16x8  = __attribute__((ext_vector_type(8))) unsigned short;

struct Params {
  const float *x_prompt, *x_sample, *st_re, *st_im, *cache_ckv, *cache_kpe, *c, *c_ctx;
  const float *norm_g, *ada_w, *ada_b, *final_g;
  const float *s5_w_in, *s5_lam_re, *s5_lam_im, *s5_log_step, *s5_b_re, *s5_b_im, *s5_c_re, *s5_c_im;
  const float *s5_d, *s5_glu_w, *s5_glu_b, *s5_w_out;
  const float *pool_w_in, *pool_w, *pool_scale, *pool_w_out;
  const float *mla_w_in, *mla_q_norm, *mla_wq_b, *mla_kv_norm, *mla_wkv_b, *mla_w_out;
  float* out;
  char* ws;
};

constexpr size_t MiB = 1ull << 20;
constexpr size_t OFF_W = 0, OFF_A = 20 * MiB, OFF_B = 116 * MiB, OFF_C = 164 * MiB, OFF_M = 212 * MiB,
                 OFF_H = 228 * MiB;
constexpr size_t OFF_BAR = OFF_M + 512 * 1024;
constexpr size_t OFF_MOD = OFF_M, OFF_QAN = OFF_M + 1 * MiB, OFF_KB = OFF_M + 7 * MiB, OFF_VT = OFF_M + 12 * MiB;
constexpr size_t W_WIN = OFF_W, W_GLU = OFF_W + 8 * MiB, W_POOLW = OFF_W + 8 * MiB, W_WQ = OFF_W + 6 * MiB,
                 W_WUV = OFF_W + 8 * MiB, W_WOUT = OFF_W + 16 * MiB;
constexpr size_t A_QA = OFF_A + 72 * MiB, A_CKVF = OFF_A + 84 * MiB, A_KPEF = OFF_A + 90 * MiB;
constexpr size_t B_WST = OFF_B, B_WBIG = OFF_B + 16 * MiB;

constexpr int OUT_RE = 12582912, OUT_IM = 13631488, OUT_CKV = 14680064, OUT_KPE = 15728640;

#define NT_TOK 12288
#define LDS_BYTES 147456

__device__ __forceinline__ u16 f2bf(float f) {
  unsigned u = __float_as_uint(f);
  u += 0x7fffu + ((u >> 16) & 1u);
  return (u16)(u >> 16);
}
__device__ __forceinline__ float bf2f(u16 h) { return __uint_as_float(((unsigned)h) << 16); }
__device__ __forceinline__ float fsigmoid(float x) { return 1.f / (1.f + __expf(-x)); }
__device__ __forceinline__ float fsilu(float x) { return x * fsigmoid(x); }
__device__ __forceinline__ float fgelu(float x) {
  float y = 0.7978845608028654f * (x + 0.044715f * x * x * x);
  float t = 1.f - 2.f / (__expf(2.f * y) + 1.f);
  return 0.5f * x * (1.f + t);
}
__device__ __forceinline__ float2 cis_rev(double rev) {
  double f = rev - rint(rev);
  float ff = (float)f;
  return make_float2(__builtin_amdgcn_cosf(ff), __builtin_amdgcn_sinf(ff));
}
__device__ __forceinline__ float wave_sum(float v) {
#pragma unroll
  for (int o = 32; o > 0; o >>= 1) v += __shfl_xor(v, o);
  return v;
}
__device__ __forceinline__ int cond_of_row(int row) { return row < 8192 ? 0 : 1 + ((row - 8192) >> 11); }
__device__ __forceinline__ u16x4 pack4(f32x4 v) {
  u16x4 r;
  r[0] = f2bf(v[0]); r[1] = f2bf(v[1]); r[2] = f2bf(v[2]); r[3] = f2bf(v[3]);
  return r;
}

__device__ __forceinline__ size_t blkA(int row, int k, int KT) { return ((size_t)((row >> 8) * KT + (k >> 6)) * 256 + (row & 255)) * 64 + (k & 63); }
__device__ __forceinline__ size_t blkB(int n, int k, int KT) { return ((size_t)((n >> 7) * KT + (k >> 6)) * 128 + (n & 127)) * 64 + (k & 63); }
__device__ __forceinline__ size_t ugaddr(int tok, int ch) { return ((size_t)((ch >> 4) * 768 + (tok >> 4))) * 256 + (tok & 15) * 16 + (ch & 15); }
__device__ __forceinline__ size_t xaddr(int row, int g, int col) { return ((((size_t)g * 6 + (row >> 7)) * 4 + (col >> 6)) * 128 + (row & 127)) * 64 + (col & 63); }

#define WAIT_VM(n) asm volatile("s_waitcnt vmcnt(" #n ")" ::: "memory")
#define BARRIER()                        \
  do {                                   \
    asm volatile("" ::: "memory");       \
    __builtin_amdgcn_s_barrier();        \
    asm volatile("" ::: "memory");       \
  } while (0)

__device__ __forceinline__ void glds16(const void* g, char* l) {
  __builtin_amdgcn_global_load_lds((const unsigned*)g, (unsigned*)l, 16, 0, 0);
}

template <int WM, int WN, bool LINA, bool LINB, int MI = 4, class AF, class BF>
__device__ __forceinline__ void gemm_loop(char* lds, int nk, AF af, BF bf, f32x4 (&acc)[MI][4], int ksa = 64, int ksb = 64) {
  constexpr int BM = WM * MI * 16, BN = WN * 64;
  constexpr int NA = BM / 64, NB = BN / 64, NG = NA + NB;
  constexpr int STG = (BM + BN) * 128;
  static_assert(3 * STG <= LDS_BYTES, "lds");
  static_assert(NG <= 2 * MI, "glds slots");
  const int tid = threadIdx.x, lane = tid & 63, wid = tid >> 6;
  const int wr = wid / WN, wc = wid % WN, fr = lane & 15, fq = lane >> 4;
  const int srow = tid >> 3;
  const int skc = ((tid & 7) ^ (srow & 7)) * 8;
#pragma unroll
  for (int mi = 0; mi < MI; ++mi)
#pragma unroll
    for (int ni = 0; ni < 4; ++ni) acc[mi][ni] = f32x4{0.f, 0.f, 0.f, 0.f};

  const u16* pa[NA];
  const u16* pb[NB];
  if constexpr (LINA) {
#pragma unroll
    for (int i = 0; i < NA; ++i) pa[i] = af(srow + i * 64, skc);
  }
  if constexpr (LINB) {
#pragma unroll
    for (int i = 0; i < NB; ++i) pb[i] = bf(srow + i * 64, skc);
  }
  auto glds_one = [&](int i, int kt, char* base) {
    if (i < NA)
      glds16(LINA ? pa[i] + kt * ksa : af(srow + i * 64, kt * 64 + skc), base + i * 8192);
    else
      glds16(LINB ? pb[i - NA] + kt * ksb : bf(srow + (i - NA) * 64, kt * 64 + skc),
             base + BM * 128 + (i - NA) * 8192);
  };
  auto stage = [&](int kt, int buf) {
    char* base = lds + buf * STG + tid * 16;
#pragma unroll
    for (int i = 0; i < NG; ++i) glds_one(i, kt, base);
  };
  constexpr int H1 = NG / 2;
  stage(0, 0);
  if (nk > 1) stage(1, 1);
  if (nk > 1) { asm volatile("s_waitcnt vmcnt(%0)" ::"n"(NG) : "memory"); } else { WAIT_VM(0); }
  BARRIER();
  int cur = 0;
  const int rowoffA = (wr * (MI * 16) + fr) * 128, rowoffB = BM * 128 + (wc * 64 + fr) * 128;
  const int off0 = ((0 + fq) ^ (fr & 7)) << 4, off1 = ((4 + fq) ^ (fr & 7)) << 4;
  bf16x8 a0[MI], b0[4], a1[MI], b1[4];
#pragma unroll
  for (int mi = 0; mi < MI; ++mi) a0[mi] = *(const bf16x8*)(lds + rowoffA + mi * 2048 + off0);
#pragma unroll
  for (int ni = 0; ni < 4; ++ni) b0[ni] = *(const bf16x8*)(lds + rowoffB + ni * 2048 + off0);
  for (int kt = 0; kt < nk; ++kt) {
    const bool pf = kt + 2 < nk;
    const int nxt = cur == 2 ? 0 : cur + 1;
    char* nbase = lds + (cur >= 1 ? cur - 1 : 2) * STG + tid * 16;
    const char* sa = lds + cur * STG + rowoffA;
    const char* sb = lds + cur * STG + rowoffB;
#pragma unroll
    for (int m2 = 0; m2 < MI; ++m2) a1[m2] = *(const bf16x8*)(sa + m2 * 2048 + off1);
#pragma unroll
    for (int n2 = 0; n2 < 4; ++n2) b1[n2] = *(const bf16x8*)(sb + n2 * 2048 + off1);
    __builtin_amdgcn_sched_barrier(0);
#pragma unroll
    for (int g = 0; g < MI; ++g) {
#pragma unroll
      for (int ni = 0; ni < 4; ++ni)
        acc[g][ni] = __builtin_amdgcn_mfma_f32_16x16x32_bf16(b0[ni], a0[g], acc[g][ni], 0, 0, 0);
      __builtin_amdgcn_sched_barrier(0);
      if (g < H1) { if (pf) glds_one(g, kt + 2, nbase); }
      __builtin_amdgcn_sched_barrier(0);
    }
    asm volatile("s_waitcnt lgkmcnt(0)" ::: "memory");
    if (pf) { asm volatile("s_waitcnt vmcnt(%0)" ::"n"(H1) : "memory"); } else { WAIT_VM(0); }
    BARRIER();
    if (kt + 1 < nk) {
      const char* na = lds + nxt * STG + rowoffA;
      const char* nbp = lds + nxt * STG + rowoffB;
#pragma unroll
      for (int m2 = 0; m2 < MI; ++m2) a0[m2] = *(const bf16x8*)(na + m2 * 2048 + off0);
#pragma unroll
      for (int n2 = 0; n2 < 4; ++n2) b0[n2] = *(const bf16x8*)(nbp + n2 * 2048 + off0);
    }
    __builtin_amdgcn_sched_barrier(0);
#pragma unroll
    for (int g = 0; g < MI; ++g) {
#pragma unroll
      for (int ni = 0; ni < 4; ++ni)
        acc[g][ni] = __builtin_amdgcn_mfma_f32_16x16x32_bf16(b1[ni], a1[g], acc[g][ni], 0, 0, 0);
      __builtin_amdgcn_sched_barrier(0);
      if (H1 + g < NG) { if (pf) glds_one(H1 + g, kt + 2, nbase); }
      __builtin_amdgcn_sched_barrier(0);
    }
    cur = nxt;
  }
}

template <int MI, class AF, class BF>
__device__ __forceinline__ void gemm_loop2(char* lds, int nk, AF af, BF bf, f32x4 (&acc)[MI][4], int ksa, int ksb) {
  constexpr int BM = 2 * MI * 16, BN = 256;
  constexpr int NA = BM / 64, NB = BN / 64, NG = NA + NB;
  constexpr int STG = (BM + BN) * 128;
  static_assert(2 * STG <= LDS_BYTES, "lds");
  static_assert(NG <= 2 * MI, "glds slots");
  const int tid = threadIdx.x, lane = tid & 63, wid = tid >> 6;
  const int wr = wid >> 2, wc = wid & 3, fr = lane & 15, fq = lane >> 4;
  const int srow = tid >> 3;
  const int skc = ((tid & 7) ^ (srow & 7)) * 8;
#pragma unroll
  for (int mi = 0; mi < MI; ++mi)
#pragma unroll
    for (int ni = 0; ni < 4; ++ni) acc[mi][ni] = f32x4{0.f, 0.f, 0.f, 0.f};
  const u16* pa[NA];
  const u16* pb[NB];
#pragma unroll
  for (int i = 0; i < NA; ++i) pa[i] = af(srow + i * 64, skc);
#pragma unroll
  for (int i = 0; i < NB; ++i) pb[i] = bf(srow + i * 64, skc);
  auto glds_one = [&](int i, int kt, char* base) {
    if (i < NA) glds16(pa[i] + kt * ksa, base + i * 8192);
    else glds16(pb[i - NA] + kt * ksb, base + BM * 128 + (i - NA) * 8192);
  };
  {
    char* base = lds + tid * 16;
#pragma unroll
    for (int i = 0; i < NG; ++i) glds_one(i, 0, base);
  }
  const int rowoffA = (wr * (MI * 16) + fr) * 128, rowoffB = BM * 128 + (wc * 64 + fr) * 128;
  for (int kt = 0; kt < nk; ++kt) {
    const int cur = kt & 1;
    WAIT_VM(0);
    BARRIER();
    const bool pf = kt + 1 < nk;
    char* nbase = lds + (cur ^ 1) * STG + tid * 16;
    const char* sa = lds + cur * STG + rowoffA;
    const char* sb = lds + cur * STG + rowoffB;
#pragma unroll
    for (int ks = 0; ks < 2; ++ks) {
      const int off = ((ks * 4 + fq) ^ (fr & 7)) << 4;
      bf16x8 a[MI], b[4];
#pragma unroll
      for (int mi = 0; mi < MI; ++mi) a[mi] = *(const bf16x8*)(sa + mi * 2048 + off);
#pragma unroll
      for (int ni = 0; ni < 4; ++ni) b[ni] = *(const bf16x8*)(sb + ni * 2048 + off);
      __builtin_amdgcn_sched_barrier(0);
#pragma unroll
      for (int g = 0; g < MI; ++g) {
#pragma unroll
        for (int ni = 0; ni < 4; ++ni)
          acc[g][ni] = __builtin_amdgcn_mfma_f32_16x16x32_bf16(b[ni], a[g], acc[g][ni], 0, 0, 0);
        __builtin_amdgcn_sched_barrier(0);
        if (ks * MI + g < NG) { if (pf) glds_one(ks * MI + g, kt + 1, nbase); }
        __builtin_amdgcn_sched_barrier(0);
      }
    }
  }
  BARRIER();
}

#define EPI2_LOOP(MI_)                                                           \
  const int _lane = threadIdx.x & 63, _wid = threadIdx.x >> 6;                   \
  const int _wr = _wid >> 2, _wc = _wid & 3, _fr = _lane & 15, _fq = _lane >> 4; \
  _Pragma("unroll") for (int mi = 0; mi < (MI_); ++mi) _Pragma("unroll") for (int ni = 0; ni < 4; ++ni)
#define EPI2_ROW(m0, MI_) ((m0) + _wr * ((MI_) * 16) + mi * 16 + _fr)
#define EPI2_COL(n0) ((n0) + _wc * 64 + ni * 16 + _fq * 4)

#define EPI_LOOP(WM_, WN_)                                                       \
  const int _lane = threadIdx.x & 63, _wid = threadIdx.x >> 6;                   \
  const int _wr = _wid / (WN_), _wc = _wid % (WN_), _fr = _lane & 15, _fq = _lane >> 4; \
  _Pragma("unroll") for (int mi = 0; mi < 4; ++mi) _Pragma("unroll") for (int ni = 0; ni < 4; ++ni)
#define EPI_ROW(m0) ((m0) + _wr * 64 + mi * 16 + _fr)
#define EPI_COL(n0) ((n0) + _wc * 64 + ni * 16 + _fq * 4)

__device__ __forceinline__ void ada_item(const Params& p, int item, char* lds) {
  const int tid = threadIdx.x;
  const int layer = item / 48, n0 = (item % 48) * 64;
  float* sc = (float*)lds;
  float* red = sc + 3072;
  for (int i = tid; i < 3072; i += 512) {
    int cond = i >> 10, k = i & 1023;
    float v = cond == 0 ? p.c_ctx[k] : p.c[(cond - 1) * 1024 + k];
    sc[i] = fsilu(v);
  }
  __syncthreads();
  const int cq = tid & 15, kg = tid >> 4;
  float a[3][4];
#pragma unroll
  for (int c = 0; c < 3; ++c)
#pragma unroll
    for (int e = 0; e < 4; ++e) a[c][e] = 0.f;
  const float* w = p.ada_w + (size_t)layer * 1024 * 3072 + (size_t)(kg * 32) * 3072 + n0 + cq * 4;
#pragma unroll 8
  for (int k = 0; k < 32; ++k) {
    float4 wv = *(const float4*)(w + (size_t)k * 3072);
#pragma unroll
    for (int c = 0; c < 3; ++c) {
      float s = sc[c * 1024 + kg * 32 + k];
      a[c][0] += s * wv.x; a[c][1] += s * wv.y; a[c][2] += s * wv.z; a[c][3] += s * wv.w;
    }
  }
#pragma unroll
  for (int c = 0; c < 3; ++c)
#pragma unroll
    for (int e = 0; e < 4; ++e) red[(kg * 3 + c) * 64 + cq * 4 + e] = a[c][e];
  __syncthreads();
  if (tid < 192) {
    int cond = tid >> 6, nn = tid & 63;
    float sum = 0.f;
#pragma unroll 8
    for (int g = 0; g < 32; ++g) sum += red[(g * 3 + cond) * 64 + nn];
    sum += p.ada_b[layer * 3072 + n0 + nn];
    ((float*)(p.ws + OFF_MOD))[(layer * 3 + cond) * 3072 + n0 + nn] = sum;
  }
  __syncthreads();
}

template <int KR>
__device__ __forceinline__ void conv_tile(const float* src, int ld, int k0, int n0, u16* dst, int ldd, int drow0, char* lds, int blkKT = 0) {
  float* t = (float*)lds;
  const int tid = threadIdx.x;
  float4 v[KR / 32];
#pragma unroll
  for (int i = 0; i < KR / 32; ++i) {
    int kk = (tid >> 4) + i * 32, n4 = (tid & 15) * 4;
    v[i] = *(const float4*)(src + (size_t)(k0 + kk) * ld + n0 + n4);
  }
#pragma unroll
  for (int i = 0; i < KR / 32; ++i) {
    int kk = (tid >> 4) + i * 32, n4 = (tid & 15) * 4;
    t[kk * 65 + n4 + 0] = v[i].x; t[kk * 65 + n4 + 1] = v[i].y; t[kk * 65 + n4 + 2] = v[i].z; t[kk * 65 + n4 + 3] = v[i].w;
  }
  __syncthreads();
#pragma unroll
  for (int r = 0; r < KR / 64; ++r) {
    int i = tid >> 3, kc = (tid & 7) * 8 + r * 64;
    u16x8 o;
#pragma unroll
    for (int q = 0; q < 8; ++q) o[q] = f2bf(t[(kc + q) * 65 + i]);
    if (blkKT) {
      const int n = drow0 + i;
      *(u16x8*)(dst + ((size_t)((n >> 7) * blkKT + ((k0 + kc) >> 6)) * 128 + (n & 127)) * 64 + (kc & 63)) = o;
    } else {
      *(u16x8*)(dst + (size_t)(drow0 + i) * ldd + k0 + kc) = o;
    }
  }
  __syncthreads();
}

__device__ __forceinline__ void conv_item(const Params& p, int layer, int it, char* lds) {
  const int kind = layer % 3, j = layer / 3;
  if (kind == 0) {
    if (it < 256) {
      int kt = it >> 6, nt = it & 63;
      conv_tile<256>(p.s5_w_in + (size_t)j * 1024 * 4096, 4096, kt * 256, nt * 64, (u16*)(p.ws + W_WIN), 1024, nt * 64, lds, 16);
    } else if (it < 512) {
      int t = it - 256, kt = t >> 5, nt = t & 31;
      conv_tile<256>(p.s5_glu_w + (size_t)j * 2048 * 2048, 2048, kt * 256, nt * 64, (u16*)(p.ws + W_GLU), 2048, nt * 64, lds, 32);
    } else {
      int t = it - 512, kt = t >> 4, nt = t & 15;
      conv_tile<256>(p.s5_w_out + (size_t)j * 2048 * 1024, 1024, kt * 256, nt * 64, (u16*)(p.ws + W_WOUT), 2048, nt * 64, lds, 32);
    }
  } else if (kind == 1) {
    if (it < 256) {
      int kt = it >> 6, nt = it & 63;
      conv_tile<256>(p.pool_w_in + (size_t)j * 1024 * 4096, 4096, kt * 256, nt * 64, (u16*)(p.ws + W_WIN), 1024, nt * 64, lds, 16);
    } else if (it < 320) {
      int t = it - 256, g = t >> 4, r = t & 15, kt = r >> 3, nt = r & 7;
      conv_tile<256>(p.pool_w + ((size_t)j * 4 + g) * 512 * 512, 512, kt * 256, nt * 64, (u16*)(p.ws + W_POOLW), 512,
                g * 512 + nt * 64, lds, 8);
    } else {
      int t = it - 320, kt = t >> 4, nt = t & 15;
      conv_tile<256>(p.pool_w_out + (size_t)j * 2048 * 1024, 1024, kt * 256, nt * 64, (u16*)(p.ws + W_WOUT), 2048, nt * 64, lds, 32);
    }
  } else {
    if (it < 156) {
      int kt = it / 39, nt = it % 39;
      conv_tile<256>(p.mla_w_in + (size_t)j * 1024 * 2496, 2496, kt * 256, nt * 64, (u16*)(p.ws + W_WIN), 1024, nt * 64, lds, 16);
    } else if (it < 172) {
      int h = it - 156, nt = h * 3 + 2;
      conv_tile<256>(p.mla_wq_b + (size_t)j * 256 * 3072, 3072, 0, nt * 64, (u16*)(p.ws + W_WQ), 256, nt * 64, lds, 4);
    } else if (it < 204) {
      int q = it - 172, h = q >> 1, half = q & 1, nt = h * 4 + 2 + half;
      conv_tile<128>(p.mla_wkv_b + (size_t)j * 128 * 4096, 4096, 0, nt * 64, (u16*)(p.ws + W_WUV), 128,
                h * 128 + half * 64, lds, 2);
    } else {
      int t = it - 204, kt = t >> 4, nt = t & 15;
      conv_tile<256>(p.mla_w_out + (size_t)j * 2048 * 1024, 1024, kt * 256, nt * 64, (u16*)(p.ws + W_WOUT), 2048, nt * 64, lds, 32);
    }
  }
}
__device__ __forceinline__ int conv_count(int layer) {
  const int kind = layer % 3;
  return kind == 0 ? 640 : (kind == 1 ? 448 : 332);
}

__device__ __forceinline__ const float* x_row(const Params& p, int layer, int row) {
  if (layer == 0) return row < 8192 ? p.x_prompt + (size_t)row * 1024 : p.x_sample + (size_t)(row - 8192) * 1024;
  return p.out + (size_t)row * 1024;
}

__device__ __forceinline__ void norm_item(const Params& p, int layer, int item, char* lds) {
  const int tid = threadIdx.x, lane = tid & 63, wid = tid >> 6;
  float* ma = (float*)lds;
  float* mb = ma + 1024;
  const int row0 = item * 32;
  const int cond = cond_of_row(row0);
  const float* mod = (const float*)(p.ws + OFF_MOD) + (size_t)(layer * 3 + cond) * 3072;
  for (int i = tid; i < 1024; i += 512) {
    ma[i] = p.norm_g[layer * 1024 + i] * (1.f + mod[1024 + i]);
    mb[i] = mod[i];
  }
  __syncthreads();
  u16* h = (u16*)(p.ws + OFF_H);
#pragma unroll 1
  for (int i = 0; i < 4; ++i) {
    const int row = row0 + wid * 4 + i;
    const float* x = x_row(p, layer, row);
    float4 v[4];
    float ss = 0.f;
#pragma unroll
    for (int q = 0; q < 4; ++q) {
      v[q] = *(const float4*)(x + q * 256 + lane * 4);
      ss += v[q].x * v[q].x + v[q].y * v[q].y + v[q].z * v[q].z + v[q].w * v[q].w;
    }
    ss = wave_sum(ss);
    const float rstd = rsqrtf(ss * (1.f / 1024.f) + 1e-6f);
#pragma unroll
    for (int q = 0; q < 4; ++q) {
      const int c = q * 256 + lane * 4;
      float4 a = *(const float4*)(ma + c), b = *(const float4*)(mb + c);
      u16x4 o;
      o[0] = f2bf(v[q].x * rstd * a.x + b.x);
      o[1] = f2bf(v[q].y * rstd * a.y + b.y);
      o[2] = f2bf(v[q].z * rstd * a.z + b.z);
      o[3] = f2bf(v[q].w * rstd * a.w + b.w);
      *(u16x4*)(h + ((size_t)((row >> 8) * 16 + (c >> 6)) * 256 + (row & 255)) * 64 + (c & 63)) = o;
    }
  }
  __syncthreads();
}

__device__ __forceinline__ void derive_item(const Params& p, int j, int g, char* lds) {
  const int tid = threadIdx.x;
  float2* pw = (float2*)lds;
  float2* bb = pw + 2 * 17 * 64;
  float2* cc = bb + 2 * 64 * 16;
  float* kt = (float*)(cc + 2 * 16 * 64);
  for (int i = tid; i < 2 * 17 * 64; i += 512) {
    int pp = i & 63, k = (i >> 6) % 17, dir = i / (17 * 64);
    int li = ((j * 2 + dir) * 128 + g) * 64 + pp;
    float lr = p.s5_lam_re[li], lim = p.s5_lam_im[li];
    float st = __expf(p.s5_log_step[(j * 2 + dir) * 128 + g]);
    float mag = __expf((float)k * lr * st);
    float2 cs = cis_rev((double)k * (double)lim * (double)st * 0.15915494309189535);
    pw[i] = make_float2(mag * cs.x, mag * cs.y);
  }
  for (int i = tid; i < 2 * 16 * 64; i += 512) {
    int pp = i & 63, c = (i >> 6) & 15, dir = i >> 10;
    size_t ci = ((size_t)((j * 2 + dir) * 128 + g) * 16 + c) * 64 + pp;
    cc[i] = make_float2(p.s5_c_re[ci], p.s5_c_im[ci]);
  }
  __syncthreads();
  for (int i = tid; i < 2 * 64 * 16; i += 512) {
    int c = i & 15, pp = (i >> 4) & 63, dir = i >> 10;
    int li = ((j * 2 + dir) * 128 + g) * 64 + pp;
    float lr = p.s5_lam_re[li], lim = p.s5_lam_im[li];
    float2 lb = pw[(dir * 17 + 1) * 64 + pp];
    float nr = lb.x - 1.f, ni = lb.y;
    float den = 1.f / (lr * lr + lim * lim);
    float cr = (nr * lr + ni * lim) * den, ci = (ni * lr - nr * lim) * den;
    size_t bi = ((size_t)li) * 16 + c;
    float br = p.s5_b_re[bi], bim = p.s5_b_im[bi];
    bb[i] = make_float2(cr * br - ci * bim, cr * bim + ci * br);
  }
  __syncthreads();
  for (int o = tid; o < 8192; o += 512) {
    int c2 = o & 15, c = (o >> 4) & 15, lag = (o >> 8) & 15, dir = o >> 12;
    float acc = 0.f;
    for (int pp = 0; pp < 64; ++pp) {
      float2 C = cc[(dir * 16 + c) * 64 + pp], P = pw[(dir * 17 + lag) * 64 + pp], B = bb[(dir * 64 + pp) * 16 + c2];
      float cpx = C.x * P.x - C.y * P.y, cpy = C.x * P.y + C.y * P.x;
      acc += cpx * B.x - cpy * B.y;
    }
    kt[o] = acc;
  }
  __syncthreads();
  u16* wbig = (u16*)(p.ws + B_WBIG) + (size_t)g * 256 * 512;
  for (int q = tid; q < 256 * 64; q += 512) {
    int o = q >> 6, k0 = (q & 63) * 8;
    int t = o >> 4, c = o & 15;
    u16x8 v;
    if (k0 < 256) {
      int s = k0 >> 4, c20 = k0 & 15;
      float dsk = p.s5_d[j * 2048 + g * 16 + c];
#pragma unroll
      for (int e = 0; e < 8; ++e) {
        int c2 = c20 + e;
        float val = 0.f;
        if (s <= t) val += kt[((0 * 16 + (t - s)) * 16 + c) * 16 + c2];
        if (s >= t) val += kt[((1 * 16 + (s - t)) * 16 + c) * 16 + c2];
        if (s == t && c2 == c) val += dsk;
        v[e] = f2bf(val);
      }
    } else {
      int dir = k0 >= 384 ? 1 : 0;
      int kk = k0 - 256 - dir * 128;
      int ri = kk >> 6, p0 = kk & 63;
      int e_pow = dir == 0 ? t + 1 : 16 - t;
#pragma unroll
      for (int e = 0; e < 8; ++e) {
        int pp = p0 + e;
        float2 C = cc[(dir * 16 + c) * 64 + pp], P = pw[(dir * 17 + e_pow) * 64 + pp];
        float val = ri == 0 ? (C.x * P.x - C.y * P.y) : -(C.x * P.y + C.y * P.x);
        v[e] = f2bf(val);
      }
    }
    *(u16x8*)(wbig + blkB(o, k0, 8)) = v;
  }
  u16* wst = (u16*)(p.ws + B_WST) + (size_t)g * 256 * 256;
  for (int q = tid; q < 256 * 32; q += 512) {
    int o = q >> 5, k0 = (q & 31) * 8;
    int dir = o >> 7, ri = (o >> 6) & 1, pp = o & 63;
    int s = k0 >> 4, c20 = k0 & 15;
    int e_pow = dir == 0 ? 15 - s : s;
    float2 P = pw[(dir * 17 + e_pow) * 64 + pp];
    u16x8 v;
#pragma unroll
    for (int e = 0; e < 8; ++e) {
      float2 B = bb[(dir * 64 + pp) * 16 + c20 + e];
      float val = ri == 0 ? (P.x * B.x - P.y * B.y) : (P.x * B.y + P.y * B.x);
      v[e] = f2bf(val);
    }
    *(u16x8*)(wst + blkB(o, k0, 4)) = v;
  }
  __syncthreads();
}

__device__ __forceinline__ void wqabs_item(const Params& p, int item, char* lds) {
  const int tid = threadIdx.x;
  const int h = item >> 3, l0 = (item & 7) * 16;
  float* bs = (float*)lds;
  {
    int li = tid >> 5, d4 = (tid & 31) * 4;
    *(float4*)(bs + li * 128 + d4) = *(const float4*)(p.mla_wkv_b + (size_t)(l0 + li) * 4096 + h * 256 + d4);
  }
  __syncthreads();
  const int r = tid & 255, lh = tid >> 8;
  float acc[8];
#pragma unroll
  for (int i = 0; i < 8; ++i) acc[i] = 0.f;
  const float* arow = p.mla_wq_b + (size_t)r * 3072 + h * 192;
  for (int d4 = 0; d4 < 32; ++d4) {
    float4 a = *(const float4*)(arow + d4 * 4);
#pragma unroll
    for (int i = 0; i < 8; ++i) {
      float4 b = *(const float4*)(bs + (lh * 8 + i) * 128 + d4 * 4);
      acc[i] += a.x * b.x + a.y * b.y + a.z * b.z + a.w * b.w;
    }
  }
  u16* wq = (u16*)(p.ws + W_WQ);
#pragma unroll
  for (int i = 0; i < 8; ++i) wq[blkB(h * 192 + l0 + lh * 8 + i, r, 4)] = f2bf(acc[i]);
  __syncthreads();
}

__device__ __forceinline__ void ph_prep(const Params& p, int layer, bool with_ada, bool with_norm, char* lds, int bid, int nb) {
  const int kind = layer % 3, j = layer / 3;
  const int n_special = (kind == 0 || kind == 2) ? 128 : 0;
  const int n_ada = with_ada ? 192 : 0;
  const int n_conv = conv_count(layer);
  const int n_norm = with_norm ? 384 : 0;
  const int total = n_special + n_ada + n_conv + n_norm;
  for (int it = bid; it < total; it += nb) {
    int t = it;
    if (t < n_special) {
      if (kind == 0) derive_item(p, j, t, lds); else wqabs_item(p, t, lds);
      continue;
    }
    t -= n_special;
    if (t < n_ada) { ada_item(p, t, lds); continue; }
    t -= n_ada;
    if (t < n_norm) { norm_item(p, layer, t, lds); continue; }
    t -= n_norm;
    conv_item(p, layer, t, lds);
  }
}
__device__ __forceinline__ void ph_norm(const Params& p, int layer, char* lds, int bid, int nb) {
  for (int it = bid; it < 384; it += nb) norm_item(p, layer, it, lds);
}

__device__ __forceinline__ void tile_mn(int t, int MT, int NT, int& mt, int& nt) {
  int per = 8 * NT;
  int grp = t / per, r = t % per;
  int gm = MT - grp * 8; gm = gm > 8 ? 8 : gm;
  mt = grp * 8 + r % gm; nt = r / gm;
}

__device__ __forceinline__ void ph_inproj(const Params& p, char* lds, int bid, int nb) {
  const u16* h = (const u16*)(p.ws + OFF_H);
  const u16* w = (const u16*)(p.ws + W_WIN);
  u16* uz = (u16*)(p.ws + OFF_A);
  for (int l = (bid >> 3); l < 96; l += (nb >> 3)) {
    const int xi = (bid & 7) >> 2, xj = bid & 3;
    const int mt = xi * 24 + (l >> 2), nt = xj * 4 + (l & 3);
    const int m0 = mt * 256, n0 = nt * 256;
    f32x4 acc[8][4];
    gemm_loop2<8>(lds, 16,
        [&](int r, int k) { return h + blkA(m0 + r, k, 16); },
        [&](int r, int k) { return w + blkB(n0 + r, k, 16); }, acc, 256 * 64, 128 * 64);
    EPI2_LOOP(8) {
      const int row = EPI2_ROW(m0, 8), col = EPI2_COL(n0);
      f32x4 v = acc[mi][ni];
      if (col >= 2048) {
        v[0] = fsilu(v[0]); v[1] = fsilu(v[1]); v[2] = fsilu(v[2]); v[3] = fsilu(v[3]);
        *(u16x4*)(uz + (size_t)NT_TOK * 2048 + (size_t)row * 2048 + (col - 2048)) = pack4(v);
      } else {
        *(u16x4*)(uz + ugaddr(row, col)) = pack4(v);
      }
    }
  }
}

__device__ __forceinline__ void ph_s5g1(const Params& p, char* lds, int bid, int nb) {
  const u16* uz = (const u16*)(p.ws + OFF_A);
  u16* X = (u16*)(p.ws + OFF_C);
  for (int t = bid; t < 768; t += nb) {
    const int g = t / 6, mt = (t % 6) >> 1, nt = t & 1;
    const int m0 = mt * 256, n0 = nt * 128;
    const u16* w = (const u16*)(p.ws + B_WST) + (size_t)g * 65536;
    f32x4 acc[4][4];
    gemm_loop<4, 2, true, true>(lds, 4,
        [&](int r, int k) { return uz + ((size_t)(g * 768 + m0 + r)) * 256 + k; },
        [&](int r, int k) { return w + ((size_t)(nt * 4) * 128 + r) * 64 + k; }, acc, 64, 128 * 64);
    EPI_LOOP(4, 2) {
      const int row = EPI_ROW(m0), col = EPI_COL(n0);
      *(u16x4*)(X + xaddr(row, g, col)) = pack4(acc[mi][ni]);
    }
  }
}

__device__ __forceinline__ void ph_scan(const Params& p, int j, int bid, int nb) {
  const int tid = threadIdx.x;
  u16* X = (u16*)(p.ws + OFF_C);
  for (int it = bid; it < 1088; it += nb) {
    int b, gq, r0, nc; bool sample;
    if (it < 64) { sample = true; b = it >> 5; gq = it & 31; r0 = 512 + b * 128; nc = 128; }
    else { int q = it - 64; sample = false; b = q >> 5; gq = q & 31; r0 = b * 16; nc = 16; }
    const int g = gq * 4 + (tid >> 7), dir = (tid >> 6) & 1, pp = tid & 63;
    const int li = ((j * 2 + dir) * 128 + g) * 64 + pp;
    const float lr = p.s5_lam_re[li], lim = p.s5_lam_im[li];
    const float st = __expf(p.s5_log_step[(j * 2 + dir) * 128 + g]);
    const float mag = __expf(16.f * lr * st);
    const float2 cs = cis_rev(16.0 * (double)lim * (double)st * 0.15915494309189535);
    const float ar = mag * cs.x, ai = mag * cs.y;
    float pr = 0.f, pi = 0.f;
    if (sample) {
      size_t si = ((size_t)((b * 2 + j) * 2 + dir) * 128 + g) * 64 + pp;
      pr = p.st_re[si]; pi = p.st_im[si];
    }
    u16* base = X + xaddr(r0, g, dir * 128 + pp);
    const size_t cstride = 64;
    if (dir == 0) {
#pragma unroll 8
      for (int c = 0; c < nc; ++c) {
        u16* q = base + (size_t)c * cstride;
        float sr = bf2f(q[0]), si = bf2f(q[8192]);
        q[0] = f2bf(pr); q[8192] = f2bf(pi);
        float nr = ar * pr - ai * pi + sr, ni = ar * pi + ai * pr + si;
        pr = nr; pi = ni;
      }
    } else {
#pragma unroll 8
      for (int c = nc - 1; c >= 0; --c) {
        u16* q = base + (size_t)c * cstride;
        float sr = bf2f(q[0]), si = bf2f(q[8192]);
        q[0] = f2bf(pr); q[8192] = f2bf(pi);
        float nr = ar * pr - ai * pi + sr, ni = ar * pi + ai * pr + si;
        pr = nr; pi = ni;
      }
    }
    if (!sample) {
      size_t oi = ((size_t)((b * 2 + j) * 2 + dir) * 128 + g) * 64 + pp;
      p.out[OUT_RE + oi] = pr;
      p.out[OUT_IM + oi] = pi;
    }
  }
}

__device__ __forceinline__ void ph_s5g3(const Params& p, char* lds, int bid, int nb) {
  u16* uz = (u16*)(p.ws + OFF_A);
  const u16* X = (const u16*)(p.ws + OFF_C);
  for (int t = bid; t < 768; t += nb) {
    const int g = t / 6, mt = t % 6;
    const int m0 = mt * 128;
    const u16* w = (const u16*)(p.ws + B_WBIG) + (size_t)g * 131072;
    f32x4 acc[4][4];
    gemm_loop<2, 4, false, true>(lds, 8,
        [&](int r, int k) {
          return k < 256 ? (const u16*)(uz + ((size_t)(g * 768 + m0 + r)) * 256 + k)
                         : X + xaddr(m0 + r, g, k - 256);
        },
        [&](int r, int k) { return w + ((size_t)((r >> 7) * 8) * 128 + (r & 127)) * 64 + k; }, acc, 64, 128 * 64);
    EPI_LOOP(2, 4) {
      const int row = EPI_ROW(m0), col = EPI_COL(0);
      f32x4 v = acc[mi][ni];
      v[0] = fgelu(v[0]); v[1] = fgelu(v[1]); v[2] = fgelu(v[2]); v[3] = fgelu(v[3]);
      *(u16x4*)(uz + ((size_t)(g * 768 + row)) * 256 + col) = pack4(v);
    }
  }
}

__device__ __forceinline__ void ph_glu(const Params& p, int j, char* lds, int bid, int nb) {
  const u16* uz = (const u16*)(p.ws + OFF_A);
  const u16* w = (const u16*)(p.ws + W_GLU);
  u16* m = (u16*)(p.ws + OFF_C);
  for (int l = (bid >> 3); l < 64; l += (nb >> 3)) {
    const int xi = (bid & 7) >> 2, xj = bid & 3;
    const int mt = xi * 32 + (l >> 1), nt = xj * 2 + (l & 1);
    const int m0 = mt * 192, n0 = nt * 256;
    f32x4 acc[6][4];
    gemm_loop2<6>(lds, 32,
        [&](int r, int k) { return uz + ugaddr(m0 + r, k); },
        [&](int r, int k) { return w + blkB(n0 + r, k, 32); }, acc, 4 * 768 * 256, 128 * 64);
    EPI2_LOOP(6) {
      const int row = EPI2_ROW(m0, 6), col = EPI2_COL(n0);
      f32x4 v = acc[mi][ni];
      float4 gb = *(const float4*)(p.s5_glu_b + j * 2048 + col);
      u16x4 yv = *(const u16x4*)(uz + ugaddr(row, col));
      u16x4 zv = *(const u16x4*)(uz + (size_t)NT_TOK * 2048 + (size_t)row * 2048 + col);
      f32x4 o;
      o[0] = bf2f(yv[0]) * fsigmoid(v[0] + gb.x) * bf2f(zv[0]);
      o[1] = bf2f(yv[1]) * fsigmoid(v[1] + gb.y) * bf2f(zv[1]);
      o[2] = bf2f(yv[2]) * fsigmoid(v[2] + gb.z) * bf2f(zv[2]);
      o[3] = bf2f(yv[3]) * fsigmoid(v[3] + gb.w) * bf2f(zv[3]);
      *(u16x4*)(m + blkA(row, col, 32)) = pack4(o);
    }
  }
}

__device__ __forceinline__ void ph_out(const Params& p, int layer, const u16* m, char* lds, int bid, int nb) {
  const u16* w = (const u16*)(p.ws + W_WOUT);
  const float* mod = (const float*)(p.ws + OFF_MOD);
  for (int t = bid; t < 256; t += nb) {
    const int mt = (t & 7) * 8 + (t >> 5), nt = (t >> 3) & 3;
    const int m0 = mt * 192, n0 = nt * 256;
    f32x4 acc[6][4];
    gemm_loop2<6>(lds, 32,
        [&](int r, int k) { return m + blkA(m0 + r, k, 32); },
        [&](int r, int k) { return w + blkB(n0 + r, k, 32); }, acc, 256 * 64, 128 * 64);
    const int lane = threadIdx.x & 63, wid = threadIdx.x >> 6;
    const int wr = wid >> 2, wc = wid & 3, fr = lane & 15, fq = lane >> 4;
#pragma unroll
    for (int mi = 0; mi < 6; ++mi) {
      const int row = m0 + wr * 96 + mi * 16 + fr;
      const float* gate = mod + (size_t)(layer * 3 + cond_of_row(row)) * 3072 + 2048;
      const float* xo_p = x_row(p, layer, row);
#pragma unroll
      for (int ni = 0; ni < 4; ++ni) {
        const int col = n0 + wc * 64 + ni * 16 + fq * 4;
        f32x4 v = acc[mi][ni];
        float4 gt = *(const float4*)(gate + col);
        float4 xo = *(const float4*)(xo_p + col);
        float4 o;
        o.x = xo.x + gt.x * v[0]; o.y = xo.y + gt.y * v[1]; o.z = xo.z + gt.z * v[2]; o.w = xo.w + gt.w * v[3];
        *(float4*)(p.out + (size_t)row * 1024 + col) = o;
      }
    }
  }
}

template <int WIN>
__device__ __forceinline__ void pool_unit(const u16* uz, u16* pb, int g, int tok, int half) {
  int t, L, base;
  if (tok < 8192) { L = 256; t = tok & 255; base = tok - t; }
  else { L = 2048; t = (tok - 8192) & 2047; base = tok - t; }
  constexpr int lo = WIN / 2;
  const int ch0 = g * 16 + half * 8;
  float acc[8];
#pragma unroll
  for (int e = 0; e < 8; ++e) acc[e] = 0.f;
  u16x8 self;
#pragma unroll
  for (int i = 0; i < WIN; ++i) {
    const int sp = t - lo + i;
    const bool valid = sp >= 0 && sp < L;
    const int sc = sp < 0 ? 0 : (sp >= L ? L - 1 : sp);
    u16x8 v = *(const u16x8*)(uz + ugaddr(base + sc, ch0));
    if (i == lo) self = v;
    const float wgt = valid ? 1.f : 0.f;
#pragma unroll
    for (int e = 0; e < 8; ++e) acc[e] += wgt * bf2f(v[e]);
  }
  int s0 = t - lo; if (s0 < 0) s0 = 0;
  int s1 = t - lo + WIN; if (s1 > L) s1 = L;
  const float inv = 1.f / (float)(s1 - s0);
  u16x8 o;
#pragma unroll
  for (int e = 0; e < 8; ++e) o[e] = f2bf(acc[e] * inv - bf2f(self[e]));
  *(u16x8*)(pb + blkA(tok, ch0, 32)) = o;
}
__device__ __forceinline__ void ph_pool(const Params& p, int bid, int nb) {
  const u16* uz = (const u16*)(p.ws + OFF_A);
  u16* pb = (u16*)(p.ws + OFF_B);
  const int lane = threadIdx.x & 63, wid = threadIdx.x >> 6;
  for (int u = bid * 8 + wid; u < 128 * 384; u += nb * 8) {
    const int g = u / 384, run = u % 384;
    const int tok = run * 32 + (lane >> 1), half = lane & 1;
    const int gi = g >> 5;
    if (gi == 0) pool_unit<2>(uz, pb, g, tok, half);
    else if (gi == 1) pool_unit<4>(uz, pb, g, tok, half);
    else if (gi == 2) pool_unit<8>(uz, pb, g, tok, half);
    else pool_unit<16>(uz, pb, g, tok, half);
  }
}

__device__ __forceinline__ void ph_poolmm(const Params& p, int j, char* lds, int bid, int nb) {
  const u16* pb = (const u16*)(p.ws + OFF_B);
  const u16* w = (const u16*)(p.ws + W_POOLW);
  const u16* uz = (const u16*)(p.ws + OFF_A);
  u16* m = (u16*)(p.ws + OFF_C);
  for (int l = (bid >> 3); l < 48 * 2; l += (nb >> 3)) {
    const int mt = l / 2, nt = (bid & 7) * 2 + l % 2;
    const int m0 = mt * 256, n0 = nt * 128, gi = n0 >> 9;
    f32x4 acc[4][4];
    gemm_loop<4, 2, true, true>(lds, 8,
        [&](int r, int k) { return pb + ((size_t)(mt * 32 + gi * 8) * 256 + r) * 64 + k; },
        [&](int r, int k) { return w + ((size_t)(nt * 8) * 128 + r) * 64 + k; }, acc, 256 * 64, 128 * 64);
    EPI_LOOP(4, 2) {
      const int row = EPI_ROW(m0), col = EPI_COL(n0);
      f32x4 v = acc[mi][ni];
      float4 sc = *(const float4*)(p.pool_scale + j * 2048 + col);
      u16x4 zv = *(const u16x4*)(uz + (size_t)NT_TOK * 2048 + (size_t)row * 2048 + col);
      f32x4 o;
      o[0] = v[0] * sc.x * bf2f(zv[0]); o[1] = v[1] * sc.y * bf2f(zv[1]);
      o[2] = v[2] * sc.z * bf2f(zv[2]); o[3] = v[3] * sc.w * bf2f(zv[3]);
      *(u16x4*)(m + blkA(row, col, 32)) = pack4(o);
    }
  }
}

__device__ __forceinline__ void ph_inproj_mla(const Params& p, char* lds, int bid, int nb) {
  const u16* h = (const u16*)(p.ws + OFF_H);
  const u16* w = (const u16*)(p.ws + W_WIN);
  float* qa = (float*)(p.ws + A_QA);
  float* ckvf = (float*)(p.ws + A_CKVF);
  float* kpef = (float*)(p.ws + A_KPEF);
  u16* zb = (u16*)(p.ws + OFF_B);
  for (int t = bid; t < 48 * 20; t += nb) {
    int mt, nt; tile_mn(t, 48, 20, mt, nt);
    const int m0 = mt * 256, n0 = nt * 128;
    f32x4 acc[4][4];
    gemm_loop<4, 2, true, true>(lds, 16,
        [&](int r, int k) { return h + ((size_t)(mt * 16) * 256 + r) * 64 + k; },
        [&](int r, int k) { int n = n0 + r; n = n > 2495 ? 2495 : n; return w + ((size_t)((n >> 7) * 16) * 128 + (n & 127)) * 64 + k; }, acc, 256 * 64, 128 * 64);
    EPI_LOOP(4, 2) {
      const int row = EPI_ROW(m0), col = EPI_COL(n0);
      f32x4 v = acc[mi][ni];
      if (col < 256) {
        *(f32x4*)(qa + (size_t)row * 256 + col) = v;
      } else if (col < 384) {
        *(f32x4*)(ckvf + (size_t)row * 128 + (col - 256)) = v;
      } else if (col < 448) {
        *(f32x4*)(kpef + (size_t)row * 64 + (col - 384)) = v;
      } else if (col < 2496) {
        v[0] = fsilu(v[0]); v[1] = fsilu(v[1]); v[2] = fsilu(v[2]); v[3] = fsilu(v[3]);
        *(u16x4*)(zb + (size_t)row * 2048 + (col - 448)) = pack4(v);
      }
    }
  }
}

__device__ __forceinline__ int vt_slot(int pos) {
  int k = pos & 31;
  return (pos & ~31) | (((k >> 2) & 3) * 8 + (k >> 4) * 4 + (k & 3));
}

__device__ __forceinline__ void ph_mlanorm(const Params& p, int j, char* lds, int bid, int nb) {
  const int tid = threadIdx.x, lane = tid & 63, wid = tid >> 6;
  const float* qa = (const float*)(p.ws + A_QA);
  const float* ckvf = (const float*)(p.ws + A_CKVF);
  const float* kpef = (const float*)(p.ws + A_KPEF);
  u16* qan = (u16*)(p.ws + OFF_QAN);
  u16* Kb = (u16*)(p.ws + OFF_KB);
  u16* VT = (u16*)(p.ws + OFF_VT);
  u16* tile = (u16*)lds;
  for (int it = bid; it < 208; it += nb) {
    const bool cache = it >= 192;
    int kvrow0, pos0, Lk; size_t vtbase;
    int tok0 = 0, cb = 0, ci0 = 0;
    bool sample = false;
    if (!cache) {
      tok0 = it * 64;
      if (tok0 < 8192) { int b = tok0 >> 8; pos0 = tok0 & 255; kvrow0 = tok0; Lk = 256; vtbase = (size_t)b * 128 * 256; }
      else { sample = true; int b = (tok0 - 8192) >> 11; int t0 = (tok0 - 8192) & 2047; pos0 = 512 + t0;
             kvrow0 = 8192 + b * 2560 + pos0; Lk = 2560; vtbase = (size_t)32 * 128 * 256 + (size_t)b * 128 * 2560; }
    } else {
      int q = it - 192; cb = q >> 3; ci0 = (q & 7) * 64; pos0 = ci0;
      kvrow0 = 8192 + cb * 2560 + pos0; Lk = 2560; vtbase = (size_t)32 * 128 * 256 + (size_t)cb * 128 * 2560;
    }
#pragma unroll 1
    for (int i = 0; i < 8; ++i) {
      const int rl = wid * 8 + i;
      float c0, c1, kp;
      if (!cache) {
        const int tok = tok0 + rl;
        float4 qv = *(const float4*)(qa + (size_t)tok * 256 + lane * 4);
        float ss = wave_sum(qv.x * qv.x + qv.y * qv.y + qv.z * qv.z + qv.w * qv.w);
        float rs = rsqrtf(ss * (1.f / 256.f) + 1e-6f);
        float4 qg = *(const float4*)(p.mla_q_norm + j * 256 + lane * 4);
        u16x4 qo;
        qo[0] = f2bf(qv.x * rs * qg.x); qo[1] = f2bf(qv.y * rs * qg.y);
        qo[2] = f2bf(qv.z * rs * qg.z); qo[3] = f2bf(qv.w * rs * qg.w);
        *(u16x4*)(qan + blkA(tok, lane * 4, 4)) = qo;
        float2 cv = *(const float2*)(ckvf + (size_t)tok * 128 + lane * 2);
        float s2 = wave_sum(cv.x * cv.x + cv.y * cv.y);
        float r2 = rsqrtf(s2 * (1.f / 128.f) + 1e-6f);
        float2 kg = *(const float2*)(p.mla_kv_norm + j * 128 + lane * 2);
        c0 = cv.x * r2 * kg.x; c1 = cv.y * r2 * kg.y;
        float x = kpef[(size_t)tok * 64 + lane];
        if (!sample) {
          *(float2*)(p.out + OUT_CKV + (size_t)tok * 128 + lane * 2) = make_float2(c0, c1);
          p.out[OUT_KPE + (size_t)tok * 64 + lane] = x;
          kp = x;
        } else {
          const int tpos = (tok - 8192) & 2047;
          const int axis = lane >> 5, within = lane & 31, fi = within & 15, isx2 = within >> 4;
          float xp = __shfl_xor(x, 16);
          float posf = (float)(axis == 0 ? (tpos >> 6) : (tpos & 63));
          float inv = __builtin_amdgcn_exp2f(-(float)fi * 0.830482023721841f);
          float rev = posf * inv * 0.15915494309189535f;
          rev -= rintf(rev);
          float cs = __builtin_amdgcn_cosf(rev), sn = __builtin_amdgcn_sinf(rev);
          float x1 = isx2 ? xp : x, x2 = isx2 ? x : xp;
          kp = isx2 ? (x1 * sn + x2 * cs) : (x1 * cs - x2 * sn);
        }
      } else {
        const size_t ci = (size_t)(cb * 1 + j) * 512 + ci0 + rl;
        float2 cv = *(const float2*)(p.cache_ckv + ci * 128 + lane * 2);
        c0 = cv.x; c1 = cv.y;
        kp = p.cache_kpe[ci * 64 + lane];
      }
      const size_t kr = (size_t)(kvrow0 + rl);
      unsigned pk = (unsigned)f2bf(c0) | ((unsigned)f2bf(c1) << 16);
      *(unsigned*)(Kb + kr * 192 + lane * 2) = pk;
      Kb[kr * 192 + 128 + lane] = f2bf(kp);
      *(unsigned*)(tile + rl * 136 + lane * 2) = pk;
    }
    __syncthreads();
    {
      const int d = tid >> 2, part = tid & 3;
      u16x8 o0, o1;
#pragma unroll
      for (int e = 0; e < 16; ++e) {
        int s = part * 16 + e;
        int blk = s >> 5, sl = s & 31;
        int kgq = sl >> 3, sub = (sl >> 2) & 1, jj = sl & 3;
        int kap = sub * 16 + kgq * 4 + jj;
        u16 v = tile[(blk * 32 + kap) * 136 + d];
        if (e < 8) o0[e] = v; else o1[e - 8] = v;
      }
      u16* dst = VT + vtbase + ((size_t)(pos0 >> 6) * 128 + d) * 64 + part * 16;
      *(u16x8*)(dst) = o0;
      *(u16x8*)(dst + 8) = o1;
    }
    __syncthreads();
  }
}

__device__ __forceinline__ void ph_qgemm(const Params& p, char* lds, int bid, int nb) {
  const u16* qan = (const u16*)(p.ws + OFF_QAN);
  const u16* w = (const u16*)(p.ws + W_WQ);
  u16* q = (u16*)(p.ws + OFF_A);
  const float SC = 0.07216878364870322f * 1.4426950408889634f;
  for (int l = (bid >> 3); l < 48 * 3; l += (nb >> 3)) {
    const int mt = l / 3, nt = (bid & 7) * 3 + l % 3;
    const int m0 = mt * 256, n0 = nt * 128;
    f32x4 acc[4][4];
    gemm_loop<4, 2, true, true>(lds, 4,
        [&](int r, int k) { return qan + ((size_t)(mt * 4) * 256 + r) * 64 + k; },
        [&](int r, int k) { return w + ((size_t)(nt * 4) * 128 + r) * 64 + k; }, acc, 256 * 64, 128 * 64);
    const int lane = threadIdx.x & 63, wid = threadIdx.x >> 6;
    const int wr = wid >> 1, wc = wid & 1, fr = lane & 15, fq = lane >> 4;
    const int cb = n0 + wc * 64;
    const bool rope = (m0 >= 8192) && ((cb % 192) == 128);
#pragma unroll
    for (int mi = 0; mi < 4; ++mi) {
      const int row = m0 + wr * 64 + mi * 16 + fr;
      f32x4 v[4];
#pragma unroll
      for (int ni = 0; ni < 4; ++ni) v[ni] = acc[mi][ni];
      if (rope) {
        const int tpos = (row - 8192) & 2047;
#pragma unroll
        for (int ax = 0; ax < 2; ++ax) {
          const float posf = (float)(ax == 0 ? (tpos >> 6) : (tpos & 63));
#pragma unroll
          for (int jj = 0; jj < 4; ++jj) {
            const int fi = fq * 4 + jj;
            float inv = __builtin_amdgcn_exp2f(-(float)fi * 0.830482023721841f);
            float rev = posf * inv * 0.15915494309189535f;
            rev -= rintf(rev);
            float cs = __builtin_amdgcn_cosf(rev), sn = __builtin_amdgcn_sinf(rev);
            float x1 = v[ax * 2][jj], x2 = v[ax * 2 + 1][jj];
            v[ax * 2][jj] = x1 * cs - x2 * sn;
            v[ax * 2 + 1][jj] = x1 * sn + x2 * cs;
          }
        }
      }
#pragma unroll
      for (int ni = 0; ni < 4; ++ni) {
        f32x4 o = v[ni];
        o[0] *= SC; o[1] *= SC; o[2] *= SC; o[3] *= SC;
        *(u16x4*)(q + (size_t)row * 3072 + cb + ni * 16 + fq * 4) = pack4(o);
      }
    }
  }
}

__device__ __forceinline__ void ph_attn(const Params& p, char* lds, int bid, int nb) {
  const int tid = threadIdx.x, lane = tid & 63, wid = tid >> 6, fr = lane & 15, fq = lane >> 4;
  const u16* q = (const u16*)(p.ws + OFF_A);
  const u16* Kb = (const u16*)(p.ws + OFF_KB);
  const u16* VT = (const u16*)(p.ws + OFF_VT);
  u16* ol = (u16*)(p.ws + OFF_C);
  for (int it = bid; it < 768; it += nb) {
    int h, tokq0, kvbase, Lk; size_t vtbase;
    if (it < 256) { int b = it >> 7, qt = (it >> 4) & 7; h = it & 15; tokq0 = 8192 + b * 2048 + qt * 256;
                    kvbase = 8192 + b * 2560; Lk = 2560; vtbase = (size_t)32 * 128 * 256 + (size_t)b * 128 * 2560; }
    else { int r = it - 256; int b = r >> 4; h = r & 15; tokq0 = b * 256; kvbase = b * 256; Lk = 256;
           vtbase = (size_t)b * 128 * 256; }
    const int nkt = Lk >> 6;
    const u16* vt = VT + vtbase;
    bf16x8 qf[2][6];
#pragma unroll
    for (int qs = 0; qs < 2; ++qs)
#pragma unroll
      for (int ks = 0; ks < 6; ++ks)
        qf[qs][ks] = *(const bf16x8*)(q + (size_t)(tokq0 + wid * 32 + qs * 16 + fr) * 3072 + h * 192 + ks * 32 + fq * 8);
    f32x4 O[8][2];
#pragma unroll
    for (int d = 0; d < 8; ++d) { O[d][0] = f32x4{0, 0, 0, 0}; O[d][1] = f32x4{0, 0, 0, 0}; }
    float mrun[2] = {-1e30f, -1e30f}, lrun[2] = {0.f, 0.f};

    int koff[3], voff[2];
#pragma unroll
    for (int i = 0; i < 3; ++i) {
      int idx = tid + i * 512;
      int r = idx / 24, pos = idx - r * 24;
      int kc = (pos & ~7) | ((pos ^ r) & 7);
      koff[i] = r * 192 + kc * 8;
    }
#pragma unroll
    for (int i = 0; i < 2; ++i) {
      int idx = tid + i * 512;
      int d = idx >> 3, pos = idx & 7;
      voff[i] = d * 64 + ((pos ^ (d & 7)) * 8);
    }
    const u16* kbase = Kb + (size_t)kvbase * 192;
    auto glds_kv = [&](int i, int kt, int buf) {
      char* base = lds + buf * 40960 + tid * 16;
      if (i < 3) glds16(kbase + kt * (64 * 192) + koff[i], base + i * 8192);
      else glds16(vt + kt * (128 * 64) + voff[i - 3], base + 24576 + (i - 3) * 8192);
    };
#pragma unroll
    for (int i = 0; i < 5; ++i) glds_kv(i, 0, 0);
    for (int kt = 0; kt < nkt; ++kt) {
      const int cur = kt & 1;
      WAIT_VM(0);
      BARRIER();
      const bool pfn = kt + 1 < nkt;
      const char* kb = lds + cur * 40960;
      const char* vb = kb + 24576;
      f32x4 s[4][2];
#pragma unroll
      for (int sub = 0; sub < 4; ++sub) { s[sub][0] = f32x4{0, 0, 0, 0}; s[sub][1] = f32x4{0, 0, 0, 0}; }
#pragma unroll
      for (int ks = 0; ks < 6; ++ks) {
        const int coff = ((ks >> 1) * 8 + ((((ks & 1) * 4 + fq) ^ fr) & 7)) * 16;
#pragma unroll
        for (int sub = 0; sub < 4; ++sub) {
          bf16x8 kf = *(const bf16x8*)(kb + (sub * 16 + fr) * 384 + coff);
          s[sub][0] = __builtin_amdgcn_mfma_f32_16x16x32_bf16(kf, qf[0][ks], s[sub][0], 0, 0, 0);
          s[sub][1] = __builtin_amdgcn_mfma_f32_16x16x32_bf16(kf, qf[1][ks], s[sub][1], 0, 0, 0);
        }
        if (ks < 5) {
          __builtin_amdgcn_sched_barrier(0);
          if (pfn) glds_kv(ks, kt + 1, cur ^ 1);
          __builtin_amdgcn_sched_barrier(0);
        }
      }
      bf16x8 pf[2][2];
#pragma unroll
      for (int qs = 0; qs < 2; ++qs) {
        float mx = s[0][qs][0];
#pragma unroll
        for (int sub = 0; sub < 4; ++sub)
#pragma unroll
          for (int jj = 0; jj < 4; ++jj) mx = fmaxf(mx, s[sub][qs][jj]);
        mx = fmaxf(mx, __shfl_xor(mx, 16));
        mx = fmaxf(mx, __shfl_xor(mx, 32));
        const float mnew = fmaxf(mrun[qs], mx);
        const float alpha = __builtin_amdgcn_exp2f(mrun[qs] - mnew);
        mrun[qs] = mnew;
        float ps = 0.f;
#pragma unroll
        for (int sub = 0; sub < 4; ++sub)
#pragma unroll
          for (int jj = 0; jj < 4; ++jj) {
            float e = __builtin_amdgcn_exp2f(s[sub][qs][jj] - mnew);
            s[sub][qs][jj] = e;
            ps += e;
          }
        lrun[qs] = lrun[qs] * alpha + ps;
#pragma unroll
        for (int d = 0; d < 8; ++d) { O[d][qs][0] *= alpha; O[d][qs][1] *= alpha; O[d][qs][2] *= alpha; O[d][qs][3] *= alpha; }
#pragma unroll
        for (int kbk = 0; kbk < 2; ++kbk) {
          bf16x8 f;
#pragma unroll
          for (int jj = 0; jj < 4; ++jj) {
            f[jj] = (short)f2bf(s[kbk * 2][qs][jj]);
            f[4 + jj] = (short)f2bf(s[kbk * 2 + 1][qs][jj]);
          }
          pf[kbk][qs] = f;
        }
      }
#pragma unroll
      for (int d = 0; d < 8; ++d)
#pragma unroll
        for (int kbk = 0; kbk < 2; ++kbk) {
          bf16x8 vf = *(const bf16x8*)(vb + (d * 16 + fr) * 128 + (((kbk * 4 + fq) ^ (fr & 7)) << 4));
          O[d][0] = __builtin_amdgcn_mfma_f32_16x16x32_bf16(vf, pf[kbk][0], O[d][0], 0, 0, 0);
          O[d][1] = __builtin_amdgcn_mfma_f32_16x16x32_bf16(vf, pf[kbk][1], O[d][1], 0, 0, 0);
        }
    }
    BARRIER();
#pragma unroll
    for (int qs = 0; qs < 2; ++qs) {
      float l = lrun[qs];
      l += __shfl_xor(l, 16);
      l += __shfl_xor(l, 32);
      const float il = 1.f / l;
      const int tok = tokq0 + wid * 32 + qs * 16 + fr;
#pragma unroll
      for (int d = 0; d < 8; ++d) {
        f32x4 o = O[d][qs];
        o[0] *= il; o[1] *= il; o[2] *= il; o[3] *= il;
        *(u16x4*)(ol + blkA(tok, h * 128 + d * 16 + fq * 4, 32)) = pack4(o);
      }
    }
  }
}

__device__ __forceinline__ void ph_oexp(const Params& p, char* lds, int bid, int nb) {
  const u16* ol = (const u16*)(p.ws + OFF_C);
  const u16* w = (const u16*)(p.ws + W_WUV);
  const u16* zb = (const u16*)(p.ws + OFF_B);
  u16* mo = (u16*)(p.ws + OFF_A);
  for (int l = (bid >> 3); l < 48 * 2; l += (nb >> 3)) {
    const int mt = l / 2, nt = (bid & 7) * 2 + l % 2;
    const int m0 = mt * 256, n0 = nt * 128;
    f32x4 acc[4][4];
    gemm_loop<4, 2, true, true>(lds, 2,
        [&](int r, int k) { return ol + ((size_t)(mt * 32 + nt * 2) * 256 + r) * 64 + k; },
        [&](int r, int k) { return w + ((size_t)(nt * 2) * 128 + r) * 64 + k; }, acc, 256 * 64, 128 * 64);
    EPI_LOOP(4, 2) {
      const int row = EPI_ROW(m0), col = EPI_COL(n0);
      f32x4 v = acc[mi][ni];
      u16x4 zv = *(const u16x4*)(zb + (size_t)row * 2048 + col);
      v[0] *= bf2f(zv[0]); v[1] *= bf2f(zv[1]); v[2] *= bf2f(zv[2]); v[3] *= bf2f(zv[3]);
      *(u16x4*)(mo + blkA(row, col, 32)) = pack4(v);
    }
  }
}

__device__ __forceinline__ void ph_final(const Params& p, int bid, int nb) {
  const int lane = threadIdx.x & 63, wid = threadIdx.x >> 6;
  for (int row = bid * 8 + wid; row < NT_TOK; row += nb * 8) {
    float* x = p.out + (size_t)row * 1024;
    float4 v[4];
    float ss = 0.f;
#pragma unroll
    for (int q = 0; q < 4; ++q) {
      v[q] = *(const float4*)(x + q * 256 + lane * 4);
      ss += v[q].x * v[q].x + v[q].y * v[q].y + v[q].z * v[q].z + v[q].w * v[q].w;
    }
    ss = wave_sum(ss);
    const float rstd = rsqrtf(ss * (1.f / 1024.f) + 1e-6f);
#pragma unroll
    for (int q = 0; q < 4; ++q) {
      float4 g = *(const float4*)(p.final_g + q * 256 + lane * 4);
      float4 o;
      o.x = v[q].x * rstd * g.x; o.y = v[q].y * rstd * g.y; o.z = v[q].z * rstd * g.z; o.w = v[q].w * rstd * g.w;
      *(float4*)(x + q * 256 + lane * 4) = o;
    }
  }
}

#define XB_TMO      128
#define XB_XCNT(j)  (256  + 64 * (j))
#define XB_XSUB(j)  (1280 + 64 * (j))
#define XB_XGEN(j)  (2304 + 64 * (j))
#define XB_TOP      3328
#define XB_TOPGEN   3392
#define XCD_BAR_WORDS 3456
#define XB_SPIN_CAP (1u << 18)
#define LAS __attribute__((address_space(3)))

__device__ __forceinline__ unsigned xb_ld(unsigned* p)              { return __hip_atomic_load(p, __ATOMIC_RELAXED, __HIP_MEMORY_SCOPE_AGENT); }
__device__ __forceinline__ unsigned xb_add(unsigned* p, unsigned v) { return __hip_atomic_fetch_add(p, v, __ATOMIC_RELAXED, __HIP_MEMORY_SCOPE_AGENT); }
__device__ __forceinline__ unsigned xb_xcc_id() { return (unsigned)__builtin_amdgcn_s_getreg((3 << 11) | 20) & 0xFu; }
#define XB_SPIN(cond, bar) do { unsigned _sp = 0; while (cond) { __builtin_amdgcn_s_sleep(1); \
    if ((++_sp & 255u) == 0u) { if (xb_ld(&(bar)[XB_TMO])) break; if (_sp > XB_SPIN_CAP) { atomicAdd(&(bar)[XB_TMO], 1u); break; } } } } while (0)

struct XcdBarrier {
    unsigned* bar; unsigned x;
    volatile LAS unsigned* st;
};

__device__ __forceinline__ XcdBarrier xcd_barrier_post(unsigned* bar, volatile LAS unsigned* st) {
    XcdBarrier b; b.bar = bar; b.x = xb_xcc_id(); b.st = st;
    if (threadIdx.x == 0) (void)xb_add(&bar[XB_XCNT(b.x)], 1u);
    return b;
}
__device__ __forceinline__ void xcd_barrier_complete(unsigned* bar, unsigned x, unsigned& nloc, unsigned& nx) {
    const unsigned G = gridDim.x * gridDim.y * gridDim.z;
    unsigned sum, cnt, mine, sp = 0u;
    for (;;) {
        sum = 0u; cnt = 0u; mine = 0u;
#pragma unroll
        for (unsigned j = 0; j < 16; ++j) { const unsigned c = xb_ld(&bar[XB_XCNT(j)]); sum += c; cnt += (c > 0u) ? 1u : 0u; mine = (j == x) ? c : mine; }
        if (sum == G) break;
        __builtin_amdgcn_s_sleep(1);
        if ((++sp & 255u) == 0u) { if (xb_ld(&bar[XB_TMO])) break; if (sp > XB_SPIN_CAP) { atomicAdd(&bar[XB_TMO], 1u); break; } }
    }
    nloc = mine > 0u ? mine : 1u; nx = cnt > 0u ? cnt : 1u;
}

__device__ __forceinline__ void xcd_barrier(const XcdBarrier& b) {
    asm volatile("s_waitcnt vmcnt(0)" ::: "memory");
    __syncthreads();
    if (threadIdx.x == 0) {
        unsigned* bar = b.bar;
        __builtin_amdgcn_s_waitcnt(0);
        unsigned nloc = b.st[0], nx = b.st[1];
        if (nloc == 0u) { xcd_barrier_complete(bar, b.x, nloc, nx); b.st[0] = nloc; b.st[1] = nx; }
        const unsigned old = xb_add(&bar[XB_XSUB(b.x)], 1u);
        const unsigned gen = old / nloc;
        if (old + 1u == (gen + 1u) * nloc) {
            __builtin_amdgcn_fence(__ATOMIC_RELEASE, "agent");
            asm volatile("s_waitcnt vmcnt(0)" ::: "memory");
            const unsigned og = xb_add(&bar[XB_TOP], 1u);
            const unsigned tg = og / nx;
            if (og + 1u == (tg + 1u) * nx) xb_add(&bar[XB_TOPGEN], 1u);
            else XB_SPIN(xb_ld(&bar[XB_TOPGEN]) == tg, bar);
            __builtin_amdgcn_fence(__ATOMIC_ACQUIRE, "agent");
            xb_add(&bar[XB_XGEN(b.x)], 1u);
            asm volatile("s_waitcnt vmcnt(0)" ::: "memory");
        } else {
            XB_SPIN(xb_ld(&bar[XB_XGEN(b.x)]) == gen, bar);
            __builtin_amdgcn_fence(__ATOMIC_ACQUIRE, "agent");
            asm volatile("s_waitcnt vmcnt(0)" ::: "memory");
        }
    }
    __syncthreads();
}


#define N_PHASES 28
template <int ph>
__device__ __forceinline__ void run_phase(const Params& p, char* lds, int bid, int nb) {
  switch (ph) {
    case 0: ph_prep(p, 0, true, false, lds, bid, nb); break;
    case 1: ph_norm(p, 0, lds, bid, nb); break;
    case 2: ph_inproj(p, lds, bid, nb); break;
    case 3: ph_s5g1(p, lds, bid, nb); break;
    case 4: ph_scan(p, 0, bid, nb); break;
    case 5: ph_s5g3(p, lds, bid, nb); break;
    case 6: ph_glu(p, 0, lds, bid, nb); break;
    case 7: ph_out(p, 0, (const u16*)(p.ws + OFF_C), lds, bid, nb); break;
    case 8: ph_prep(p, 1, false, true, lds, bid, nb); break;
    case 9: ph_inproj(p, lds, bid, nb); break;
    case 10: ph_pool(p, bid, nb); break;
    case 11: ph_poolmm(p, 0, lds, bid, nb); break;
    case 12: ph_out(p, 1, (const u16*)(p.ws + OFF_C), lds, bid, nb); break;
    case 13: ph_prep(p, 2, false, true, lds, bid, nb); break;
    case 14: ph_inproj_mla(p, lds, bid, nb); break;
    case 15: ph_mlanorm(p, 0, lds, bid, nb); break;
    case 16: ph_qgemm(p, lds, bid, nb); break;
    case 17: ph_attn(p, lds, bid, nb); break;
    case 18: ph_oexp(p, lds, bid, nb); break;
    case 19: ph_out(p, 2, (const u16*)(p.ws + OFF_A), lds, bid, nb); break;
    case 20: ph_prep(p, 3, false, true, lds, bid, nb); break;
    case 21: ph_inproj(p, lds, bid, nb); break;
    case 22: ph_s5g1(p, lds, bid, nb); break;
    case 23: ph_scan(p, 1, bid, nb); break;
    case 24: ph_s5g3(p, lds, bid, nb); break;
    case 25: ph_glu(p, 1, lds, bid, nb); break;
    case 26: ph_out(p, 3, (const u16*)(p.ws + OFF_C), lds, bid, nb); break;
    case 27: ph_final(p, bid, nb); break;
    default: break;
  }
}

template <int PH>
__device__ __forceinline__ void run_all(const Params& p, char* lds, cg::grid_group& grid, const XcdBarrier& xb, int bid, int nb) {
  if constexpr (PH < N_PHASES) {
    run_phase<PH>(p, lds, bid, nb);
#ifdef DUP_PHASE
    if constexpr (PH == DUP_PHASE) { xcd_barrier(xb); run_phase<PH>(p, lds, bid, nb); }
#endif
    if constexpr (PH + 1 < N_PHASES) {
      if constexpr (PH == 0) grid.sync(); else xcd_barrier(xb);
      run_all<PH + 1>(p, lds, grid, xb, bid, nb);
    }
  }
}

#if MK_SINGLE
__global__ void __launch_bounds__(512) k_mega(Params p) {
  __shared__ __attribute__((aligned(16))) char lds[LDS_BYTES];
  __shared__ uint4 xb_words;
  __shared__ int s_vbid;
  cg::grid_group grid = cg::this_grid();
  unsigned* bar = (unsigned*)(p.ws + OFF_BAR);
  if (threadIdx.x == 0) {
    xb_words = make_uint4(0u, 0u, 0u, 0u);
    const unsigned x = xb_xcc_id() & 7u;
    const unsigned j = atomicAdd(&bar[XCD_BAR_WORDS + 64 * x], 1u);
    s_vbid = (int)(j * 8u + x);
  }
  __syncthreads();
  XcdBarrier xb = xcd_barrier_post(bar, (volatile LAS unsigned*)&xb_words);
  const int nb = gridDim.x;
  run_phase<0>(p, lds, blockIdx.x, nb);
  grid.sync();
  int vb = s_vbid;
  {
    bool ok = (nb & 7) == 0;
#pragma unroll
    for (int x = 0; x < 8; ++x) ok = ok && (xb_ld(&bar[XCD_BAR_WORDS + 64 * x]) == (unsigned)(nb >> 3));
    if (!ok) vb = blockIdx.x;
  }
  run_all<1>(p, lds, grid, xb, vb, nb);
}
#else
template <int PH>
__global__ void __launch_bounds__(512) __attribute__((amdgpu_waves_per_eu(2, 2))) k_phase(Params p) {
  __shared__ __attribute__((aligned(16))) char lds[LDS_BYTES];
  run_phase<PH>(p, lds, blockIdx.x, gridDim.x);
}
template <int PH>
static void launch_all(const Params& p, hipStream_t stream) {
  if constexpr (PH < N_PHASES) {
    k_phase<PH><<<256, 512, 0, stream>>>(p);
    launch_all<PH + 1>(p, stream);
  }
}
#endif

extern "C" void kernel_launch(void* const* d_in, const int* in_sizes, int n_in, void* d_out, int out_size,
                              void* d_ws, size_t ws_size, hipStream_t stream) {
  Params p{};
  const float** f = (const float**)&p;
  for (int i = 0; i < 34; ++i) f[i] = (const float*)d_in[i];
  p.out = (float*)d_out;
  p.ws = (char*)d_ws;
#if MK_SINGLE
  static int grid_blocks = 0;
  if (!grid_blocks) {
    int dev = 0, cus = 0, per_cu = 0;
    (void)hipGetDevice(&dev);
    (void)hipDeviceGetAttribute(&cus, hipDeviceAttributeMultiprocessorCount, dev);
    (void)hipOccupancyMaxActiveBlocksPerMultiprocessor(&per_cu, k_mega, 512, 0);
    if (per_cu > 1) per_cu = 1;
    grid_blocks = cus * per_cu;
    if (grid_blocks <= 0) grid_blocks = 256;
  }
  (void)hipMemsetAsync((char*)d_ws + OFF_BAR, 0, (XCD_BAR_WORDS + 8 * 64) * 4, stream);
  void* args[] = {&p};
  hipError_t e = hipLaunchCooperativeKernel((void*)k_mega, dim3(grid_blocks), dim3(512), args, 0, stream);
  if (e != hipSuccess) fprintf(stderr, "cooperative launch failed: %s (grid %d)\n", hipGetErrorString(e), grid_blocks);
#else
  launch_all<0>(p, stream);
#endif
}
```

```cpp
#include <hip/hip_runtime.h>
#include <hip/hip_cooperative_groups.h>
#include <cstdio>
namespace cg = cooperative_groups;

#ifndef MK_SINGLE
#define MK_SINGLE 1
#endif

typedef unsigned short u16;
using bf16x8 = __attribute__((ext_vector_type(8))) short;
using f32x4  = __attribute__((ext_vector_type(4))) float;
using u16x4  = __attribute__((ext_vector_type(4))) unsigned short;
using u16x8  = __attribute__((ext_vector_type(8))) unsigned short;

struct Params {
  const float *x_prompt, *x_sample, *st_re, *st_im, *cache_ckv, *cache_kpe, *c, *c_ctx;
  const float *norm_g, *ada_w, *ada_b, *final_g;
  const float *s5_w_in, *s5_lam_re, *s5_lam_im, *s5_log_step, *s5_b_re, *s5_b_im, *s5_c_re, *s5_c_im;
  const float *s5_d, *s5_glu_w, *s5_glu_b, *s5_w_out;
  const float *pool_w_in, *pool_w, *pool_scale, *pool_w_out;
  const float *mla_w_in, *mla_q_norm, *mla_wq_b, *mla_kv_norm, *mla_wkv_b, *mla_w_out;
  float* out;
  char* ws;
};

constexpr size_t MiB = 1ull << 20;
constexpr size_t OFF_W = 0, OFF_A = 20 * MiB, OFF_B = 116 * MiB, OFF_C = 164 * MiB, OFF_M = 212 * MiB,
                 OFF_H = 228 * MiB;
constexpr size_t OFF_BAR = OFF_M + 512 * 1024;
constexpr size_t OFF_MOD = OFF_M, OFF_QAN = OFF_M + 1 * MiB, OFF_KB = OFF_M + 7 * MiB, OFF_VT = OFF_M + 12 * MiB;
constexpr size_t W_WIN = OFF_W, W_GLU = OFF_W + 8 * MiB, W_POOLW = OFF_W + 8 * MiB, W_WQ = OFF_W + 6 * MiB,
                 W_WUV = OFF_W + 8 * MiB, W_WOUT = OFF_W + 16 * MiB;
constexpr size_t A_QA = OFF_A + 72 * MiB, A_CKVF = OFF_A + 84 * MiB, A_KPEF = OFF_A + 90 * MiB;
constexpr size_t B_WST = OFF_B, B_WBIG = OFF_B + 16 * MiB;

constexpr int OUT_RE = 12582912, OUT_IM = 13631488, OUT_CKV = 14680064, OUT_KPE = 15728640;

#define NT_TOK 12288
#define LDS_BYTES 147456

typedef float f32x2_t __attribute__((ext_vector_type(2)));
typedef __bf16 bf16x2_t __attribute__((ext_vector_type(2)));
typedef unsigned u32x2_t __attribute__((ext_vector_type(2)));
typedef unsigned u32x4_t __attribute__((ext_vector_type(4)));
__device__ __forceinline__ unsigned pack2bf(float a, float b) {
  f32x2_t v = {a, b};
  bf16x2_t r = __builtin_convertvector(v, bf16x2_t);
  return __builtin_bit_cast(unsigned, r);
}
__device__ __forceinline__ u16 f2bf(float f) { return (u16)(pack2bf(f, 0.f) & 0xffffu); }
__device__ __forceinline__ float bf2f(u16 h) { return __uint_as_float(((unsigned)h) << 16); }
__device__ __forceinline__ float fsigmoid(float x) { return 1.f / (1.f + __expf(-x)); }
__device__ __forceinline__ float fsilu(float x) { return x * fsigmoid(x); }
__device__ __forceinline__ float fgelu(float x) {
  float y = 0.7978845608028654f * (x + 0.044715f * x * x * x);
  float t = 1.f - 2.f / (__expf(2.f * y) + 1.f);
  return 0.5f * x * (1.f + t);
}
__device__ __forceinline__ float2 cis_rev(double rev) {
  double f = rev - rint(rev);
  float ff = (float)f;
  return make_float2(__builtin_amdgcn_cosf(ff), __builtin_amdgcn_sinf(ff));
}
__device__ __forceinline__ float wave_sum(float v) {
#pragma unroll
  for (int o = 32; o > 0; o >>= 1) v += __shfl_xor(v, o);
  return v;
}
__device__ __forceinline__ int cond_of_row(int row) { return row < 8192 ? 0 : 1 + ((row - 8192) >> 11); }
__device__ __forceinline__ u16x4 pack4(f32x4 v) {
  u32x2_t w = {pack2bf(v[0], v[1]), pack2bf(v[2], v[3])};
  return __builtin_bit_cast(u16x4, w);
}
__device__ __forceinline__ u16x8 pack8(const float* a) {
  u32x4_t w = {pack2bf(a[0], a[1]), pack2bf(a[2], a[3]), pack2bf(a[4], a[5]), pack2bf(a[6], a[7])};
  return __builtin_bit_cast(u16x8, w);
}

__device__ __forceinline__ size_t blkA(int row, int k, int KT) { return ((size_t)((row >> 8) * KT + (k >> 6)) * 256 + (row & 255)) * 64 + (k & 63); }
__device__ __forceinline__ size_t blkB(int n, int k, int KT) { return ((size_t)((n >> 7) * KT + (k >> 6)) * 128 + (n & 127)) * 64 + (k & 63); }
__device__ __forceinline__ size_t ugaddr(int tok, int ch) { return ((size_t)((ch >> 4) * 768 + (tok >> 4))) * 256 + (tok & 15) * 16 + (ch & 15); }
__device__ __forceinline__ size_t xaddr(int row, int g, int col) { return ((((size_t)g * 6 + (row >> 7)) * 4 + (col >> 6)) * 128 + (row & 127)) * 64 + (col & 63); }

#define WAIT_VM(n) asm volatile("s_waitcnt vmcnt(" #n ")" ::: "memory")
#define BARRIER()                        \
  do {                                   \
    asm volatile("" ::: "memory");       \
    __builtin_amdgcn_s_barrier();        \
    asm volatile("" ::: "memory");       \
  } while (0)

__device__ __forceinline__ void glds16(const void* g, char* l) {
  __builtin_amdgcn_global_load_lds((const unsigned*)g, (unsigned*)l, 16, 0, 0);
}

template <int WM, int WN, bool LINA, bool LINB, int MI = 4, class AF, class BF>
__device__ __forceinline__ void gemm_loop(char* lds, int nk, AF af, BF bf, f32x4 (&acc)[MI][4], int ksa = 64, int ksb = 64) {
  constexpr int BM = WM * MI * 16, BN = WN * 64;
  constexpr int NA = BM / 64, NB = BN / 64, NG = NA + NB;
  constexpr int STG = (BM + BN) * 128;
  static_assert(3 * STG <= LDS_BYTES, "lds");
  static_assert(NG <= 2 * MI, "glds slots");
  const int tid = threadIdx.x, lane = tid & 63, wid = tid >> 6;
  const int wr = wid / WN, wc = wid % WN, fr = lane & 15, fq = lane >> 4;
  const int srow = tid >> 3;
  const int skc = ((tid & 7) ^ (srow & 7)) * 8;
#pragma unroll
  for (int mi = 0; mi < MI; ++mi)
#pragma unroll
    for (int ni = 0; ni < 4; ++ni) acc[mi][ni] = f32x4{0.f, 0.f, 0.f, 0.f};

  const u16* pa[NA];
  const u16* pb[NB];
  if constexpr (LINA) {
#pragma unroll
    for (int i = 0; i < NA; ++i) pa[i] = af(srow + i * 64, skc);
  }
  if constexpr (LINB) {
#pragma unroll
    for (int i = 0; i < NB; ++i) pb[i] = bf(srow + i * 64, skc);
  }
  auto glds_one = [&](int i, int kt, char* base) {
    if (i < NA)
      glds16(LINA ? pa[i] + kt * ksa : af(srow + i * 64, kt * 64 + skc), base + i * 8192);
    else
      glds16(LINB ? pb[i - NA] + kt * ksb : bf(srow + (i - NA) * 64, kt * 64 + skc),
             base + BM * 128 + (i - NA) * 8192);
  };
  auto stage = [&](int kt, int buf) {
    char* base = lds + buf * STG + tid * 16;
#pragma unroll
    for (int i = 0; i < NG; ++i) glds_one(i, kt, base);
  };
  constexpr int H1 = NG / 2;
  stage(0, 0);
  if (nk > 1) stage(1, 1);
  if (nk > 1) { asm volatile("s_waitcnt vmcnt(%0)" ::"n"(NG) : "memory"); } else { WAIT_VM(0); }
  BARRIER();
  int cur = 0;
  const int rowoffA = (wr * (MI * 16) + fr) * 128, rowoffB = BM * 128 + (wc * 64 + fr) * 128;
  const int off0 = ((0 + fq) ^ (fr & 7)) << 4, off1 = ((4 + fq) ^ (fr & 7)) << 4;
  bf16x8 a0[MI], b0[4], a1[MI], b1[4];
#pragma unroll
  for (int mi = 0; mi < MI; ++mi) a0[mi] = *(const bf16x8*)(lds + rowoffA + mi * 2048 + off0);
#pragma unroll
  for (int ni = 0; ni < 4; ++ni) b0[ni] = *(const bf16x8*)(lds + rowoffB + ni * 2048 + off0);
  for (int kt = 0; kt < nk; ++kt) {
    const bool pf = kt + 2 < nk;
    const int nxt = cur == 2 ? 0 : cur + 1;
    char* nbase = lds + (cur >= 1 ? cur - 1 : 2) * STG + tid * 16;
    const char* sa = lds + cur * STG + rowoffA;
    const char* sb = lds + cur * STG + rowoffB;
#pragma unroll
    for (int m2 = 0; m2 < MI; ++m2) a1[m2] = *(const bf16x8*)(sa + m2 * 2048 + off1);
#pragma unroll
    for (int n2 = 0; n2 < 4; ++n2) b1[n2] = *(const bf16x8*)(sb + n2 * 2048 + off1);
    __builtin_amdgcn_sched_barrier(0);
#pragma unroll
    for (int g = 0; g < MI; ++g) {
#pragma unroll
      for (int ni = 0; ni < 4; ++ni)
        acc[g][ni] = __builtin_amdgcn_mfma_f32_16x16x32_bf16(b0[ni], a0[g], acc[g][ni], 0, 0, 0);
      __builtin_amdgcn_sched_barrier(0);
      if (g < H1) { if (pf) glds_one(g, kt + 2, nbase); }
      __builtin_amdgcn_sched_barrier(0);
    }
    asm volatile("s_waitcnt lgkmcnt(0)" ::: "memory");
    if (pf) { asm volatile("s_waitcnt vmcnt(%0)" ::"n"(H1) : "memory"); } else { WAIT_VM(0); }
    BARRIER();
    if (kt + 1 < nk) {
      const char* na = lds + nxt * STG + rowoffA;
      const char* nbp = lds + nxt * STG + rowoffB;
#pragma unroll
      for (int m2 = 0; m2 < MI; ++m2) a0[m2] = *(const bf16x8*)(na + m2 * 2048 + off0);
#pragma unroll
      for (int n2 = 0; n2 < 4; ++n2) b0[n2] = *(const bf16x8*)(nbp + n2 * 2048 + off0);
    }
    __builtin_amdgcn_sched_barrier(0);
#pragma unroll
    for (int g = 0; g < MI; ++g) {
#pragma unroll
      for (int ni = 0; ni < 4; ++ni)
        acc[g][ni] = __builtin_amdgcn_mfma_f32_16x16x32_bf16(b1[ni], a1[g], acc[g][ni], 0, 0, 0);
      __builtin_amdgcn_sched_barrier(0);
      if (H1 + g < NG) { if (pf) glds_one(H1 + g, kt + 2, nbase); }
      __builtin_amdgcn_sched_barrier(0);
    }
    cur = nxt;
  }
}

template <int MI, class AF, class BF>
__device__ __forceinline__ void gemm_loop2(char* lds, int nk, AF af, BF bf, f32x4 (&acc)[MI][4], int ksa, int ksb) {
  constexpr int BM = 2 * MI * 16, BN = 256;
  constexpr int NA = BM / 64, NB = BN / 64, NG = NA + NB;
  constexpr int STG = (BM + BN) * 128;
  static_assert(2 * STG + 2048 <= LDS_BYTES, "lds");
  static_assert(NG < 2 * MI, "glds slots");
  const int tid = threadIdx.x, lane = tid & 63, wid = tid >> 6;
  const int wr = wid >> 2, wc = wid & 3, fr = lane & 15, fq = lane >> 4;
  const int srow = tid >> 3;
  const int skc = ((tid & 7) ^ (srow & 7)) * 8;
#pragma unroll
  for (int mi = 0; mi < MI; ++mi)
#pragma unroll
    for (int ni = 0; ni < 4; ++ni) acc[mi][ni] = f32x4{0.f, 0.f, 0.f, 0.f};
  const u16* pa[NA];
  const u16* pb[NB];
#pragma unroll
  for (int i = 0; i < NA; ++i) pa[i] = af(srow + i * 64, skc);
#pragma unroll
  for (int i = 0; i < NB; ++i) pb[i] = bf(srow + i * 64, skc);
  auto glds_one = [&](int i, int kt, char* base) {
    if (i < NA) glds16(pa[i] + kt * ksa, base + i * 8192);
    else glds16(pb[i - NA] + kt * ksb, base + BM * 128 + (i - NA) * 8192);
  };
  const int pidx = tid < BM + BN ? tid : BM + BN - 1;
  const u16* ppf = pidx < BM ? af(pidx, 0) : bf(pidx - BM, 0);
  const int pstride = pidx < BM ? ksa : ksb;
  char* pdummy = lds + 2 * STG + tid * 4;
  auto prefetch = [&](int kt) {
    const int k2 = kt < nk ? kt : nk - 1;
    __builtin_amdgcn_global_load_lds((const unsigned*)(ppf + (size_t)k2 * pstride), (unsigned*)pdummy, 4, 0, 0);
  };
  {
    char* base = lds + tid * 16;
#pragma unroll
    for (int i = 0; i < NG; ++i) glds_one(i, 0, base);
    prefetch(2);
  }
  const int rowoffA = (wr * (MI * 16) + fr) * 128, rowoffB = BM * 128 + (wc * 64 + fr) * 128;
  for (int kt = 0; kt < nk; ++kt) {
    const int cur = kt & 1;
    WAIT_VM(1);
    BARRIER();
    const bool pf = kt + 1 < nk;
    char* nbase = lds + (cur ^ 1) * STG + tid * 16;
    const char* sa = lds + cur * STG + rowoffA;
    const char* sb = lds + cur * STG + rowoffB;
#pragma unroll
    for (int ks = 0; ks < 2; ++ks) {
      const int off = ((ks * 4 + fq) ^ (fr & 7)) << 4;
      bf16x8 a[MI], b[4];
#pragma unroll
      for (int mi = 0; mi < MI; ++mi) a[mi] = *(const bf16x8*)(sa + mi * 2048 + off);
#pragma unroll
      for (int ni = 0; ni < 4; ++ni) b[ni] = *(const bf16x8*)(sb + ni * 2048 + off);
      __builtin_amdgcn_sched_barrier(0);
#pragma unroll
      for (int g = 0; g < MI; ++g) {
#pragma unroll
        for (int ni = 0; ni < 4; ++ni)
          acc[g][ni] = __builtin_amdgcn_mfma_f32_16x16x32_bf16(b[ni], a[g], acc[g][ni], 0, 0, 0);
        __builtin_amdgcn_sched_barrier(0);
        if (ks * MI + g < NG) { if (pf) glds_one(ks * MI + g, kt + 1, nbase); }
        if (ks * MI + g == NG) prefetch(kt + 3);
        __builtin_amdgcn_sched_barrier(0);
      }
    }
  }
  BARRIER();
}

#define EPI2_LOOP(MI_)                                                           \
  const int _lane = threadIdx.x & 63, _wid = threadIdx.x >> 6;                   \
  const int _wr = _wid >> 2, _wc = _wid & 3, _fr = _lane & 15, _fq = _lane >> 4; \
  _Pragma("unroll") for (int mi = 0; mi < (MI_); ++mi) _Pragma("unroll") for (int ni = 0; ni < 4; ++ni)
#define EPI2_ROW(m0, MI_) ((m0) + _wr * ((MI_) * 16) + mi * 16 + _fr)
#define EPI2_COL(n0) ((n0) + _wc * 64 + ni * 16 + _fq * 4)

#define EPI_LOOP(WM_, WN_)                                                       \
  const int _lane = threadIdx.x & 63, _wid = threadIdx.x >> 6;                   \
  const int _wr = _wid / (WN_), _wc = _wid % (WN_), _fr = _lane & 15, _fq = _lane >> 4; \
  _Pragma("unroll") for (int mi = 0; mi < 4; ++mi) _Pragma("unroll") for (int ni = 0; ni < 4; ++ni)
#define EPI_ROW(m0) ((m0) + _wr * 64 + mi * 16 + _fr)
#define EPI_COL(n0) ((n0) + _wc * 64 + ni * 16 + _fq * 4)

__device__ __forceinline__ void ada_item(const Params& p, int item, char* lds) {
  const int tid = threadIdx.x;
  const int layer = item / 48, n0 = (item % 48) * 64;
  float* sc = (float*)lds;
  float* red = sc + 3072;
  for (int i = tid; i < 3072; i += 512) {
    int cond = i >> 10, k = i & 1023;
    float v = cond == 0 ? p.c_ctx[k] : p.c[(cond - 1) * 1024 + k];
    sc[i] = fsilu(v);
  }
  __syncthreads();
  const int cq = tid & 15, kg = tid >> 4;
  float a[3][4];
#pragma unroll
  for (int c = 0; c < 3; ++c)
#pragma unroll
    for (int e = 0; e < 4; ++e) a[c][e] = 0.f;
  const float* w = p.ada_w + (size_t)layer * 1024 * 3072 + (size_t)(kg * 32) * 3072 + n0 + cq * 4;
#pragma unroll 8
  for (int k = 0; k < 32; ++k) {
    float4 wv = *(const float4*)(w + (size_t)k * 3072);
#pragma unroll
    for (int c = 0; c < 3; ++c) {
      float s = sc[c * 1024 + kg * 32 + k];
      a[c][0] += s * wv.x; a[c][1] += s * wv.y; a[c][2] += s * wv.z; a[c][3] += s * wv.w;
    }
  }
#pragma unroll
  for (int c = 0; c < 3; ++c)
#pragma unroll
    for (int e = 0; e < 4; ++e) red[(kg * 3 + c) * 64 + cq * 4 + e] = a[c][e];
  __syncthreads();
  if (tid < 192) {
    int cond = tid >> 6, nn = tid & 63;
    float sum = 0.f;
#pragma unroll 8
    for (int g = 0; g < 32; ++g) sum += red[(g * 3 + cond) * 64 + nn];
    sum += p.ada_b[layer * 3072 + n0 + nn];
    ((float*)(p.ws + OFF_MOD))[(layer * 3 + cond) * 3072 + n0 + nn] = sum;
  }
  __syncthreads();
}

template <int KR>
__device__ __forceinline__ void conv_tile(const float* src, int ld, int k0, int n0, u16* dst, int ldd, int drow0, char* lds, int blkKT = 0) {
  float* t = (float*)lds;
  const int tid = threadIdx.x;
  float4 v[KR / 32];
#pragma unroll
  for (int i = 0; i < KR / 32; ++i) {
    int kk = (tid >> 4) + i * 32, n4 = (tid & 15) * 4;
    v[i] = *(const float4*)(src + (size_t)(k0 + kk) * ld + n0 + n4);
  }
#pragma unroll
  for (int i = 0; i < KR / 32; ++i) {
    int kk = (tid >> 4) + i * 32, n4 = (tid & 15) * 4;
    t[kk * 65 + n4 + 0] = v[i].x; t[kk * 65 + n4 + 1] = v[i].y; t[kk * 65 + n4 + 2] = v[i].z; t[kk * 65 + n4 + 3] = v[i].w;
  }
  __syncthreads();
#pragma unroll
  for (int r = 0; r < KR / 64; ++r) {
    int i = tid >> 3, kc = (tid & 7) * 8 + r * 64;
    float tv[8];
#pragma unroll
    for (int q = 0; q < 8; ++q) tv[q] = t[(kc + q) * 65 + i];
    u16x8 o = pack8(tv);
    if (blkKT) {
      const int n = drow0 + i;
      *(u16x8*)(dst + ((size_t)((n >> 7) * blkKT + ((k0 + kc) >> 6)) * 128 + (n & 127)) * 64 + (kc & 63)) = o;
    } else {
      *(u16x8*)(dst + (size_t)(drow0 + i) * ldd + k0 + kc) = o;
    }
  }
  __syncthreads();
}

__device__ __forceinline__ void conv_item(const Params& p, int layer, int it, char* lds) {
  const int kind = layer % 3, j = layer / 3;
  if (kind == 0) {
    if (it < 256) {
      int kt = it >> 6, nt = it & 63;
      conv_tile<256>(p.s5_w_in + (size_t)j * 1024 * 4096, 4096, kt * 256, nt * 64, (u16*)(p.ws + W_WIN), 1024, nt * 64, lds, 16);
    } else if (it < 512) {
      int t = it - 256, kt = t >> 5, nt = t & 31;
      conv_tile<256>(p.s5_glu_w + (size_t)j * 2048 * 2048, 2048, kt * 256, nt * 64, (u16*)(p.ws + W_GLU), 2048, nt * 64, lds, 32);
    } else {
      int t = it - 512, kt = t >> 4, nt = t & 15;
      conv_tile<256>(p.s5_w_out + (size_t)j * 2048 * 1024, 1024, kt * 256, nt * 64, (u16*)(p.ws + W_WOUT), 2048, nt * 64, lds, 32);
    }
  } else if (kind == 1) {
    if (it < 256) {
      int kt = it >> 6, nt = it & 63;
      conv_tile<256>(p.pool_w_in + (size_t)j * 1024 * 4096, 4096, kt * 256, nt * 64, (u16*)(p.ws + W_WIN), 1024, nt * 64, lds, 16);
    } else if (it < 320) {
      int t = it - 256, g = t >> 4, r = t & 15, kt = r >> 3, nt = r & 7;
      conv_tile<256>(p.pool_w + ((size_t)j * 4 + g) * 512 * 512, 512, kt * 256, nt * 64, (u16*)(p.ws + W_POOLW), 512,
                g * 512 + nt * 64, lds, 8);
    } else {
      int t = it - 320, kt = t >> 4, nt = t & 15;
      conv_tile<256>(p.pool_w_out + (size_t)j * 2048 * 1024, 1024, kt * 256, nt * 64, (u16*)(p.ws + W_WOUT), 2048, nt * 64, lds, 32);
    }
  } else {
    if (it < 156) {
      int kt = it / 39, nt = it % 39;
      conv_tile<256>(p.mla_w_in + (size_t)j * 1024 * 2496, 2496, kt * 256, nt * 64, (u16*)(p.ws + W_WIN), 1024, nt * 64, lds, 16);
    } else if (it < 172) {
      int h = it - 156, nt = h * 3 + 2;
      conv_tile<256>(p.mla_wq_b + (size_t)j * 256 * 3072, 3072, 0, nt * 64, (u16*)(p.ws + W_WQ), 256, nt * 64, lds, 4);
    } else if (it < 204) {
      int q = it - 172, h = q >> 1, half = q & 1, nt = h * 4 + 2 + half;
      conv_tile<128>(p.mla_wkv_b + (size_t)j * 128 * 4096, 4096, 0, nt * 64, (u16*)(p.ws + W_WUV), 128,
                h * 128 + half * 64, lds, 2);
    } else {
      int t = it - 204, kt = t >> 4, nt = t & 15;
      conv_tile<256>(p.mla_w_out + (size_t)j * 2048 * 1024, 1024, kt * 256, nt * 64, (u16*)(p.ws + W_WOUT), 2048, nt * 64, lds, 32);
    }
  }
}
__device__ __forceinline__ int conv_count(int layer) {
  const int kind = layer % 3;
  return kind == 0 ? 640 : (kind == 1 ? 448 : 332);
}

__device__ __forceinline__ const float* x_row(const Params& p, int layer, int row) {
  if (layer == 0) return row < 8192 ? p.x_prompt + (size_t)row * 1024 : p.x_sample + (size_t)(row - 8192) * 1024;
  return p.out + (size_t)row * 1024;
}

__device__ __forceinline__ void norm_item(const Params& p, int layer, int item, char* lds) {
  const int tid = threadIdx.x, lane = tid & 63, wid = tid >> 6;
  float* ma = (float*)lds;
  float* mb = ma + 1024;
  const int row0 = item * 32;
  const int cond = cond_of_row(row0);
  const float* mod = (const float*)(p.ws + OFF_MOD) + (size_t)(layer * 3 + cond) * 3072;
  for (int i = tid; i < 1024; i += 512) {
    ma[i] = p.norm_g[layer * 1024 + i] * (1.f + mod[1024 + i]);
    mb[i] = mod[i];
  }
  __syncthreads();
  u16* h = (u16*)(p.ws + OFF_H);
#pragma unroll 1
  for (int i = 0; i < 4; ++i) {
    const int row = row0 + wid * 4 + i;
    const float* x = x_row(p, layer, row);
    float4 v[4];
    float ss = 0.f;
#pragma unroll
    for (int q = 0; q < 4; ++q) {
      v[q] = *(const float4*)(x + q * 256 + lane * 4);
      ss += v[q].x * v[q].x + v[q].y * v[q].y + v[q].z * v[q].z + v[q].w * v[q].w;
    }
    ss = wave_sum(ss);
    const float rstd = rsqrtf(ss * (1.f / 1024.f) + 1e-6f);
#pragma unroll
    for (int q = 0; q < 4; ++q) {
      const int c = q * 256 + lane * 4;
      float4 a = *(const float4*)(ma + c), b = *(const float4*)(mb + c);
      f32x4 ov = {v[q].x * rstd * a.x + b.x, v[q].y * rstd * a.y + b.y, v[q].z * rstd * a.z + b.z, v[q].w * rstd * a.w + b.w};
      u16x4 o = pack4(ov);
      *(u16x4*)(h + ((size_t)((row >> 8) * 16 + (c >> 6)) * 256 + (row & 255)) * 64 + (c & 63)) = o;
    }
  }
  __syncthreads();
}

__device__ __forceinline__ void derive_item(const Params& p, int j, int item, char* lds) {
  const int tid = threadIdx.x;
  const int g = item >> 2, qu = item & 3;
  float2* pw = (float2*)lds;
  float2* bb = pw + 2 * 17 * 64;
  float2* cc = bb + 2 * 64 * 16;
  float* kt = (float*)(cc + 2 * 16 * 64);
  for (int i = tid; i < 2 * 17 * 64; i += 512) {
    int pp = i & 63, k = (i >> 6) % 17, dir = i / (17 * 64);
    int li = ((j * 2 + dir) * 128 + g) * 64 + pp;
    float lr = p.s5_lam_re[li], lim = p.s5_lam_im[li];
    float st = __expf(p.s5_log_step[(j * 2 + dir) * 128 + g]);
    float mag = __expf((float)k * lr * st);
    float2 cs = cis_rev((double)k * (double)lim * (double)st * 0.15915494309189535);
    pw[i] = make_float2(mag * cs.x, mag * cs.y);
  }
  for (int i = tid; i < 2 * 16 * 64; i += 512) {
    int pp = i & 63, c = (i >> 6) & 15, dir = i >> 10;
    size_t ci = ((size_t)((j * 2 + dir) * 128 + g) * 16 + c) * 64 + pp;
    cc[i] = make_float2(p.s5_c_re[ci], p.s5_c_im[ci]);
  }
  __syncthreads();
  for (int i = tid; i < 2 * 64 * 16; i += 512) {
    int c = i & 15, pp = (i >> 4) & 63, dir = i >> 10;
    int li = ((j * 2 + dir) * 128 + g) * 64 + pp;
    float lr = p.s5_lam_re[li], lim = p.s5_lam_im[li];
    float2 lb = pw[(dir * 17 + 1) * 64 + pp];
    float nr = lb.x - 1.f, ni = lb.y;
    float den = 1.f / (lr * lr + lim * lim);
    float cr = (nr * lr + ni * lim) * den, ci = (ni * lr - nr * lim) * den;
    size_t bi = ((size_t)li) * 16 + c;
    float br = p.s5_b_re[bi], bim = p.s5_b_im[bi];
    bb[i] = make_float2(cr * br - ci * bim, cr * bim + ci * br);
  }
  __syncthreads();
  for (int o = tid; o < 2048; o += 512) {
    int c2 = o & 15, cq = (o >> 4) & 3, lag = (o >> 6) & 15, dir = o >> 10;
    int c = qu * 4 + cq;
    float acc = 0.f;
    for (int pp = 0; pp < 64; ++pp) {
      float2 C = cc[(dir * 16 + c) * 64 + pp], P = pw[(dir * 17 + lag) * 64 + pp], B = bb[(dir * 64 + pp) * 16 + c2];
      float cpx = C.x * P.x - C.y * P.y, cpy = C.x * P.y + C.y * P.x;
      acc += cpx * B.x - cpy * B.y;
    }
    kt[o] = acc;
  }
  __syncthreads();
  u16* wbig = (u16*)(p.ws + B_WBIG) + (size_t)g * 256 * 512;
  for (int q = tid; q < 64 * 64; q += 512) {
    int rowi = q >> 6, k0 = (q & 63) * 8;
    int t = rowi >> 2, cq = rowi & 3, c = qu * 4 + cq, o = t * 16 + c;
    float tv[8];
    if (k0 < 256) {
      int s = k0 >> 4, c20 = k0 & 15;
      float dsk = p.s5_d[j * 2048 + g * 16 + c];
#pragma unroll
      for (int e = 0; e < 8; ++e) {
        int c2 = c20 + e;
        float val = 0.f;
        if (s <= t) val += kt[((0 * 16 + (t - s)) * 4 + cq) * 16 + c2];
        if (s >= t) val += kt[((1 * 16 + (s - t)) * 4 + cq) * 16 + c2];
        if (s == t && c2 == c) val += dsk;
        tv[e] = val;
      }
    } else {
      int dir = k0 >= 384 ? 1 : 0;
      int kk = k0 - 256 - dir * 128;
      int ri = kk >> 6, p0 = kk & 63;
      int e_pow = dir == 0 ? t + 1 : 16 - t;
#pragma unroll
      for (int e = 0; e < 8; ++e) {
        int pp = p0 + e;
        float2 C = cc[(dir * 16 + c) * 64 + pp], P = pw[(dir * 17 + e_pow) * 64 + pp];
        tv[e] = ri == 0 ? (C.x * P.x - C.y * P.y) : -(C.x * P.y + C.y * P.x);
      }
    }
    *(u16x8*)(wbig + blkB(o, k0, 8)) = pack8(tv);
  }
  u16* wst = (u16*)(p.ws + B_WST) + (size_t)g * 256 * 256;
  for (int q = tid; q < 64 * 32; q += 512) {
    int rowi = q >> 5, k0 = (q & 31) * 8;
    int dir = rowi >> 5, ri = (rowi >> 4) & 1, pp = qu * 16 + (rowi & 15);
    int o = dir * 128 + ri * 64 + pp;
    int s = k0 >> 4, c20 = k0 & 15;
    int e_pow = dir == 0 ? 15 - s : s;
    float2 P = pw[(dir * 17 + e_pow) * 64 + pp];
    float tv[8];
#pragma unroll
    for (int e = 0; e < 8; ++e) {
      float2 B = bb[(dir * 64 + pp) * 16 + c20 + e];
      tv[e] = ri == 0 ? (P.x * B.x - P.y * B.y) : (P.x * B.y + P.y * B.x);
    }
    *(u16x8*)(wst + blkB(o, k0, 4)) = pack8(tv);
  }
  __syncthreads();
}

__device__ __forceinline__ void wqabs_item(const Params& p, int item, char* lds) {
  const int tid = threadIdx.x;
  const int h = item >> 3, l0 = (item & 7) * 16;
  float* bs = (float*)lds;
  {
    int li = tid >> 5, d4 = (tid & 31) * 4;
    *(float4*)(bs + li * 128 + d4) = *(const float4*)(p.mla_wkv_b + (size_t)(l0 + li) * 4096 + h * 256 + d4);
  }
  __syncthreads();
  const int r = tid & 255, lh = tid >> 8;
  float acc[8];
#pragma unroll
  for (int i = 0; i < 8; ++i) acc[i] = 0.f;
  const float* arow = p.mla_wq_b + (size_t)r * 3072 + h * 192;
  for (int d4 = 0; d4 < 32; ++d4) {
    float4 a = *(const float4*)(arow + d4 * 4);
#pragma unroll
    for (int i = 0; i < 8; ++i) {
      float4 b = *(const float4*)(bs + (lh * 8 + i) * 128 + d4 * 4);
      acc[i] += a.x * b.x + a.y * b.y + a.z * b.z + a.w * b.w;
    }
  }
  u16* wq = (u16*)(p.ws + W_WQ);
#pragma unroll
  for (int i = 0; i < 8; ++i) wq[blkB(h * 192 + l0 + lh * 8 + i, r, 4)] = f2bf(acc[i]);
  __syncthreads();
}

__device__ __forceinline__ void ph_prep(const Params& p, int layer, bool with_ada, bool with_norm, char* lds, int bid, int nb) {
  const int kind = layer % 3, j = layer / 3;
  const int n_special = kind == 0 ? 512 : (kind == 2 ? 128 : 0);
  const int n_ada = with_ada ? 192 : 0;
  const int n_conv = conv_count(layer);
  const int n_norm = with_norm ? 384 : 0;
  const int total = n_special + n_ada + n_conv + n_norm;
  for (int it = bid; it < total; it += nb) {
    int t = it;
    if (t < n_special) {
      if (kind == 0) derive_item(p, j, t, lds); else wqabs_item(p, t, lds);
      continue;
    }
    t -= n_special;
    if (t < n_ada) { ada_item(p, t, lds); continue; }
    t -= n_ada;
    if (t < n_norm) { norm_item(p, layer, t, lds); continue; }
    t -= n_norm;
    conv_item(p, layer, t, lds);
  }
}
__device__ __forceinline__ void ph_norm(const Params& p, int layer, char* lds, int bid, int nb) {
  for (int it = bid; it < 384; it += nb) norm_item(p, layer, it, lds);
}

__device__ __forceinline__ void tile_mn(int t, int MT, int NT, int& mt, int& nt) {
  int per = 8 * NT;
  int grp = t / per, r = t % per;
  int gm = MT - grp * 8; gm = gm > 8 ? 8 : gm;
  mt = grp * 8 + r % gm; nt = r / gm;
}

__device__ __forceinline__ void ph_inproj(const Params& p, char* lds, int bid, int nb) {
  const u16* h = (const u16*)(p.ws + OFF_H);
  const u16* w = (const u16*)(p.ws + W_WIN);
  u16* uz = (u16*)(p.ws + OFF_A);
  for (int l = (bid >> 3); l < 96; l += (nb >> 3)) {
    const int xi = (bid & 7) >> 2, xj = bid & 3;
    const int mt = xi * 24 + (l >> 2), nt = xj * 4 + (l & 3);
    const int m0 = mt * 256, n0 = nt * 256;
    f32x4 acc[8][4];
    gemm_loop2<8>(lds, 16,
        [&](int r, int k) { return h + blkA(m0 + r, k, 16); },
        [&](int r, int k) { return w + blkB(n0 + r, k, 16); }, acc, 256 * 64, 128 * 64);
    EPI2_LOOP(8) {
      const int row = EPI2_ROW(m0, 8), col = EPI2_COL(n0);
      f32x4 v = acc[mi][ni];
      if (col >= 2048) {
        v[0] = fsilu(v[0]); v[1] = fsilu(v[1]); v[2] = fsilu(v[2]); v[3] = fsilu(v[3]);
        *(u16x4*)(uz + (size_t)NT_TOK * 2048 + (size_t)row * 2048 + (col - 2048)) = pack4(v);
      } else {
        *(u16x4*)(uz + ugaddr(row, col)) = pack4(v);
      }
    }
  }
}

__device__ __forceinline__ void ph_s5g1(const Params& p, char* lds, int bid, int nb) {
  const u16* uz = (const u16*)(p.ws + OFF_A);
  u16* X = (u16*)(p.ws + OFF_C);
  for (int t = bid; t < 768; t += nb) {
    const int g = t / 6, mt = (t % 6) >> 1, nt = t & 1;
    const int m0 = mt * 256, n0 = nt * 128;
    const u16* w = (const u16*)(p.ws + B_WST) + (size_t)g * 65536;
    f32x4 acc[4][4];
    gemm_loop<4, 2, true, true>(lds, 4,
        [&](int r, int k) { return uz + ((size_t)(g * 768 + m0 + r)) * 256 + k; },
        [&](int r, int k) { return w + ((size_t)(nt * 4) * 128 + r) * 64 + k; }, acc, 64, 128 * 64);
    EPI_LOOP(4, 2) {
      const int row = EPI_ROW(m0), col = EPI_COL(n0);
      *(u16x4*)(X + xaddr(row, g, col)) = pack4(acc[mi][ni]);
    }
  }
}

__device__ __forceinline__ void ph_scan(const Params& p, int j, int bid, int nb) {
  const int tid = threadIdx.x;
  u16* X = (u16*)(p.ws + OFF_C);
  for (int it = bid; it < 1088; it += nb) {
    int b, gq, r0, nc; bool sample;
    if (it < 64) { sample = true; b = it >> 5; gq = it & 31; r0 = 512 + b * 128; nc = 128; }
    else { int q = it - 64; sample = false; b = q >> 5; gq = q & 31; r0 = b * 16; nc = 16; }
    const int g = gq * 4 + (tid >> 7), dir = (tid >> 6) & 1, pp = tid & 63;
    const int li = ((j * 2 + dir) * 128 + g) * 64 + pp;
    const float lr = p.s5_lam_re[li], lim = p.s5_lam_im[li];
    const float st = __expf(p.s5_log_step[(j * 2 + dir) * 128 + g]);
    const float mag = __expf(16.f * lr * st);
    const float2 cs = cis_rev(16.0 * (double)lim * (double)st * 0.15915494309189535);
    const float ar = mag * cs.x, ai = mag * cs.y;
    float pr = 0.f, pi = 0.f;
    if (sample) {
      size_t si = ((size_t)((b * 2 + j) * 2 + dir) * 128 + g) * 64 + pp;
      pr = p.st_re[si]; pi = p.st_im[si];
    }
    u16* base = X + xaddr(r0, g, dir * 128 + pp);
    const size_t cstride = 64;
    if (dir == 0) {
#pragma unroll 8
      for (int c = 0; c < nc; ++c) {
        u16* q = base + (size_t)c * cstride;
        float sr = bf2f(q[0]), si = bf2f(q[8192]);
        q[0] = f2bf(pr); q[8192] = f2bf(pi);
        float nr = ar * pr - ai * pi + sr, ni = ar * pi + ai * pr + si;
        pr = nr; pi = ni;
      }
    } else {
#pragma unroll 8
      for (int c = nc - 1; c >= 0; --c) {
        u16* q = base + (size_t)c * cstride;
        float sr = bf2f(q[0]), si = bf2f(q[8192]);
        q[0] = f2bf(pr); q[8192] = f2bf(pi);
        float nr = ar * pr - ai * pi + sr, ni = ar * pi + ai * pr + si;
        pr = nr; pi = ni;
      }
    }
    if (!sample) {
      size_t oi = ((size_t)((b * 2 + j) * 2 + dir) * 128 + g) * 64 + pp;
      p.out[OUT_RE + oi] = pr;
      p.out[OUT_IM + oi] = pi;
    }
  }
}

__device__ __forceinline__ void ph_s5g3(const Params& p, char* lds, int bid, int nb) {
  u16* uz = (u16*)(p.ws + OFF_A);
  const u16* X = (const u16*)(p.ws + OFF_C);
  for (int t = bid; t < 768; t += nb) {
    const int g = t / 6, mt = t % 6;
    const int m0 = mt * 128;
    const u16* w = (const u16*)(p.ws + B_WBIG) + (size_t)g * 131072;
    f32x4 acc[4][4];
    gemm_loop<2, 4, false, true>(lds, 8,
        [&](int r, int k) {
          return k < 256 ? (const u16*)(uz + ((size_t)(g * 768 + m0 + r)) * 256 + k)
                         : X + xaddr(m0 + r, g, k - 256);
        },
        [&](int r, int k) { return w + ((size_t)((r >> 7) * 8) * 128 + (r & 127)) * 64 + k; }, acc, 64, 128 * 64);
    EPI_LOOP(2, 4) {
      const int row = EPI_ROW(m0), col = EPI_COL(0);
      f32x4 v = acc[mi][ni];
      v[0] = fgelu(v[0]); v[1] = fgelu(v[1]); v[2] = fgelu(v[2]); v[3] = fgelu(v[3]);
      *(u16x4*)(uz + ((size_t)(g * 768 + row)) * 256 + col) = pack4(v);
    }
  }
}

__device__ __forceinline__ void ph_glu(const Params& p, int j, char* lds, int bid, int nb) {
  const u16* uz = (const u16*)(p.ws + OFF_A);
  const u16* w = (const u16*)(p.ws + W_GLU);
  u16* m = (u16*)(p.ws + OFF_C);
  for (int l = (bid >> 3); l < 64; l += (nb >> 3)) {
    const int xi = (bid & 7) >> 2, xj = bid & 3;
    const int mt = xi * 32 + (l >> 1), nt = xj * 2 + (l & 1);
    const int m0 = mt * 192, n0 = nt * 256;
    f32x4 acc[6][4];
    gemm_loop2<6>(lds, 32,
        [&](int r, int k) { return uz + ugaddr(m0 + r, k); },
        [&](int r, int k) { return w + blkB(n0 + r, k, 32); }, acc, 4 * 768 * 256, 128 * 64);
    EPI2_LOOP(6) {
      const int row = EPI2_ROW(m0, 6), col = EPI2_COL(n0);
      f32x4 v = acc[mi][ni];
      float4 gb = *(const float4*)(p.s5_glu_b + j * 2048 + col);
      u16x4 yv = *(const u16x4*)(uz + ugaddr(row, col));
      u16x4 zv = *(const u16x4*)(uz + (size_t)NT_TOK * 2048 + (size_t)row * 2048 + col);
      f32x4 o;
      o[0] = bf2f(yv[0]) * fsigmoid(v[0] + gb.x) * bf2f(zv[0]);
      o[1] = bf2f(yv[1]) * fsigmoid(v[1] + gb.y) * bf2f(zv[1]);
      o[2] = bf2f(yv[2]) * fsigmoid(v[2] + gb.z) * bf2f(zv[2]);
      o[3] = bf2f(yv[3]) * fsigmoid(v[3] + gb.w) * bf2f(zv[3]);
      *(u16x4*)(m + blkA(row, col, 32)) = pack4(o);
    }
  }
}

__device__ __forceinline__ void ph_out(const Params& p, int layer, const u16* m, char* lds, int bid, int nb) {
  const u16* w = (const u16*)(p.ws + W_WOUT);
  const float* mod = (const float*)(p.ws + OFF_MOD);
  for (int t = bid; t < 256; t += nb) {
    const int mt = (t & 7) * 8 + (t >> 5), nt = (t >> 3) & 3;
    const int m0 = mt * 192, n0 = nt * 256;
    f32x4 acc[6][4];
    gemm_loop2<6>(lds, 32,
        [&](int r, int k) { return m + blkA(m0 + r, k, 32); },
        [&](int r, int k) { return w + blkB(n0 + r, k, 32); }, acc, 256 * 64, 128 * 64);
    const int lane = threadIdx.x & 63, wid = threadIdx.x >> 6;
    const int wr = wid >> 2, wc = wid & 3, fr = lane & 15, fq = lane >> 4;
#pragma unroll
    for (int mi = 0; mi < 6; ++mi) {
      const int row = m0 + wr * 96 + mi * 16 + fr;
      const float* gate = mod + (size_t)(layer * 3 + cond_of_row(row)) * 3072 + 2048;
      const float* xo_p = x_row(p, layer, row);
#pragma unroll
      for (int ni = 0; ni < 4; ++ni) {
        const int col = n0 + wc * 64 + ni * 16 + fq * 4;
        f32x4 v = acc[mi][ni];
        float4 gt = *(const float4*)(gate + col);
        float4 xo = *(const float4*)(xo_p + col);
        float4 o;
        o.x = xo.x + gt.x * v[0]; o.y = xo.y + gt.y * v[1]; o.z = xo.z + gt.z * v[2]; o.w = xo.w + gt.w * v[3];
        *(float4*)(p.out + (size_t)row * 1024 + col) = o;
      }
    }
  }
}

template <int WIN>
__device__ __forceinline__ void pool_unit(const u16* uz, u16* pb, int g, int tok, int half) {
  int t, L, base;
  if (tok < 8192) { L = 256; t = tok & 255; base = tok - t; }
  else { L = 2048; t = (tok - 8192) & 2047; base = tok - t; }
  constexpr int lo = WIN / 2;
  const int ch0 = g * 16 + half * 8;
  float acc[8];
#pragma unroll
  for (int e = 0; e < 8; ++e) acc[e] = 0.f;
  u16x8 self;
#pragma unroll
  for (int i = 0; i < WIN; ++i) {
    const int sp = t - lo + i;
    const bool valid = sp >= 0 && sp < L;
    const int sc = sp < 0 ? 0 : (sp >= L ? L - 1 : sp);
    u16x8 v = *(const u16x8*)(uz + ugaddr(base + sc, ch0));
    if (i == lo) self = v;
    const float wgt = valid ? 1.f : 0.f;
#pragma unroll
    for (int e = 0; e < 8; ++e) acc[e] += wgt * bf2f(v[e]);
  }
  int s0 = t - lo; if (s0 < 0) s0 = 0;
  int s1 = t - lo + WIN; if (s1 > L) s1 = L;
  const float inv = 1.f / (float)(s1 - s0);
  u16x8 o;
#pragma unroll
  for (int e = 0; e < 8; ++e) o[e] = f2bf(acc[e] * inv - bf2f(self[e]));
  *(u16x8*)(pb + blkA(tok, ch0, 32)) = o;
}
__device__ __forceinline__ void ph_pool(const Params& p, int bid, int nb) {
  const u16* uz = (const u16*)(p.ws + OFF_A);
  u16* pb = (u16*)(p.ws + OFF_B);
  const int lane = threadIdx.x & 63, wid = threadIdx.x >> 6;
  for (int u = bid * 8 + wid; u < 128 * 384; u += nb * 8) {
    const int g = u / 384, run = u % 384;
    const int tok = run * 32 + (lane >> 1), half = lane & 1;
    const int gi = g >> 5;
    if (gi == 0) pool_unit<2>(uz, pb, g, tok, half);
    else if (gi == 1) pool_unit<4>(uz, pb, g, tok, half);
    else if (gi == 2) pool_unit<8>(uz, pb, g, tok, half);
    else pool_unit<16>(uz, pb, g, tok, half);
  }
}

__device__ __forceinline__ void ph_poolmm(const Params& p, int j, char* lds, int bid, int nb) {
  const u16* pb = (const u16*)(p.ws + OFF_B);
  const u16* w = (const u16*)(p.ws + W_POOLW);
  const u16* uz = (const u16*)(p.ws + OFF_A);
  u16* m = (u16*)(p.ws + OFF_C);
  for (int l = (bid >> 3); l < 48 * 2; l += (nb >> 3)) {
    const int mt = l / 2, nt = (bid & 7) * 2 + l % 2;
    const int m0 = mt * 256, n0 = nt * 128, gi = n0 >> 9;
    f32x4 acc[4][4];
    gemm_loop<4, 2, true, true>(lds, 8,
        [&](int r, int k) { return pb + ((size_t)(mt * 32 + gi * 8) * 256 + r) * 64 + k; },
        [&](int r, int k) { return w + ((size_t)(nt * 8) * 128 + r) * 64 + k; }, acc, 256 * 64, 128 * 64);
    EPI_LOOP(4, 2) {
      const int row = EPI_ROW(m0), col = EPI_COL(n0);
      f32x4 v = acc[mi][ni];
      float4 sc = *(const float4*)(p.pool_scale + j * 2048 + col);
      u16x4 zv = *(const u16x4*)(uz + (size_t)NT_TOK * 2048 + (size_t)row * 2048 + col);
      f32x4 o;
      o[0] = v[0] * sc.x * bf2f(zv[0]); o[1] = v[1] * sc.y * bf2f(zv[1]);
      o[2] = v[2] * sc.z * bf2f(zv[2]); o[3] = v[3] * sc.w * bf2f(zv[3]);
      *(u16x4*)(m + blkA(row, col, 32)) = pack4(o);
    }
  }
}

__device__ __forceinline__ void ph_inproj_mla(const Params& p, char* lds, int bid, int nb) {
  const u16* h = (const u16*)(p.ws + OFF_H);
  const u16* w = (const u16*)(p.ws + W_WIN);
  float* qa = (float*)(p.ws + A_QA);
  float* ckvf = (float*)(p.ws + A_CKVF);
  float* kpef = (float*)(p.ws + A_KPEF);
  u16* zb = (u16*)(p.ws + OFF_B);
  for (int t = bid; t < 480; t += nb) {
    const int x = t & 7, l = t >> 3;
    const int mt = x * 6 + l / 10, nt = l % 10;
    const int m0 = mt * 256, n0 = nt * 256;
    f32x4 acc[8][4];
    gemm_loop2<8>(lds, 16,
        [&](int r, int k) { return h + blkA(m0 + r, k, 16); },
        [&](int r, int k) { int n = n0 + r; n = n > 2495 ? 2495 : n; return w + blkB(n, k, 16); }, acc, 256 * 64, 128 * 64);
    EPI2_LOOP(8) {
      const int row = EPI2_ROW(m0, 8), col = EPI2_COL(n0);
      f32x4 v = acc[mi][ni];
      if (col < 256) {
        *(f32x4*)(qa + (size_t)row * 256 + col) = v;
      } else if (col < 384) {
        *(f32x4*)(ckvf + (size_t)row * 128 + (col - 256)) = v;
      } else if (col < 448) {
        *(f32x4*)(kpef + (size_t)row * 64 + (col - 384)) = v;
      } else if (col < 2496) {
        v[0] = fsilu(v[0]); v[1] = fsilu(v[1]); v[2] = fsilu(v[2]); v[3] = fsilu(v[3]);
        *(u16x4*)(zb + (size_t)row * 2048 + (col - 448)) = pack4(v);
      }
    }
  }
}

__device__ __forceinline__ int vt_slot(int pos) {
  int k = pos & 31;
  return (pos & ~31) | (((k >> 2) & 3) * 8 + (k >> 4) * 4 + (k & 3));
}

__device__ __forceinline__ void ph_mlanorm(const Params& p, int j, char* lds, int bid, int nb) {
  const int tid = threadIdx.x, lane = tid & 63, wid = tid >> 6;
  const float* qa = (const float*)(p.ws + A_QA);
  const float* ckvf = (const float*)(p.ws + A_CKVF);
  const float* kpef = (const float*)(p.ws + A_KPEF);
  u16* qan = (u16*)(p.ws + OFF_QAN);
  u16* Kb = (u16*)(p.ws + OFF_KB);
  u16* VT = (u16*)(p.ws + OFF_VT);
  u16* tile = (u16*)lds;
  for (int it = bid; it < 208; it += nb) {
    const bool cache = it >= 192;
    int kvrow0, pos0, Lk; size_t vtbase;
    int tok0 = 0, cb = 0, ci0 = 0;
    bool sample = false;
    if (!cache) {
      tok0 = it * 64;
      if (tok0 < 8192) { int b = tok0 >> 8; pos0 = tok0 & 255; kvrow0 = tok0; Lk = 256; vtbase = (size_t)b * 128 * 256; }
      else { sample = true; int b = (tok0 - 8192) >> 11; int t0 = (tok0 - 8192) & 2047; pos0 = 512 + t0;
             kvrow0 = 8192 + b * 2560 + pos0; Lk = 2560; vtbase = (size_t)32 * 128 * 256 + (size_t)b * 128 * 2560; }
    } else {
      int q = it - 192; cb = q >> 3; ci0 = (q & 7) * 64; pos0 = ci0;
      kvrow0 = 8192 + cb * 2560 + pos0; Lk = 2560; vtbase = (size_t)32 * 128 * 256 + (size_t)cb * 128 * 2560;
    }
#pragma unroll 1
    for (int i = 0; i < 8; ++i) {
      const int rl = wid * 8 + i;
      float c0, c1, kp;
      if (!cache) {
        const int tok = tok0 + rl;
        float4 qv = *(const float4*)(qa + (size_t)tok * 256 + lane * 4);
        float ss = wave_sum(qv.x * qv.x + qv.y * qv.y + qv.z * qv.z + qv.w * qv.w);
        float rs = rsqrtf(ss * (1.f / 256.f) + 1e-6f);
        float4 qg = *(const float4*)(p.mla_q_norm + j * 256 + lane * 4);
        u16x4 qo;
        qo[0] = f2bf(qv.x * rs * qg.x); qo[1] = f2bf(qv.y * rs * qg.y);
        qo[2] = f2bf(qv.z * rs * qg.z); qo[3] = f2bf(qv.w * rs * qg.w);
        *(u16x4*)(qan + blkA(tok, lane * 4, 4)) = qo;
        float2 cv = *(const float2*)(ckvf + (size_t)tok * 128 + lane * 2);
        float s2 = wave_sum(cv.x * cv.x + cv.y * cv.y);
        float r2 = rsqrtf(s2 * (1.f / 128.f) + 1e-6f);
        float2 kg = *(const float2*)(p.mla_kv_norm + j * 128 + lane * 2);
        c0 = cv.x * r2 * kg.x; c1 = cv.y * r2 * kg.y;
        float x = kpef[(size_t)tok * 64 + lane];
        if (!sample) {
          *(float2*)(p.out + OUT_CKV + (size_t)tok * 128 + lane * 2) = make_float2(c0, c1);
          p.out[OUT_KPE + (size_t)tok * 64 + lane] = x;
          kp = x;
        } else {
          const int tpos = (tok - 8192) & 2047;
          const int axis = lane >> 5, within = lane & 31, fi = within & 15, isx2 = within >> 4;
          float xp = __shfl_xor(x, 16);
          float posf = (float)(axis == 0 ? (tpos >> 6) : (tpos & 63));
          float inv = __builtin_amdgcn_exp2f(-(float)fi * 0.830482023721841f);
          float rev = posf * inv * 0.15915494309189535f;
          rev -= rintf(rev);
          float cs = __builtin_amdgcn_cosf(rev), sn = __builtin_amdgcn_sinf(rev);
          float x1 = isx2 ? xp : x, x2 = isx2 ? x : xp;
          kp = isx2 ? (x1 * sn + x2 * cs) : (x1 * cs - x2 * sn);
        }
      } else {
        const size_t ci = (size_t)(cb * 1 + j) * 512 + ci0 + rl;
        float2 cv = *(const float2*)(p.cache_ckv + ci * 128 + lane * 2);
        c0 = cv.x; c1 = cv.y;
        kp = p.cache_kpe[ci * 64 + lane];
      }
      const size_t kr = (size_t)(kvrow0 + rl);
      unsigned pk = (unsigned)f2bf(c0) | ((unsigned)f2bf(c1) << 16);
      *(unsigned*)(Kb + kr * 192 + lane * 2) = pk;
      Kb[kr * 192 + 128 + lane] = f2bf(kp);
      *(unsigned*)(tile + rl * 136 + lane * 2) = pk;
    }
    __syncthreads();
    {
      const int d = tid >> 2, part = tid & 3;
      u16x8 o0, o1;
#pragma unroll
      for (int e = 0; e < 16; ++e) {
        int s = part * 16 + e;
        int blk = s >> 5, sl = s & 31;
        int kgq = sl >> 3, sub = (sl >> 2) & 1, jj = sl & 3;
        int kap = sub * 16 + kgq * 4 + jj;
        u16 v = tile[(blk * 32 + kap) * 136 + d];
        if (e < 8) o0[e] = v; else o1[e - 8] = v;
      }
      u16* dst = VT + vtbase + ((size_t)(pos0 >> 6) * 128 + d) * 64 + part * 16;
      *(u16x8*)(dst) = o0;
      *(u16x8*)(dst + 8) = o1;
    }
    __syncthreads();
  }
}

__device__ __forceinline__ void ph_qgemm(const Params& p, char* lds, int bid, int nb) {
  const u16* qan = (const u16*)(p.ws + OFF_QAN);
  const u16* w = (const u16*)(p.ws + W_WQ);
  u16* q = (u16*)(p.ws + OFF_A);
  const float SC = 0.07216878364870322f * 1.4426950408889634f;
  for (int l = (bid >> 3); l < 48 * 3; l += (nb >> 3)) {
    const int mt = l / 3, nt = (bid & 7) * 3 + l % 3;
    const int m0 = mt * 256, n0 = nt * 128;
    f32x4 acc[4][4];
    gemm_loop<4, 2, true, true>(lds, 4,
        [&](int r, int k) { return qan + ((size_t)(mt * 4) * 256 + r) * 64 + k; },
        [&](int r, int k) { return w + ((size_t)(nt * 4) * 128 + r) * 64 + k; }, acc, 256 * 64, 128 * 64);
    const int lane = threadIdx.x & 63, wid = threadIdx.x >> 6;
    const int wr = wid >> 1, wc = wid & 1, fr = lane & 15, fq = lane >> 4;
    const int cb = n0 + wc * 64;
    const bool rope = (m0 >= 8192) && ((cb % 192) == 128);
#pragma unroll
    for (int mi = 0; mi < 4; ++mi) {
      const int row = m0 + wr * 64 + mi * 16 + fr;
      f32x4 v[4];
#pragma unroll
      for (int ni = 0; ni < 4; ++ni) v[ni] = acc[mi][ni];
      if (rope) {
        const int tpos = (row - 8192) & 2047;
#pragma unroll
        for (int ax = 0; ax < 2; ++ax) {
          const float posf = (float)(ax == 0 ? (tpos >> 6) : (tpos & 63));
#pragma unroll
          for (int jj = 0; jj < 4; ++jj) {
            const int fi = fq * 4 + jj;
            float inv = __builtin_amdgcn_exp2f(-(float)fi * 0.830482023721841f);
            float rev = posf * inv * 0.15915494309189535f;
            rev -= rintf(rev);
            float cs = __builtin_amdgcn_cosf(rev), sn = __builtin_amdgcn_sinf(rev);
            float x1 = v[ax * 2][jj], x2 = v[ax * 2 + 1][jj];
            v[ax * 2][jj] = x1 * cs - x2 * sn;
            v[ax * 2 + 1][jj] = x1 * sn + x2 * cs;
          }
        }
      }
#pragma unroll
      for (int ni = 0; ni < 4; ++ni) {
        f32x4 o = v[ni];
        o[0] *= SC; o[1] *= SC; o[2] *= SC; o[3] *= SC;
        *(u16x4*)(q + (size_t)row * 3072 + cb + ni * 16 + fq * 4) = pack4(o);
      }
    }
  }
}

__device__ __forceinline__ void ph_attn(const Params& p, char* lds, int bid, int nb) {
  const int tid = threadIdx.x, lane = tid & 63, wid = tid >> 6, fr = lane & 15, fq = lane >> 4;
  const u16* q = (const u16*)(p.ws + OFF_A);
  const u16* Kb = (const u16*)(p.ws + OFF_KB);
  const u16* VT = (const u16*)(p.ws + OFF_VT);
  u16* ol = (u16*)(p.ws + OFF_C);
  for (int it = bid; it < 768; it += nb) {
    int h, tokq0, kvbase, Lk; size_t vtbase;
    if (it < 256) { int b = it >> 7, qt = (it >> 4) & 7; h = it & 15; tokq0 = 8192 + b * 2048 + qt * 256;
                    kvbase = 8192 + b * 2560; Lk = 2560; vtbase = (size_t)32 * 128 * 256 + (size_t)b * 128 * 2560; }
    else { int r = it - 256; int b = r >> 4; h = r & 15; tokq0 = b * 256; kvbase = b * 256; Lk = 256;
           vtbase = (size_t)b * 128 * 256; }
    const int nkt = Lk >> 6;
    const u16* vt = VT + vtbase;
    bf16x8 qf[2][6];
#pragma unroll
    for (int qs = 0; qs < 2; ++qs)
#pragma unroll
      for (int ks = 0; ks < 6; ++ks)
        qf[qs][ks] = *(const bf16x8*)(q + (size_t)(tokq0 + wid * 32 + qs * 16 + fr) * 3072 + h * 192 + ks * 32 + fq * 8);
    f32x4 O[8][2];
#pragma unroll
    for (int d = 0; d < 8; ++d) { O[d][0] = f32x4{0, 0, 0, 0}; O[d][1] = f32x4{0, 0, 0, 0}; }
    float mrun[2] = {-1e30f, -1e30f}, lrun[2] = {0.f, 0.f};

    int koff[3], voff[2];
#pragma unroll
    for (int i = 0; i < 3; ++i) {
      int idx = tid + i * 512;
      int r = idx / 24, pos = idx - r * 24;
      int kc = (pos & ~7) | ((pos ^ r) & 7);
      koff[i] = r * 192 + kc * 8;
    }
#pragma unroll
    for (int i = 0; i < 2; ++i) {
      int idx = tid + i * 512;
      int d = idx >> 3, pos = idx & 7;
      voff[i] = d * 64 + ((pos ^ (d & 7)) * 8);
    }
    const u16* kbase = Kb + (size_t)kvbase * 192;
    auto glds_kv = [&](int i, int kt, int buf) {
      char* base = lds + buf * 40960 + tid * 16;
      if (i < 3) glds16(kbase + kt * (64 * 192) + koff[i], base + i * 8192);
      else glds16(vt + kt * (128 * 64) + voff[i - 3], base + 24576 + (i - 3) * 8192);
    };
#pragma unroll
    for (int i = 0; i < 5; ++i) glds_kv(i, 0, 0);
    for (int kt = 0; kt < nkt; ++kt) {
      const int cur = kt & 1;
      WAIT_VM(0);
      BARRIER();
      const bool pfn = kt + 1 < nkt;
      const char* kb = lds + cur * 40960;
      const char* vb = kb + 24576;
      f32x4 s[4][2];
#pragma unroll
      for (int sub = 0; sub < 4; ++sub) { s[sub][0] = f32x4{0, 0, 0, 0}; s[sub][1] = f32x4{0, 0, 0, 0}; }
#pragma unroll
      for (int ks = 0; ks < 6; ++ks) {
        const int coff = ((ks >> 1) * 8 + ((((ks & 1) * 4 + fq) ^ fr) & 7)) * 16;
#pragma unroll
        for (int sub = 0; sub < 4; ++sub) {
          bf16x8 kf = *(const bf16x8*)(kb + (sub * 16 + fr) * 384 + coff);
          s[sub][0] = __builtin_amdgcn_mfma_f32_16x16x32_bf16(kf, qf[0][ks], s[sub][0], 0, 0, 0);
          s[sub][1] = __builtin_amdgcn_mfma_f32_16x16x32_bf16(kf, qf[1][ks], s[sub][1], 0, 0, 0);
        }
        if (ks < 5) {
          __builtin_amdgcn_sched_barrier(0);
          if (pfn) glds_kv(ks, kt + 1, cur ^ 1);
          __builtin_amdgcn_sched_barrier(0);
        }
      }
      bf16x8 pf[2][2];
#pragma unroll
      for (int qs = 0; qs < 2; ++qs) {
        float mx = s[0][qs][0];
#pragma unroll
        for (int sub = 0; sub < 4; ++sub)
#pragma unroll
          for (int jj = 0; jj < 4; ++jj) mx = fmaxf(mx, s[sub][qs][jj]);
        mx = fmaxf(mx, __shfl_xor(mx, 16));
        mx = fmaxf(mx, __shfl_xor(mx, 32));
        const float mnew = fmaxf(mrun[qs], mx);
        const float alpha = __builtin_amdgcn_exp2f(mrun[qs] - mnew);
        mrun[qs] = mnew;
        float ps = 0.f;
#pragma unroll
        for (int sub = 0; sub < 4; ++sub)
#pragma unroll
          for (int jj = 0; jj < 4; ++jj) {
            float e = __builtin_amdgcn_exp2f(s[sub][qs][jj] - mnew);
            s[sub][qs][jj] = e;
            ps += e;
          }
        lrun[qs] = lrun[qs] * alpha + ps;
#pragma unroll
        for (int d = 0; d < 8; ++d) { O[d][qs][0] *= alpha; O[d][qs][1] *= alpha; O[d][qs][2] *= alpha; O[d][qs][3] *= alpha; }
#pragma unroll
        for (int kbk = 0; kbk < 2; ++kbk) {
          u32x4_t w = {pack2bf(s[kbk * 2][qs][0], s[kbk * 2][qs][1]), pack2bf(s[kbk * 2][qs][2], s[kbk * 2][qs][3]),
                       pack2bf(s[kbk * 2 + 1][qs][0], s[kbk * 2 + 1][qs][1]), pack2bf(s[kbk * 2 + 1][qs][2], s[kbk * 2 + 1][qs][3])};
          pf[kbk][qs] = __builtin_bit_cast(bf16x8, w);
        }
      }
#pragma unroll
      for (int d = 0; d < 8; ++d)
#pragma unroll
        for (int kbk = 0; kbk < 2; ++kbk) {
          bf16x8 vf = *(const bf16x8*)(vb + (d * 16 + fr) * 128 + (((kbk * 4 + fq) ^ (fr & 7)) << 4));
          O[d][0] = __builtin_amdgcn_mfma_f32_16x16x32_bf16(vf, pf[kbk][0], O[d][0], 0, 0, 0);
          O[d][1] = __builtin_amdgcn_mfma_f32_16x16x32_bf16(vf, pf[kbk][1], O[d][1], 0, 0, 0);
        }
    }
    BARRIER();
#pragma unroll
    for (int qs = 0; qs < 2; ++qs) {
      float l = lrun[qs];
      l += __shfl_xor(l, 16);
      l += __shfl_xor(l, 32);
      const float il = 1.f / l;
      const int tok = tokq0 + wid * 32 + qs * 16 + fr;
#pragma unroll
      for (int d = 0; d < 8; ++d) {
        f32x4 o = O[d][qs];
        o[0] *= il; o[1] *= il; o[2] *= il; o[3] *= il;
        *(u16x4*)(ol + blkA(tok, h * 128 + d * 16 + fq * 4, 32)) = pack4(o);
      }
    }
  }
}

__device__ __forceinline__ void ph_oexp(const Params& p, char* lds, int bid, int nb) {
  const u16* ol = (const u16*)(p.ws + OFF_C);
  const u16* w = (const u16*)(p.ws + W_WUV);
  const u16* zb = (const u16*)(p.ws + OFF_B);
  u16* mo = (u16*)(p.ws + OFF_A);
  for (int l = (bid >> 3); l < 48 * 2; l += (nb >> 3)) {
    const int mt = l / 2, nt = (bid & 7) * 2 + l % 2;
    const int m0 = mt * 256, n0 = nt * 128;
    f32x4 acc[4][4];
    gemm_loop<4, 2, true, true>(lds, 2,
        [&](int r, int k) { return ol + ((size_t)(mt * 32 + nt * 2) * 256 + r) * 64 + k; },
        [&](int r, int k) { return w + ((size_t)(nt * 2) * 128 + r) * 64 + k; }, acc, 256 * 64, 128 * 64);
    EPI_LOOP(4, 2) {
      const int row = EPI_ROW(m0), col = EPI_COL(n0);
      f32x4 v = acc[mi][ni];
      u16x4 zv = *(const u16x4*)(zb + (size_t)row * 2048 + col);
      v[0] *= bf2f(zv[0]); v[1] *= bf2f(zv[1]); v[2] *= bf2f(zv[2]); v[3] *= bf2f(zv[3]);
      *(u16x4*)(mo + blkA(row, col, 32)) = pack4(v);
    }
  }
}

__device__ __forceinline__ void ph_final(const Params& p, int bid, int nb) {
  const int lane = threadIdx.x & 63, wid = threadIdx.x >> 6;
  for (int row = bid * 8 + wid; row < NT_TOK; row += nb * 8) {
    float* x = p.out + (size_t)row * 1024;
    float4 v[4];
    float ss = 0.f;
#pragma unroll
    for (int q = 0; q < 4; ++q) {
      v[q] = *(const float4*)(x + q * 256 + lane * 4);
      ss += v[q].x * v[q].x + v[q].y * v[q].y + v[q].z * v[q].z + v[q].w * v[q].w;
    }
    ss = wave_sum(ss);
    const float rstd = rsqrtf(ss * (1.f / 1024.f) + 1e-6f);
#pragma unroll
    for (int q = 0; q < 4; ++q) {
      float4 g = *(const float4*)(p.final_g + q * 256 + lane * 4);
      float4 o;
      o.x = v[q].x * rstd * g.x; o.y = v[q].y * rstd * g.y; o.z = v[q].z * rstd * g.z; o.w = v[q].w * rstd * g.w;
      *(float4*)(x + q * 256 + lane * 4) = o;
    }
  }
}

#define XB_TMO      128
#define XB_XCNT(j)  (256  + 64 * (j))
#define XB_XSUB(j)  (1280 + 64 * (j))
#define XB_XGEN(j)  (2304 + 64 * (j))
#define XB_TOP      3328
#define XB_TOPGEN   3392
#define XCD_BAR_WORDS 3456
#define XB_SPIN_CAP (1u << 18)
#define LAS __attribute__((address_space(3)))

__device__ __forceinline__ unsigned xb_ld(unsigned* p)              { return __hip_atomic_load(p, __ATOMIC_RELAXED, __HIP_MEMORY_SCOPE_AGENT); }
__device__ __forceinline__ unsigned xb_add(unsigned* p, unsigned v) { return __hip_atomic_fetch_add(p, v, __ATOMIC_RELAXED, __HIP_MEMORY_SCOPE_AGENT); }
__device__ __forceinline__ unsigned xb_xcc_id() { return (unsigned)__builtin_amdgcn_s_getreg((3 << 11) | 20) & 0xFu; }
#define XB_SPIN(cond, bar) do { unsigned _sp = 0; while (cond) { __builtin_amdgcn_s_sleep(1); \
    if ((++_sp & 255u) == 0u) { if (xb_ld(&(bar)[XB_TMO])) break; if (_sp > XB_SPIN_CAP) { atomicAdd(&(bar)[XB_TMO], 1u); break; } } } } while (0)

struct XcdBarrier {
    unsigned* bar; unsigned x;
    volatile LAS unsigned* st;
};

__device__ __forceinline__ XcdBarrier xcd_barrier_post(unsigned* bar, volatile LAS unsigned* st) {
    XcdBarrier b; b.bar = bar; b.x = xb_xcc_id(); b.st = st;
    if (threadIdx.x == 0) (void)xb_add(&bar[XB_XCNT(b.x)], 1u);
    return b;
}
__device__ __forceinline__ void xcd_barrier_complete(unsigned* bar, unsigned x, unsigned& nloc, unsigned& nx) {
    const unsigned G = gridDim.x * gridDim.y * gridDim.z;
    unsigned sum, cnt, mine, sp = 0u;
    for (;;) {
        sum = 0u; cnt = 0u; mine = 0u;
#pragma unroll
        for (unsigned j = 0; j < 16; ++j) { const unsigned c = xb_ld(&bar[XB_XCNT(j)]); sum += c; cnt += (c > 0u) ? 1u : 0u; mine = (j == x) ? c : mine; }
        if (sum == G) break;
        __builtin_amdgcn_s_sleep(1);
        if ((++sp & 255u) == 0u) { if (xb_ld(&bar[XB_TMO])) break; if (sp > XB_SPIN_CAP) { atomicAdd(&bar[XB_TMO], 1u); break; } }
    }
    nloc = mine > 0u ? mine : 1u; nx = cnt > 0u ? cnt : 1u;
}

__device__ __forceinline__ void xcd_barrier(const XcdBarrier& b) {
    asm volatile("s_waitcnt vmcnt(0)" ::: "memory");
    __syncthreads();
    if (threadIdx.x == 0) {
        unsigned* bar = b.bar;
        __builtin_amdgcn_s_waitcnt(0);
        unsigned nloc = b.st[0], nx = b.st[1];
        if (nloc == 0u) { xcd_barrier_complete(bar, b.x, nloc, nx); b.st[0] = nloc; b.st[1] = nx; }
        const unsigned old = xb_add(&bar[XB_XSUB(b.x)], 1u);
        const unsigned gen = old / nloc;
        if (old + 1u == (gen + 1u) * nloc) {
            __builtin_amdgcn_fence(__ATOMIC_RELEASE, "agent");
            asm volatile("s_waitcnt vmcnt(0)" ::: "memory");
            const unsigned og = xb_add(&bar[XB_TOP], 1u);
            const unsigned tg = og / nx;
            if (og + 1u == (tg + 1u) * nx) xb_add(&bar[XB_TOPGEN], 1u);
            else XB_SPIN(xb_ld(&bar[XB_TOPGEN]) == tg, bar);
            __builtin_amdgcn_fence(__ATOMIC_ACQUIRE, "agent");
            xb_add(&bar[XB_XGEN(b.x)], 1u);
            asm volatile("s_waitcnt vmcnt(0)" ::: "memory");
        } else {
            XB_SPIN(xb_ld(&bar[XB_XGEN(b.x)]) == gen, bar);
            __builtin_amdgcn_fence(__ATOMIC_ACQUIRE, "agent");
            asm volatile("s_waitcnt vmcnt(0)" ::: "memory");
        }
    }
    __syncthreads();
}


#define N_PHASES 28
template <int ph>
__device__ __forceinline__ void run_phase(const Params& p, char* lds, int bid, int nb) {
  switch (ph) {
    case 0: ph_prep(p, 0, true, false, lds, bid, nb); break;
    case 1: ph_norm(p, 0, lds, bid, nb); break;
    case 2: ph_inproj(p, lds, bid, nb); break;
    case 3: ph_s5g1(p, lds, bid, nb); break;
    case 4: ph_scan(p, 0, bid, nb); break;
    case 5: ph_s5g3(p, lds, bid, nb); break;
    case 6: ph_glu(p, 0, lds, bid, nb); break;
    case 7: ph_out(p, 0, (const u16*)(p.ws + OFF_C), lds, bid, nb); break;
    case 8: ph_prep(p, 1, false, true, lds, bid, nb); break;
    case 9: ph_inproj(p, lds, bid, nb); break;
    case 10: ph_pool(p, bid, nb); break;
    case 11: ph_poolmm(p, 0, lds, bid, nb); break;
    case 12: ph_out(p, 1, (const u16*)(p.ws + OFF_C), lds, bid, nb); break;
    case 13: ph_prep(p, 2, false, true, lds, bid, nb); break;
    case 14: ph_inproj_mla(p, lds, bid, nb); break;
    case 15: ph_mlanorm(p, 0, lds, bid, nb); break;
    case 16: ph_qgemm(p, lds, bid, nb); break;
    case 17: ph_attn(p, lds, bid, nb); break;
    case 18: ph_oexp(p, lds, bid, nb); break;
    case 19: ph_out(p, 2, (const u16*)(p.ws + OFF_A), lds, bid, nb); break;
    case 20: ph_prep(p, 3, false, true, lds, bid, nb); break;
    case 21: ph_inproj(p, lds, bid, nb); break;
    case 22: ph_s5g1(p, lds, bid, nb); break;
    case 23: ph_scan(p, 1, bid, nb); break;
    case 24: ph_s5g3(p, lds, bid, nb); break;
    case 25: ph_glu(p, 1, lds, bid, nb); break;
    case 26: ph_out(p, 3, (const u16*)(p.ws + OFF_C), lds, bid, nb); break;
    case 27: ph_final(p, bid, nb); break;
    default: break;
  }
}

template <int PH>
__device__ __forceinline__ void run_all(const Params& p, char* lds, cg::grid_group& grid, const XcdBarrier& xb, int bid, int nb) {
  if constexpr (PH < N_PHASES) {
    run_phase<PH>(p, lds, bid, nb);
#ifdef DUP_PHASE
    if constexpr (PH == DUP_PHASE) { xcd_barrier(xb); run_phase<PH>(p, lds, bid, nb); }
#endif
    if constexpr (PH + 1 < N_PHASES) {
      if constexpr (PH == 0) grid.sync(); else xcd_barrier(xb);
      run_all<PH + 1>(p, lds, grid, xb, bid, nb);
    }
  }
}

#if MK_SINGLE
__global__ void __launch_bounds__(512) k_mega(Params p) {
  __shared__ __attribute__((aligned(16))) char lds[LDS_BYTES];
  __shared__ uint4 xb_words;
  __shared__ int s_vbid;
  cg::grid_group grid = cg::this_grid();
  unsigned* bar = (unsigned*)(p.ws + OFF_BAR);
  if (threadIdx.x == 0) {
    xb_words = make_uint4(0u, 0u, 0u, 0u);
    const unsigned x = xb_xcc_id() & 7u;
    const unsigned j = atomicAdd(&bar[XCD_BAR_WORDS + 64 * x], 1u);
    s_vbid = (int)(j * 8u + x);
  }
  __syncthreads();
  XcdBarrier xb = xcd_barrier_post(bar, (volatile LAS unsigned*)&xb_words);
  const int nb = gridDim.x;
  run_phase<0>(p, lds, blockIdx.x, nb);
  xcd_barrier(xb);
  int vb = s_vbid;
  {
    bool ok = (nb & 7) == 0;
#pragma unroll
    for (int x = 0; x < 8; ++x) ok = ok && (xb_ld(&bar[XCD_BAR_WORDS + 64 * x]) == (unsigned)(nb >> 3));
    if (!ok) vb = blockIdx.x;
  }
  run_all<1>(p, lds, grid, xb, vb, nb);
}
#else
template <int PH>
__global__ void __launch_bounds__(512) __attribute__((amdgpu_waves_per_eu(2, 2))) k_phase(Params p) {
  __shared__ __attribute__((aligned(16))) char lds[LDS_BYTES];
  run_phase<PH>(p, lds, blockIdx.x, gridDim.x);
}
template <int PH>
static void launch_all(const Params& p, hipStream_t stream) {
  if constexpr (PH < N_PHASES) {
    k_phase<PH><<<256, 512, 0, stream>>>(p);
    launch_all<PH + 1>(p, stream);
  }
}
#endif

extern "C" void kernel_launch(void* const* d_in, const int* in_sizes, int n_in, void* d_out, int out_size,
                              void* d_ws, size_t ws_size, hipStream_t stream) {
  Params p{};
  const float** f = (const float**)&p;
  for (int i = 0; i < 34; ++i) f[i] = (const float*)d_in[i];
  p.out = (float*)d_out;
  p.ws = (char*)d_ws;
#if MK_SINGLE
  static int grid_blocks = 0;
  if (!grid_blocks) {
    int dev = 0, cus = 0, per_cu = 0;
    (void)hipGetDevice(&dev);
    (void)hipDeviceGetAttribute(&cus, hipDeviceAttributeMultiprocessorCount, dev);
    (void)hipOccupancyMaxActiveBlocksPerMultiprocessor(&per_cu, k_mega, 512, 0);
    if (per_cu > 1) per_cu = 1;
    grid_blocks = cus * per_cu;
    if (grid_blocks <= 0) grid_blocks = 256;
  }
  (void)hipMemsetAsync((char*)d_ws + OFF_BAR, 0, (XCD_BAR_WORDS + 8 * 64) * 4, stream);
  void* args[] = {&p};
  hipError_t e = hipLaunchCooperativeKernel((void*)k_mega, dim3(grid_blocks), dim3(512), args, 0, stream);
  if (e != hipSuccess) fprintf(stderr, "cooperative launch failed: %s (grid %d)\n", hipGetErrorString(e), grid_blocks);
#else
  launch_all<0>(p, stream);
#endif
}
```

```cpp
#include <hip/hip_runtime.h>
#include <hip/hip_cooperative_groups.h>
#include <cstdio>
namespace cg = cooperative_groups;

#ifndef MK_SINGLE
#define MK_SINGLE 1
#endif

typedef unsigned short u16;
using bf16x8 = __attribute__((ext_vector_type(8))) short;
using f32x4  = __attribute__((ext_vector_type(4))) float;
using u16x4  = __attribute__((ext_vector_type(4))) unsigned short;
using u16x8  = __attribute__((ext_vector_type(8))) unsigned short;

struct Params {
  const float *x_prompt, *x_sample, *st_re, *st_im, *cache_ckv, *cache_kpe, *c, *c_ctx;
  const float *norm_g, *ada_w, *ada_b, *final_g;
  const float *s5_w_in, *s5_lam_re, *s5_lam_im, *s5_log_step, *s5_b_re, *s5_b_im, *s5_c_re, *s5_c_im;
  const float *s5_d, *s5_glu_w, *s5_glu_b, *s5_w_out;
  const float *pool_w_in, *pool_w, *pool_scale, *pool_w_out;
  const float *mla_w_in, *mla_q_norm, *mla_wq_b, *mla_kv_norm, *mla_wkv_b, *mla_w_out;
  float* out;
  char* ws;
};

constexpr size_t MiB = 1ull << 20;
constexpr size_t OFF_W = 0, OFF_A = 20 * MiB, OFF_B = 116 * MiB, OFF_C = 164 * MiB, OFF_M = 212 * MiB,
                 OFF_H = 228 * MiB;
constexpr size_t OFF_BAR = OFF_M + 512 * 1024;
constexpr size_t OFF_MOD = OFF_M, OFF_QAN = OFF_M + 1 * MiB, OFF_KB = OFF_M + 7 * MiB, OFF_VT = OFF_M + 12 * MiB;
constexpr size_t W_WIN = OFF_W, W_GLU = OFF_W + 8 * MiB, W_POOLW = OFF_W + 8 * MiB, W_WQ = OFF_W + 6 * MiB,
                 W_WUV = OFF_W + 8 * MiB, W_WOUT = OFF_W + 16 * MiB;
constexpr size_t A_QA = OFF_A + 72 * MiB, A_CKVF = OFF_A + 84 * MiB, A_KPEF = OFF_A + 90 * MiB;
constexpr size_t B_WST = OFF_B, B_WBIG = OFF_B + 16 * MiB;

constexpr int OUT_RE = 12582912, OUT_IM = 13631488, OUT_CKV = 14680064, OUT_KPE = 15728640;

#define NT_TOK 12288
#define LDS_BYTES 147456

typedef float f32x2_t __attribute__((ext_vector_type(2)));
typedef __bf16 bf16x2_t __attribute__((ext_vector_type(2)));
typedef unsigned u32x2_t __attribute__((ext_vector_type(2)));
typedef unsigned u32x4_t __attribute__((ext_vector_type(4)));
__device__ __forceinline__ unsigned pack2bf(float a, float b) {
  f32x2_t v = {a, b};
  bf16x2_t r = __builtin_convertvector(v, bf16x2_t);
  return __builtin_bit_cast(unsigned, r);
}
__device__ __forceinline__ u16 f2bf(float f) { return (u16)(pack2bf(f, 0.f) & 0xffffu); }
__device__ __forceinline__ float bf2f(u16 h) { return __uint_as_float(((unsigned)h) << 16); }
__device__ __forceinline__ float frcp(float x) { return __builtin_amdgcn_rcpf(x); }
__device__ __forceinline__ float fsigmoid(float x) { return frcp(1.f + __builtin_amdgcn_exp2f(-1.4426950408889634f * x)); }
__device__ __forceinline__ float fsilu(float x) { return x * fsigmoid(x); }
__device__ __forceinline__ float fgelu(float x) {
  float y = 0.7978845608028654f * (x + 0.044715f * x * x * x);
  return x * fsigmoid(2.f * y);
}
__device__ __forceinline__ float2 cis_rev(double rev) {
  double f = rev - rint(rev);
  float ff = (float)f;
  return make_float2(__builtin_amdgcn_cosf(ff), __builtin_amdgcn_sinf(ff));
}
__device__ __forceinline__ float wave_sum(float v) {
#pragma unroll
  for (int o = 32; o > 0; o >>= 1) v += __shfl_xor(v, o);
  return v;
}
__device__ __forceinline__ int cond_of_row(int row) { return row < 8192 ? 0 : 1 + ((row - 8192) >> 11); }
__device__ __forceinline__ u16x4 pack4(f32x4 v) {
  u32x2_t w = {pack2bf(v[0], v[1]), pack2bf(v[2], v[3])};
  return __builtin_bit_cast(u16x4, w);
}
__device__ __forceinline__ u16x8 pack8(const float* a) {
  u32x4_t w = {pack2bf(a[0], a[1]), pack2bf(a[2], a[3]), pack2bf(a[4], a[5]), pack2bf(a[6], a[7])};
  return __builtin_bit_cast(u16x8, w);
}

__device__ __forceinline__ size_t blkA(int row, int k, int KT) { return ((size_t)((row >> 8) * KT + (k >> 6)) * 256 + (row & 255)) * 64 + (k & 63); }
__device__ __forceinline__ size_t blkB(int n, int k, int KT) { return ((size_t)((n >> 7) * KT + (k >> 6)) * 128 + (n & 127)) * 64 + (k & 63); }
__device__ __forceinline__ size_t ugaddr(int tok, int ch) { return ((size_t)((ch >> 4) * 768 + (tok >> 4))) * 256 + (tok & 15) * 16 + (ch & 15); }
__device__ __forceinline__ size_t xaddr(int row, int g, int col) { return ((((size_t)g * 6 + (row >> 7)) * 4 + (col >> 6)) * 128 + (row & 127)) * 64 + (col & 63); }

#define WAIT_VM(n) asm volatile("s_waitcnt vmcnt(" #n ")" ::: "memory")
#define BARRIER()                        \
  do {                                   \
    asm volatile("" ::: "memory");       \
    __builtin_amdgcn_s_barrier();        \
    asm volatile("" ::: "memory");       \
  } while (0)

__device__ __forceinline__ void glds16(const void* g, char* l) {
  __builtin_amdgcn_global_load_lds((const unsigned*)g, (unsigned*)l, 16, 0, 0);
}

template <int WM, int WN, bool LINA, bool LINB, int MI = 4, class AF, class BF>
__device__ __forceinline__ void gemm_loop(char* lds, int nk, AF af, BF bf, f32x4 (&acc)[MI][4], int ksa = 64, int ksb = 64) {
  constexpr int BM = WM * MI * 16, BN = WN * 64;
  constexpr int NA = BM / 64, NB = BN / 64, NG = NA + NB;
  constexpr int STG = (BM + BN) * 128;
  static_assert(3 * STG <= LDS_BYTES, "lds");
  static_assert(NG <= 2 * MI, "glds slots");
  const int tid = threadIdx.x, lane = tid & 63, wid = tid >> 6;
  const int wr = wid / WN, wc = wid % WN, fr = lane & 15, fq = lane >> 4;
  const int srow = tid >> 3;
  const int skc = ((tid & 7) ^ (srow & 7)) * 8;
#pragma unroll
  for (int mi = 0; mi < MI; ++mi)
#pragma unroll
    for (int ni = 0; ni < 4; ++ni) acc[mi][ni] = f32x4{0.f, 0.f, 0.f, 0.f};

  const u16* pa[NA];
  const u16* pb[NB];
  if constexpr (LINA) {
#pragma unroll
    for (int i = 0; i < NA; ++i) pa[i] = af(srow + i * 64, skc);
  }
  if constexpr (LINB) {
#pragma unroll
    for (int i = 0; i < NB; ++i) pb[i] = bf(srow + i * 64, skc);
  }
  auto glds_one = [&](int i, int kt, char* base) {
    if (i < NA)
      glds16(LINA ? pa[i] + kt * ksa : af(srow + i * 64, kt * 64 + skc), base + i * 8192);
    else
      glds16(LINB ? pb[i - NA] + kt * ksb : bf(srow + (i - NA) * 64, kt * 64 + skc),
             base + BM * 128 + (i - NA) * 8192);
  };
  auto stage = [&](int kt, int buf) {
    char* base = lds + buf * STG + tid * 16;
#pragma unroll
    for (int i = 0; i < NG; ++i) glds_one(i, kt, base);
  };
  constexpr int H1 = NG / 2;
  stage(0, 0);
  if (nk > 1) stage(1, 1);
  if (nk > 1) { asm volatile("s_waitcnt vmcnt(%0)" ::"n"(NG) : "memory"); } else { WAIT_VM(0); }
  BARRIER();
  int cur = 0;
  const int rowoffA = (wr * (MI * 16) + fr) * 128, rowoffB = BM * 128 + (wc * 64 + fr) * 128;
  const int off0 = ((0 + fq) ^ (fr & 7)) << 4, off1 = ((4 + fq) ^ (fr & 7)) << 4;
  bf16x8 a0[MI], b0[4], a1[MI], b1[4];
#pragma unroll
  for (int mi = 0; mi < MI; ++mi) a0[mi] = *(const bf16x8*)(lds + rowoffA + mi * 2048 + off0);
#pragma unroll
  for (int ni = 0; ni < 4; ++ni) b0[ni] = *(const bf16x8*)(lds + rowoffB + ni * 2048 + off0);
  for (int kt = 0; kt < nk; ++kt) {
    const bool pf = kt + 2 < nk;
    const int nxt = cur == 2 ? 0 : cur + 1;
    char* nbase = lds + (cur >= 1 ? cur - 1 : 2) * STG + tid * 16;
    const char* sa = lds + cur * STG + rowoffA;
    const char* sb = lds + cur * STG + rowoffB;
#pragma unroll
    for (int m2 = 0; m2 < MI; ++m2) a1[m2] = *(const bf16x8*)(sa + m2 * 2048 + off1);
#pragma unroll
    for (int n2 = 0; n2 < 4; ++n2) b1[n2] = *(const bf16x8*)(sb + n2 * 2048 + off1);
    __builtin_amdgcn_sched_barrier(0);
#pragma unroll
    for (int g = 0; g < MI; ++g) {
#pragma unroll
      for (int ni = 0; ni < 4; ++ni)
        acc[g][ni] = __builtin_amdgcn_mfma_f32_16x16x32_bf16(b0[ni], a0[g], acc[g][ni], 0, 0, 0);
      __builtin_amdgcn_sched_barrier(0);
      if (g < H1) { if (pf) glds_one(g, kt + 2, nbase); }
      __builtin_amdgcn_sched_barrier(0);
    }
    asm volatile("s_waitcnt lgkmcnt(0)" ::: "memory");
    if (pf) { asm volatile("s_waitcnt vmcnt(%0)" ::"n"(H1) : "memory"); } else { WAIT_VM(0); }
    BARRIER();
    if (kt + 1 < nk) {
      const char* na = lds + nxt * STG + rowoffA;
      const char* nbp = lds + nxt * STG + rowoffB;
#pragma unroll
      for (int m2 = 0; m2 < MI; ++m2) a0[m2] = *(const bf16x8*)(na + m2 * 2048 + off0);
#pragma unroll
      for (int n2 = 0; n2 < 4; ++n2) b0[n2] = *(const bf16x8*)(nbp + n2 * 2048 + off0);
    }
    __builtin_amdgcn_sched_barrier(0);
#pragma unroll
    for (int g = 0; g < MI; ++g) {
#pragma unroll
      for (int ni = 0; ni < 4; ++ni)
        acc[g][ni] = __builtin_amdgcn_mfma_f32_16x16x32_bf16(b1[ni], a1[g], acc[g][ni], 0, 0, 0);
      __builtin_amdgcn_sched_barrier(0);
      if (H1 + g < NG) { if (pf) glds_one(H1 + g, kt + 2, nbase); }
      __builtin_amdgcn_sched_barrier(0);
    }
    cur = nxt;
  }
}

struct NoSeg { __device__ const u16* operator()(int, int) const { return nullptr; } };
template <int MI, bool SEG2 = false, class AF, class BF, class AF2 = NoSeg>
__device__ __forceinline__ void gemm_loop2(char* lds, int nk, AF af, BF bf, f32x4 (&acc)[MI][4], int ksa, int ksb,
                                           AF2 af2 = NoSeg(), int ksa2 = 0, int ksplit = 1 << 30) {
  constexpr int BM = 2 * MI * 16, BN = 256;
  constexpr int NA = BM / 64, NB = BN / 64, NG = NA + NB;
  constexpr int STG = (BM + BN) * 128;
  static_assert(2 * STG + 2048 <= LDS_BYTES, "lds");
  static_assert(NG < 2 * MI, "glds slots");
  const int tid = threadIdx.x, lane = tid & 63, wid = tid >> 6;
  const int wr = wid >> 2, wc = wid & 3, fr = lane & 15, fq = lane >> 4;
  const int srow = tid >> 3;
  const int skc = ((tid & 7) ^ (srow & 7)) * 8;
#pragma unroll
  for (int mi = 0; mi < MI; ++mi)
#pragma unroll
    for (int ni = 0; ni < 4; ++ni) acc[mi][ni] = f32x4{0.f, 0.f, 0.f, 0.f};
  const u16* pa[NA];
  const u16* pa2[NA];
  const u16* pb[NB];
#pragma unroll
  for (int i = 0; i < NA; ++i) pa[i] = af(srow + i * 64, skc);
  if constexpr (SEG2) {
#pragma unroll
    for (int i = 0; i < NA; ++i) pa2[i] = af2(srow + i * 64, skc);
  }
#pragma unroll
  for (int i = 0; i < NB; ++i) pb[i] = bf(srow + i * 64, skc);
  auto glds_one = [&](int i, int kt, char* base) {
    if (i < NA) {
      if (SEG2 && kt >= ksplit) glds16(pa2[i] + (kt - ksplit) * ksa2, base + i * 8192);
      else glds16(pa[i] + kt * ksa, base + i * 8192);
    } else glds16(pb[i - NA] + kt * ksb, base + BM * 128 + (i - NA) * 8192);
  };
  const int pidx = tid < BM + BN ? tid : BM + BN - 1;
  const u16* ppf = pidx < BM ? af(pidx, 0) : bf(pidx - BM, 0);
  const int pstride = pidx < BM ? ksa : ksb;
  char* pdummy = lds + 2 * STG + tid * 4;
  auto prefetch = [&](int kt) {
    int k2 = kt < nk ? kt : nk - 1;
    if (SEG2) k2 = k2 < ksplit ? k2 : ksplit - 1;
    __builtin_amdgcn_global_load_lds((const unsigned*)(ppf + (size_t)k2 * pstride), (unsigned*)pdummy, 4, 0, 0);
  };
  {
    char* base = lds + tid * 16;
#pragma unroll
    for (int i = 0; i < NG; ++i) glds_one(i, 0, base);
    prefetch(2);
  }
  const int rowoffA = (wr * (MI * 16) + fr) * 128, rowoffB = BM * 128 + (wc * 64 + fr) * 128;
  for (int kt = 0; kt < nk; ++kt) {
    const int cur = kt & 1;
    WAIT_VM(1);
    BARRIER();
    const bool pf = kt + 1 < nk;
    char* nbase = lds + (cur ^ 1) * STG + tid * 16;
    const char* sa = lds + cur * STG + rowoffA;
    const char* sb = lds + cur * STG + rowoffB;
#pragma unroll
    for (int ks = 0; ks < 2; ++ks) {
      const int off = ((ks * 4 + fq) ^ (fr & 7)) << 4;
      bf16x8 a[MI], b[4];
#pragma unroll
      for (int mi = 0; mi < MI; ++mi) a[mi] = *(const bf16x8*)(sa + mi * 2048 + off);
#pragma unroll
      for (int ni = 0; ni < 4; ++ni) b[ni] = *(const bf16x8*)(sb + ni * 2048 + off);
      __builtin_amdgcn_sched_barrier(0);
#pragma unroll
      for (int g = 0; g < MI; ++g) {
#pragma unroll
        for (int ni = 0; ni < 4; ++ni)
          acc[g][ni] = __builtin_amdgcn_mfma_f32_16x16x32_bf16(b[ni], a[g], acc[g][ni], 0, 0, 0);
        __builtin_amdgcn_sched_barrier(0);
        if (ks * MI + g < NG) { if (pf) glds_one(ks * MI + g, kt + 1, nbase); }
        if (ks * MI + g == NG) prefetch(kt + 3);
        __builtin_amdgcn_sched_barrier(0);
      }
    }
  }
  BARRIER();
}

#define EPI2_LOOP(MI_)                                                           \
  const int _lane = threadIdx.x & 63, _wid = threadIdx.x >> 6;                   \
  const int _wr = _wid >> 2, _wc = _wid & 3, _fr = _lane & 15, _fq = _lane >> 4; \
  _Pragma("unroll") for (int mi = 0; mi < (MI_); ++mi) _Pragma("unroll") for (int ni = 0; ni < 4; ++ni)
#define EPI2_ROW(m0, MI_) ((m0) + _wr * ((MI_) * 16) + mi * 16 + _fr)
#define EPI2_COL(n0) ((n0) + _wc * 64 + ni * 16 + _fq * 4)

#define EPI_LOOP(WM_, WN_)                                                       \
  const int _lane = threadIdx.x & 63, _wid = threadIdx.x >> 6;                   \
  const int _wr = _wid / (WN_), _wc = _wid % (WN_), _fr = _lane & 15, _fq = _lane >> 4; \
  _Pragma("unroll") for (int mi = 0; mi < 4; ++mi) _Pragma("unroll") for (int ni = 0; ni < 4; ++ni)
#define EPI_ROW(m0) ((m0) + _wr * 64 + mi * 16 + _fr)
#define EPI_COL(n0) ((n0) + _wc * 64 + ni * 16 + _fq * 4)

__device__ __forceinline__ void ada_item(const Params& p, int item, char* lds) {
  const int tid = threadIdx.x;
  const int layer = item / 48, n0 = (item % 48) * 64;
  float* sc = (float*)lds;
  float* red = sc + 3072;
  for (int i = tid; i < 3072; i += 512) {
    int cond = i >> 10, k = i & 1023;
    float v = cond == 0 ? p.c_ctx[k] : p.c[(cond - 1) * 1024 + k];
    sc[i] = fsilu(v);
  }
  __syncthreads();
  const int cq = tid & 15, kg = tid >> 4;
  float a[3][4];
#pragma unroll
  for (int c = 0; c < 3; ++c)
#pragma unroll
    for (int e = 0; e < 4; ++e) a[c][e] = 0.f;
  const float* w = p.ada_w + (size_t)layer * 1024 * 3072 + (size_t)(kg * 32) * 3072 + n0 + cq * 4;
#pragma unroll 8
  for (int k = 0; k < 32; ++k) {
    float4 wv = *(const float4*)(w + (size_t)k * 3072);
#pragma unroll
    for (int c = 0; c < 3; ++c) {
      float s = sc[c * 1024 + kg * 32 + k];
      a[c][0] += s * wv.x; a[c][1] += s * wv.y; a[c][2] += s * wv.z; a[c][3] += s * wv.w;
    }
  }
#pragma unroll
  for (int c = 0; c < 3; ++c)
#pragma unroll
    for (int e = 0; e < 4; ++e) red[(kg * 3 + c) * 64 + cq * 4 + e] = a[c][e];
  __syncthreads();
  if (tid < 192) {
    int cond = tid >> 6, nn = tid & 63;
    float sum = 0.f;
#pragma unroll 8
    for (int g = 0; g < 32; ++g) sum += red[(g * 3 + cond) * 64 + nn];
    sum += p.ada_b[layer * 3072 + n0 + nn];
    ((float*)(p.ws + OFF_MOD))[(layer * 3 + cond) * 3072 + n0 + nn] = sum;
  }
  __syncthreads();
}

template <int KR>
__device__ __forceinline__ void conv_tile(const float* src, int ld, int k0, int n0, u16* dst, int ldd, int drow0, char* lds, int blkKT = 0) {
  float* t = (float*)lds;
  const int tid = threadIdx.x;
  float4 v[KR / 32];
#pragma unroll
  for (int i = 0; i < KR / 32; ++i) {
    int kk = (tid >> 4) + i * 32, n4 = (tid & 15) * 4;
    v[i] = *(const float4*)(src + (size_t)(k0 + kk) * ld + n0 + n4);
  }
#pragma unroll
  for (int i = 0; i < KR / 32; ++i) {
    int kk = (tid >> 4) + i * 32, n4 = (tid & 15) * 4;
    t[kk * 65 + n4 + 0] = v[i].x; t[kk * 65 + n4 + 1] = v[i].y; t[kk * 65 + n4 + 2] = v[i].z; t[kk * 65 + n4 + 3] = v[i].w;
  }
  __syncthreads();
#pragma unroll
  for (int r = 0; r < KR / 64; ++r) {
    int i = tid >> 3, kc = (tid & 7) * 8 + r * 64;
    float tv[8];
#pragma unroll
    for (int q = 0; q < 8; ++q) tv[q] = t[(kc + q) * 65 + i];
    u16x8 o = pack8(tv);
    if (blkKT) {
      const int n = drow0 + i;
      *(u16x8*)(dst + ((size_t)((n >> 7) * blkKT + ((k0 + kc) >> 6)) * 128 + (n & 127)) * 64 + (kc & 63)) = o;
    } else {
      *(u16x8*)(dst + (size_t)(drow0 + i) * ldd + k0 + kc) = o;
    }
  }
  __syncthreads();
}

__device__ __forceinline__ void conv_item(const Params& p, int layer, int it, char* lds) {
  const int kind = layer % 3, j = layer / 3;
  if (kind == 0) {
    if (it < 256) {
      int kt = it >> 6, nt = it & 63;
      conv_tile<256>(p.s5_w_in + (size_t)j * 1024 * 4096, 4096, kt * 256, nt * 64, (u16*)(p.ws + W_WIN), 1024, nt * 64, lds, 16);
    } else if (it < 512) {
      int t = it - 256, kt = t >> 5, nt = t & 31;
      conv_tile<256>(p.s5_glu_w + (size_t)j * 2048 * 2048, 2048, kt * 256, nt * 64, (u16*)(p.ws + W_GLU), 2048, nt * 64, lds, 32);
    } else {
      int t = it - 512, kt = t >> 4, nt = t & 15;
      conv_tile<256>(p.s5_w_out + (size_t)j * 2048 * 1024, 1024, kt * 256, nt * 64, (u16*)(p.ws + W_WOUT), 2048, nt * 64, lds, 32);
    }
  } else if (kind == 1) {
    if (it < 256) {
      int kt = it >> 6, nt = it & 63;
      conv_tile<256>(p.pool_w_in + (size_t)j * 1024 * 4096, 4096, kt * 256, nt * 64, (u16*)(p.ws + W_WIN), 1024, nt * 64, lds, 16);
    } else if (it < 320) {
      int t = it - 256, g = t >> 4, r = t & 15, kt = r >> 3, nt = r & 7;
      conv_tile<256>(p.pool_w + ((size_t)j * 4 + g) * 512 * 512, 512, kt * 256, nt * 64, (u16*)(p.ws + W_POOLW), 512,
                g * 512 + nt * 64, lds, 8);
    } else {
      int t = it - 320, kt = t >> 4, nt = t & 15;
      conv_tile<256>(p.pool_w_out + (size_t)j * 2048 * 1024, 1024, kt * 256, nt * 64, (u16*)(p.ws + W_WOUT), 2048, nt * 64, lds, 32);
    }
  } else {
    if (it < 156) {
      int kt = it / 39, nt = it % 39;
      conv_tile<256>(p.mla_w_in + (size_t)j * 1024 * 2496, 2496, kt * 256, nt * 64, (u16*)(p.ws + W_WIN), 1024, nt * 64, lds, 16);
    } else if (it < 172) {
      int h = it - 156, nt = h * 3 + 2;
      conv_tile<256>(p.mla_wq_b + (size_t)j * 256 * 3072, 3072, 0, nt * 64, (u16*)(p.ws + W_WQ), 256, nt * 64, lds, 4);
    } else if (it < 204) {
      int q = it - 172, h = q >> 1, half = q & 1, nt = h * 4 + 2 + half;
      conv_tile<128>(p.mla_wkv_b + (size_t)j * 128 * 4096, 4096, 0, nt * 64, (u16*)(p.ws + W_WUV), 128,
                h * 128 + half * 64, lds, 2);
    } else {
      int t = it - 204, kt = t >> 4, nt = t & 15;
      conv_tile<256>(p.mla_w_out + (size_t)j * 2048 * 1024, 1024, kt * 256, nt * 64, (u16*)(p.ws + W_WOUT), 2048, nt * 64, lds, 32);
    }
  }
}
__device__ __forceinline__ int conv_count(int layer) {
  const int kind = layer % 3;
  return kind == 0 ? 640 : (kind == 1 ? 448 : 332);
}

__device__ __forceinline__ const float* x_row(const Params& p, int layer, int row) {
  if (layer == 0) return row < 8192 ? p.x_prompt + (size_t)row * 1024 : p.x_sample + (size_t)(row - 8192) * 1024;
  return p.out + (size_t)row * 1024;
}

__device__ __forceinline__ void norm_item(const Params& p, int layer, int item, char* lds) {
  const int tid = threadIdx.x, lane = tid & 63, wid = tid >> 6;
  float* ma = (float*)lds;
  float* mb = ma + 1024;
  const int row0 = item * 32;
  const int cond = cond_of_row(row0);
  const float* mod = (const float*)(p.ws + OFF_MOD) + (size_t)(layer * 3 + cond) * 3072;
  for (int i = tid; i < 1024; i += 512) {
    ma[i] = p.norm_g[layer * 1024 + i] * (1.f + mod[1024 + i]);
    mb[i] = mod[i];
  }
  __syncthreads();
  u16* h = (u16*)(p.ws + OFF_H);
#pragma unroll 1
  for (int i = 0; i < 4; ++i) {
    const int row = row0 + wid * 4 + i;
    const float* x = x_row(p, layer, row);
    float4 v[4];
    float ss = 0.f;
#pragma unroll
    for (int q = 0; q < 4; ++q) {
      v[q] = *(const float4*)(x + q * 256 + lane * 4);
      ss += v[q].x * v[q].x + v[q].y * v[q].y + v[q].z * v[q].z + v[q].w * v[q].w;
    }
    ss = wave_sum(ss);
    const float rstd = rsqrtf(ss * (1.f / 1024.f) + 1e-6f);
#pragma unroll
    for (int q = 0; q < 4; ++q) {
      const int c = q * 256 + lane * 4;
      float4 a = *(const float4*)(ma + c), b = *(const float4*)(mb + c);
      f32x4 ov = {v[q].x * rstd * a.x + b.x, v[q].y * rstd * a.y + b.y, v[q].z * rstd * a.z + b.z, v[q].w * rstd * a.w + b.w};
      u16x4 o = pack4(ov);
      *(u16x4*)(h + ((size_t)((row >> 8) * 16 + (c >> 6)) * 256 + (row & 255)) * 64 + (c & 63)) = o;
    }
  }
  __syncthreads();
}

__device__ __forceinline__ void derive_item(const Params& p, int j, int item, char* lds) {
  const int tid = threadIdx.x;
  const int g = item >> 2, qu = item & 3;
  float2* pw = (float2*)lds;
  float2* bb = pw + 2 * 17 * 64;
  float2* cc = bb + 2 * 64 * 16;
  float* kt = (float*)(cc + 2 * 16 * 64);
  for (int i = tid; i < 2 * 17 * 64; i += 512) {
    int pp = i & 63, k = (i >> 6) % 17, dir = i / (17 * 64);
    int li = ((j * 2 + dir) * 128 + g) * 64 + pp;
    float lr = p.s5_lam_re[li], lim = p.s5_lam_im[li];
    float st = __expf(p.s5_log_step[(j * 2 + dir) * 128 + g]);
    float mag = __expf((float)k * lr * st);
    float2 cs = cis_rev((double)k * (double)lim * (double)st * 0.15915494309189535);
    pw[i] = make_float2(mag * cs.x, mag * cs.y);
  }
  for (int i = tid; i < 2 * 16 * 64; i += 512) {
    int pp = i & 63, c = (i >> 6) & 15, dir = i >> 10;
    size_t ci = ((size_t)((j * 2 + dir) * 128 + g) * 16 + c) * 64 + pp;
    cc[i] = make_float2(p.s5_c_re[ci], p.s5_c_im[ci]);
  }
  __syncthreads();
  for (int i = tid; i < 2 * 64 * 16; i += 512) {
    int c = i & 15, pp = (i >> 4) & 63, dir = i >> 10;
    int li = ((j * 2 + dir) * 128 + g) * 64 + pp;
    float lr = p.s5_lam_re[li], lim = p.s5_lam_im[li];
    float2 lb = pw[(dir * 17 + 1) * 64 + pp];
    float nr = lb.x - 1.f, ni = lb.y;
    float den = 1.f / (lr * lr + lim * lim);
    float cr = (nr * lr + ni * lim) * den, ci = (ni * lr - nr * lim) * den;
    size_t bi = ((size_t)li) * 16 + c;
    float br = p.s5_b_re[bi], bim = p.s5_b_im[bi];
    bb[i] = make_float2(cr * br - ci * bim, cr * bim + ci * br);
  }
  __syncthreads();
  for (int o = tid; o < 2048; o += 512) {
    int c2 = o & 15, cq = (o >> 4) & 3, lag = (o >> 6) & 15, dir = o >> 10;
    int c = qu * 4 + cq;
    float acc = 0.f;
    for (int pp = 0; pp < 64; ++pp) {
      float2 C = cc[(dir * 16 + c) * 64 + pp], P = pw[(dir * 17 + lag) * 64 + pp], B = bb[(dir * 64 + pp) * 16 + c2];
      float cpx = C.x * P.x - C.y * P.y, cpy = C.x * P.y + C.y * P.x;
      acc += cpx * B.x - cpy * B.y;
    }
    kt[o] = acc;
  }
  __syncthreads();
  u16* wbig = (u16*)(p.ws + B_WBIG) + (size_t)g * 256 * 512;
  for (int q = tid; q < 64 * 64; q += 512) {
    int rowi = q >> 6, k0 = (q & 63) * 8;
    int t = rowi >> 2, cq = rowi & 3, c = qu * 4 + cq, o = t * 16 + c;
    float tv[8];
    if (k0 < 256) {
      int s = k0 >> 4, c20 = k0 & 15;
      float dsk = p.s5_d[j * 2048 + g * 16 + c];
#pragma unroll
      for (int e = 0; e < 8; ++e) {
        int c2 = c20 + e;
        float val = 0.f;
        if (s <= t) val += kt[((0 * 16 + (t - s)) * 4 + cq) * 16 + c2];
        if (s >= t) val += kt[((1 * 16 + (s - t)) * 4 + cq) * 16 + c2];
        if (s == t && c2 == c) val += dsk;
        tv[e] = val;
      }
    } else {
      int dir = k0 >= 384 ? 1 : 0;
      int kk = k0 - 256 - dir * 128;
      int ri = kk >> 6, p0 = kk & 63;
      int e_pow = dir == 0 ? t + 1 : 16 - t;
#pragma unroll
      for (int e = 0; e < 8; ++e) {
        int pp = p0 + e;
        float2 C = cc[(dir * 16 + c) * 64 + pp], P = pw[(dir * 17 + e_pow) * 64 + pp];
        tv[e] = ri == 0 ? (C.x * P.x - C.y * P.y) : -(C.x * P.y + C.y * P.x);
      }
    }
    *(u16x8*)(wbig + blkB(o, k0, 8)) = pack8(tv);
  }
  u16* wst = (u16*)(p.ws + B_WST) + (size_t)g * 256 * 256;
  for (int q = tid; q < 64 * 32; q += 512) {
    int rowi = q >> 5, k0 = (q & 31) * 8;
    int dir = rowi >> 5, ri = (rowi >> 4) & 1, pp = qu * 16 + (rowi & 15);
    int o = dir * 128 + ri * 64 + pp;
    int s = k0 >> 4, c20 = k0 & 15;
    int e_pow = dir == 0 ? 15 - s : s;
    float2 P = pw[(dir * 17 + e_pow) * 64 + pp];
    float tv[8];
#pragma unroll
    for (int e = 0; e < 8; ++e) {
      float2 B = bb[(dir * 64 + pp) * 16 + c20 + e];
      tv[e] = ri == 0 ? (P.x * B.x - P.y * B.y) : (P.x * B.y + P.y * B.x);
    }
    *(u16x8*)(wst + blkB(o, k0, 4)) = pack8(tv);
  }
  __syncthreads();
}

__device__ __forceinline__ void wqabs_item(const Params& p, int item, char* lds) {
  const int tid = threadIdx.x;
  const int h = item >> 3, l0 = (item & 7) * 16;
  float* bs = (float*)lds;
  {
    int li = tid >> 5, d4 = (tid & 31) * 4;
    *(float4*)(bs + li * 128 + d4) = *(const float4*)(p.mla_wkv_b + (size_t)(l0 + li) * 4096 + h * 256 + d4);
  }
  __syncthreads();
  const int r = tid & 255, lh = tid >> 8;
  float acc[8];
#pragma unroll
  for (int i = 0; i < 8; ++i) acc[i] = 0.f;
  const float* arow = p.mla_wq_b + (size_t)r * 3072 + h * 192;
  for (int d4 = 0; d4 < 32; ++d4) {
    float4 a = *(const float4*)(arow + d4 * 4);
#pragma unroll
    for (int i = 0; i < 8; ++i) {
      float4 b = *(const float4*)(bs + (lh * 8 + i) * 128 + d4 * 4);
      acc[i] += a.x * b.x + a.y * b.y + a.z * b.z + a.w * b.w;
    }
  }
  u16* wq = (u16*)(p.ws + W_WQ);
#pragma unroll
  for (int i = 0; i < 8; ++i) wq[blkB(h * 192 + l0 + lh * 8 + i, r, 4)] = f2bf(acc[i]);
  __syncthreads();
}

__device__ __forceinline__ void ph_prep(const Params& p, int layer, bool with_ada, bool with_norm, char* lds, int bid, int nb) {
  const int kind = layer % 3, j = layer / 3;
  const int n_special = kind == 0 ? 512 : (kind == 2 ? 128 : 0);
  const int n_ada = with_ada ? 192 : 0;
  const int n_conv = conv_count(layer);
  const int n_norm = with_norm ? 384 : 0;
  const int total = n_special + n_ada + n_conv + n_norm;
  for (int it = bid; it < total; it += nb) {
    int t = it;
    if (t < n_special) {
      if (kind == 0) derive_item(p, j, t, lds); else wqabs_item(p, t, lds);
      continue;
    }
    t -= n_special;
    if (t < n_ada) { ada_item(p, t, lds); continue; }
    t -= n_ada;
    if (t < n_norm) { norm_item(p, layer, t, lds); continue; }
    t -= n_norm;
    conv_item(p, layer, t, lds);
  }
}
__device__ __forceinline__ void ph_norm(const Params& p, int layer, char* lds, int bid, int nb) {
  for (int it = bid; it < 384; it += nb) norm_item(p, layer, it, lds);
}

__device__ __forceinline__ void tile_mn(int t, int MT, int NT, int& mt, int& nt) {
  int per = 8 * NT;
  int grp = t / per, r = t % per;
  int gm = MT - grp * 8; gm = gm > 8 ? 8 : gm;
  mt = grp * 8 + r % gm; nt = r / gm;
}

__device__ __forceinline__ void ph_inproj(const Params& p, char* lds, int bid, int nb) {
  const u16* h = (const u16*)(p.ws + OFF_H);
  const u16* w = (const u16*)(p.ws + W_WIN);
  u16* uz = (u16*)(p.ws + OFF_A);
  for (int l = (bid >> 3); l < 96; l += (nb >> 3)) {
    const int xi = (bid & 7) >> 2, xj = bid & 3;
    const int mt = xi * 24 + (l >> 2), nt = xj * 4 + (l & 3);
    const int m0 = mt * 256, n0 = nt * 256;
    f32x4 acc[8][4];
    gemm_loop2<8>(lds, 16,
        [&](int r, int k) { return h + blkA(m0 + r, k, 16); },
        [&](int r, int k) { return w + blkB(n0 + r, k, 16); }, acc, 256 * 64, 128 * 64);
    EPI2_LOOP(8) {
      const int row = EPI2_ROW(m0, 8), col = EPI2_COL(n0);
      f32x4 v = acc[mi][ni];
      if (col >= 2048) {
        v[0] = fsilu(v[0]); v[1] = fsilu(v[1]); v[2] = fsilu(v[2]); v[3] = fsilu(v[3]);
        *(u16x4*)(uz + (size_t)NT_TOK * 2048 + (size_t)row * 2048 + (col - 2048)) = pack4(v);
      } else {
        *(u16x4*)(uz + ugaddr(row, col)) = pack4(v);
      }
    }
  }
}

__device__ __forceinline__ void ph_s5g1scan(const Params& p, int j, char* lds, int bid, int nb) {
  const int tid = threadIdx.x;
  const u16* uz = (const u16*)(p.ws + OFF_A);
  u16* X = (u16*)(p.ws + OFF_C);
  float* S = (float*)lds;
  for (int t = bid; t < 768; t += nb) {
    const int g = t / 6, mt = t % 6;
    const int m0 = mt * 128;
    const u16* w = (const u16*)(p.ws + B_WST) + (size_t)g * 65536;
    f32x4 acc[4][4];
    gemm_loop2<4>(lds, 4,
        [&](int r, int k) { return uz + ((size_t)(g * 768 + m0 + r)) * 256 + k; },
        [&](int r, int k) { return w + blkB(r, k, 4); }, acc, 64, 128 * 64);
    WAIT_VM(0);
    BARRIER();
    {
      EPI2_LOOP(4) {
        const int row = EPI2_ROW(0, 4), col = EPI2_COL(0);
        *(f32x4*)(S + row * 260 + col) = acc[mi][ni];
      }
    }
    __syncthreads();
    const bool sample = mt >= 4;
    const int ntask = sample ? 128 : 1024;
    for (int task = tid; task < ntask; task += 512) {
      const int seq = sample ? 0 : (task >> 7), dir = (task >> 6) & 1, pp = task & 63;
      const int nc = sample ? 128 : 16, rl0 = seq * 16;
      const int li = ((j * 2 + dir) * 128 + g) * 64 + pp;
      const float lr = p.s5_lam_re[li], lim = p.s5_lam_im[li];
      const float st = __expf(p.s5_log_step[(j * 2 + dir) * 128 + g]);
      const float mag = __expf(16.f * lr * st);
      const float2 cs = cis_rev(16.0 * (double)lim * (double)st * 0.15915494309189535);
      const float ar = mag * cs.x, ai = mag * cs.y;
      float pr = 0.f, pi = 0.f;
      const int b = sample ? (mt - 4) : (mt * 8 + seq);
      if (sample) {
        size_t si = ((size_t)((b * 2 + j) * 2 + dir) * 128 + g) * 64 + pp;
        pr = p.st_re[si]; pi = p.st_im[si];
      }
      const int col = dir * 128 + pp;
      u16* xb = X + xaddr(m0 + rl0, g, col);
      const float* sb = S + rl0 * 260 + col;
      if (dir == 0) {
#pragma unroll 4
        for (int c = 0; c < nc; ++c) {
          const float sr = sb[c * 260], si = sb[c * 260 + 64];
          xb[c * 64] = f2bf(pr); xb[c * 64 + 8192] = f2bf(pi);
          const float nr = ar * pr - ai * pi + sr, ni = ar * pi + ai * pr + si;
          pr = nr; pi = ni;
        }
      } else {
#pragma unroll 4
        for (int c = nc - 1; c >= 0; --c) {
          const float sr = sb[c * 260], si = sb[c * 260 + 64];
          xb[c * 64] = f2bf(pr); xb[c * 64 + 8192] = f2bf(pi);
          const float nr = ar * pr - ai * pi + sr, ni = ar * pi + ai * pr + si;
          pr = nr; pi = ni;
        }
      }
      if (!sample) {
        size_t oi = ((size_t)((b * 2 + j) * 2 + dir) * 128 + g) * 64 + pp;
        p.out[OUT_RE + oi] = pr;
        p.out[OUT_IM + oi] = pi;
      }
    }
    __syncthreads();
  }
}

__device__ __forceinline__ void ph_s5g3(const Params& p, char* lds, int bid, int nb) {
  u16* uz = (u16*)(p.ws + OFF_A);
  const u16* X = (const u16*)(p.ws + OFF_C);
  for (int t = bid; t < 768; t += nb) {
    const int g = t / 6, mt = t % 6;
    const int m0 = mt * 128;
    const u16* w = (const u16*)(p.ws + B_WBIG) + (size_t)g * 131072;
    f32x4 acc[4][4];
    gemm_loop2<4, true>(lds, 8,
        [&](int r, int k) { return (const u16*)(uz + ((size_t)(g * 768 + m0 + r)) * 256 + k); },
        [&](int r, int k) { return w + blkB(r, k, 8); }, acc, 64, 128 * 64,
        [&](int r, int k) { return X + xaddr(m0 + r, g, k); }, 128 * 64, 4);
    EPI2_LOOP(4) {
      const int row = EPI2_ROW(m0, 4), col = EPI2_COL(0);
      f32x4 v = acc[mi][ni];
      v[0] = fgelu(v[0]); v[1] = fgelu(v[1]); v[2] = fgelu(v[2]); v[3] = fgelu(v[3]);
      *(u16x4*)(uz + ((size_t)(g * 768 + row)) * 256 + col) = pack4(v);
    }
  }
}

__device__ __forceinline__ void ph_glu(const Params& p, int j, char* lds, int bid, int nb) {
  const u16* uz = (const u16*)(p.ws + OFF_A);
  const u16* w = (const u16*)(p.ws + W_GLU);
  u16* m = (u16*)(p.ws + OFF_C);
  for (int l = (bid >> 3); l < 64; l += (nb >> 3)) {
    const int xi = (bid & 7) >> 2, xj = bid & 3;
    const int mt = xi * 32 + (l >> 1), nt = xj * 2 + (l & 1);
    const int m0 = mt * 192, n0 = nt * 256;
    f32x4 acc[6][4];
    gemm_loop2<6>(lds, 32,
        [&](int r, int k) { return uz + ugaddr(m0 + r, k); },
        [&](int r, int k) { return w + blkB(n0 + r, k, 32); }, acc, 4 * 768 * 256, 128 * 64);
    EPI2_LOOP(6) {
      const int row = EPI2_ROW(m0, 6), col = EPI2_COL(n0);
      f32x4 v = acc[mi][ni];
      float4 gb = *(const float4*)(p.s5_glu_b + j * 2048 + col);
      u16x4 yv = *(const u16x4*)(uz + ugaddr(row, col));
      u16x4 zv = *(const u16x4*)(uz + (size_t)NT_TOK * 2048 + (size_t)row * 2048 + col);
      f32x4 o;
      o[0] = bf2f(yv[0]) * fsigmoid(v[0] + gb.x) * bf2f(zv[0]);
      o[1] = bf2f(yv[1]) * fsigmoid(v[1] + gb.y) * bf2f(zv[1]);
      o[2] = bf2f(yv[2]) * fsigmoid(v[2] + gb.z) * bf2f(zv[2]);
      o[3] = bf2f(yv[3]) * fsigmoid(v[3] + gb.w) * bf2f(zv[3]);
      *(u16x4*)(m + blkA(row, col, 32)) = pack4(o);
    }
  }
}

__device__ __forceinline__ void ph_out(const Params& p, int layer, const u16* m, char* lds, int bid, int nb) {
  const u16* w = (const u16*)(p.ws + W_WOUT);
  const float* mod = (const float*)(p.ws + OFF_MOD);
  for (int t = bid; t < 256; t += nb) {
    const int mt = (t & 7) * 8 + (t >> 5), nt = (t >> 3) & 3;
    const int m0 = mt * 192, n0 = nt * 256;
    f32x4 acc[6][4];
    gemm_loop2<6>(lds, 32,
        [&](int r, int k) { return m + blkA(m0 + r, k, 32); },
        [&](int r, int k) { return w + blkB(n0 + r, k, 32); }, acc, 256 * 64, 128 * 64);
    const int lane = threadIdx.x & 63, wid = threadIdx.x >> 6;
    const int wr = wid >> 2, wc = wid & 3, fr = lane & 15, fq = lane >> 4;
#pragma unroll
    for (int mi = 0; mi < 6; ++mi) {
      const int row = m0 + wr * 96 + mi * 16 + fr;
      const float* gate = mod + (size_t)(layer * 3 + cond_of_row(row)) * 3072 + 2048;
      const float* xo_p = x_row(p, layer, row);
#pragma unroll
      for (int ni = 0; ni < 4; ++ni) {
        const int col = n0 + wc * 64 + ni * 16 + fq * 4;
        f32x4 v = acc[mi][ni];
        float4 gt = *(const float4*)(gate + col);
        float4 xo = *(const float4*)(xo_p + col);
        float4 o;
        o.x = xo.x + gt.x * v[0]; o.y = xo.y + gt.y * v[1]; o.z = xo.z + gt.z * v[2]; o.w = xo.w + gt.w * v[3];
        *(float4*)(p.out + (size_t)row * 1024 + col) = o;
      }
    }
  }
}

template <int WIN>
__device__ __forceinline__ void pool_unit(const u16* uz, u16* pb, int g, int tok, int half) {
  int t, L, base;
  if (tok < 8192) { L = 256; t = tok & 255; base = tok - t; }
  else { L = 2048; t = (tok - 8192) & 2047; base = tok - t; }
  constexpr int lo = WIN / 2;
  const int ch0 = g * 16 + half * 8;
  float acc[8];
#pragma unroll
  for (int e = 0; e < 8; ++e) acc[e] = 0.f;
  u16x8 self;
#pragma unroll
  for (int i = 0; i < WIN; ++i) {
    const int sp = t - lo + i;
    const bool valid = sp >= 0 && sp < L;
    const int sc = sp < 0 ? 0 : (sp >= L ? L - 1 : sp);
    u16x8 v = *(const u16x8*)(uz + ugaddr(base + sc, ch0));
    if (i == lo) self = v;
    const float wgt = valid ? 1.f : 0.f;
#pragma unroll
    for (int e = 0; e < 8; ++e) acc[e] += wgt * bf2f(v[e]);
  }
  int s0 = t - lo; if (s0 < 0) s0 = 0;
  int s1 = t - lo + WIN; if (s1 > L) s1 = L;
  const float inv = 1.f / (float)(s1 - s0);
  u16x8 o;
#pragma unroll
  for (int e = 0; e < 8; ++e) o[e] = f2bf(acc[e] * inv - bf2f(self[e]));
  *(u16x8*)(pb + blkA(tok, ch0, 32)) = o;
}
__device__ __forceinline__ void ph_pool(const Params& p, int bid, int nb) {
  const u16* uz = (const u16*)(p.ws + OFF_A);
  u16* pb = (u16*)(p.ws + OFF_B);
  const int lane = threadIdx.x & 63, wid = threadIdx.x >> 6;
  for (int u = bid * 8 + wid; u < 128 * 384; u += nb * 8) {
    const int g = u / 384, run = u % 384;
    const int tok = run * 32 + (lane >> 1), half = lane & 1;
    const int gi = g >> 5;
    if (gi == 0) pool_unit<2>(uz, pb, g, tok, half);
    else if (gi == 1) pool_unit<4>(uz, pb, g, tok, half);
    else if (gi == 2) pool_unit<8>(uz, pb, g, tok, half);
    else pool_unit<16>(uz, pb, g, tok, half);
  }
}

__device__ __forceinline__ void ph_poolmm(const Params& p, int j, char* lds, int bid, int nb) {
  const u16* pb = (const u16*)(p.ws + OFF_B);
  const u16* w = (const u16*)(p.ws + W_POOLW);
  const u16* uz = (const u16*)(p.ws + OFF_A);
  u16* m = (u16*)(p.ws + OFF_C);
  for (int l = (bid >> 3); l < 48 * 2; l += (nb >> 3)) {
    const int mt = l / 2, nt = (bid & 7) * 2 + l % 2;
    const int m0 = mt * 256, n0 = nt * 128, gi = n0 >> 9;
    f32x4 acc[4][4];
    gemm_loop<4, 2, true, true>(lds, 8,
        [&](int r, int k) { return pb + ((size_t)(mt * 32 + gi * 8) * 256 + r) * 64 + k; },
        [&](int r, int k) { return w + ((size_t)(nt * 8) * 128 + r) * 64 + k; }, acc, 256 * 64, 128 * 64);
    EPI_LOOP(4, 2) {
      const int row = EPI_ROW(m0), col = EPI_COL(n0);
      f32x4 v = acc[mi][ni];
      float4 sc = *(const float4*)(p.pool_scale + j * 2048 + col);
      u16x4 zv = *(const u16x4*)(uz + (size_t)NT_TOK * 2048 + (size_t)row * 2048 + col);
      f32x4 o;
      o[0] = v[0] * sc.x * bf2f(zv[0]); o[1] = v[1] * sc.y * bf2f(zv[1]);
      o[2] = v[2] * sc.z * bf2f(zv[2]); o[3] = v[3] * sc.w * bf2f(zv[3]);
      *(u16x4*)(m + blkA(row, col, 32)) = pack4(o);
    }
  }
}

__device__ __forceinline__ void ph_inproj_mla(const Params& p, char* lds, int bid, int nb) {
  const u16* h = (const u16*)(p.ws + OFF_H);
  const u16* w = (const u16*)(p.ws + W_WIN);
  float* qa = (float*)(p.ws + A_QA);
  float* ckvf = (float*)(p.ws + A_CKVF);
  float* kpef = (float*)(p.ws + A_KPEF);
  u16* zb = (u16*)(p.ws + OFF_B);
  for (int t = bid; t < 480; t += nb) {
    const int x = t & 7, l = t >> 3;
    const int mt = x * 6 + l / 10, nt = l % 10;
    const int m0 = mt * 256, n0 = nt * 256;
    f32x4 acc[8][4];
    gemm_loop2<8>(lds, 16,
        [&](int r, int k) { return h + blkA(m0 + r, k, 16); },
        [&](int r, int k) { int n = n0 + r; n = n > 2495 ? 2495 : n; return w + blkB(n, k, 16); }, acc, 256 * 64, 128 * 64);
    EPI2_LOOP(8) {
      const int row = EPI2_ROW(m0, 8), col = EPI2_COL(n0);
      f32x4 v = acc[mi][ni];
      if (col < 256) {
        *(f32x4*)(qa + (size_t)row * 256 + col) = v;
      } else if (col < 384) {
        *(f32x4*)(ckvf + (size_t)row * 128 + (col - 256)) = v;
      } else if (col < 448) {
        *(f32x4*)(kpef + (size_t)row * 64 + (col - 384)) = v;
      } else if (col < 2496) {
        v[0] = fsilu(v[0]); v[1] = fsilu(v[1]); v[2] = fsilu(v[2]); v[3] = fsilu(v[3]);
        *(u16x4*)(zb + (size_t)row * 2048 + (col - 448)) = pack4(v);
      }
    }
  }
}

__device__ __forceinline__ int vt_slot(int pos) {
  int k = pos & 31;
  return (pos & ~31) | (((k >> 2) & 3) * 8 + (k >> 4) * 4 + (k & 3));
}

__device__ __forceinline__ void ph_mlanorm(const Params& p, int j, char* lds, int bid, int nb) {
  const int tid = threadIdx.x, lane = tid & 63, wid = tid >> 6;
  const float* qa = (const float*)(p.ws + A_QA);
  const float* ckvf = (const float*)(p.ws + A_CKVF);
  const float* kpef = (const float*)(p.ws + A_KPEF);
  u16* qan = (u16*)(p.ws + OFF_QAN);
  u16* Kb = (u16*)(p.ws + OFF_KB);
  u16* VT = (u16*)(p.ws + OFF_VT);
  u16* tile = (u16*)lds;
  for (int it = bid; it < 208; it += nb) {
    const bool cache = it >= 192;
    int kvrow0, pos0, Lk; size_t vtbase;
    int tok0 = 0, cb = 0, ci0 = 0;
    bool sample = false;
    if (!cache) {
      tok0 = it * 64;
      if (tok0 < 8192) { int b = tok0 >> 8; pos0 = tok0 & 255; kvrow0 = tok0; Lk = 256; vtbase = (size_t)b * 128 * 256; }
      else { sample = true; int b = (tok0 - 8192) >> 11; int t0 = (tok0 - 8192) & 2047; pos0 = 512 + t0;
             kvrow0 = 8192 + b * 2560 + pos0; Lk = 2560; vtbase = (size_t)32 * 128 * 256 + (size_t)b * 128 * 2560; }
    } else {
      int q = it - 192; cb = q >> 3; ci0 = (q & 7) * 64; pos0 = ci0;
      kvrow0 = 8192 + cb * 2560 + pos0; Lk = 2560; vtbase = (size_t)32 * 128 * 256 + (size_t)cb * 128 * 2560;
    }
#pragma unroll 1
    for (int i = 0; i < 8; ++i) {
      const int rl = wid * 8 + i;
      float c0, c1, kp;
      if (!cache) {
        const int tok = tok0 + rl;
        float4 qv = *(const float4*)(qa + (size_t)tok * 256 + lane * 4);
        float ss = wave_sum(qv.x * qv.x + qv.y * qv.y + qv.z * qv.z + qv.w * qv.w);
        float rs = rsqrtf(ss * (1.f / 256.f) + 1e-6f);
        float4 qg = *(const float4*)(p.mla_q_norm + j * 256 + lane * 4);
        u16x4 qo;
        qo[0] = f2bf(qv.x * rs * qg.x); qo[1] = f2bf(qv.y * rs * qg.y);
        qo[2] = f2bf(qv.z * rs * qg.z); qo[3] = f2bf(qv.w * rs * qg.w);
        *(u16x4*)(qan + blkA(tok, lane * 4, 4)) = qo;
        float2 cv = *(const float2*)(ckvf + (size_t)tok * 128 + lane * 2);
        float s2 = wave_sum(cv.x * cv.x + cv.y * cv.y);
        float r2 = rsqrtf(s2 * (1.f / 128.f) + 1e-6f);
        float2 kg = *(const float2*)(p.mla_kv_norm + j * 128 + lane * 2);
        c0 = cv.x * r2 * kg.x; c1 = cv.y * r2 * kg.y;
        float x = kpef[(size_t)tok * 64 + lane];
        if (!sample) {
          *(float2*)(p.out + OUT_CKV + (size_t)tok * 128 + lane * 2) = make_float2(c0, c1);
          p.out[OUT_KPE + (size_t)tok * 64 + lane] = x;
          kp = x;
        } else {
          const int tpos = (tok - 8192) & 2047;
          const int axis = lane >> 5, within = lane & 31, fi = within & 15, isx2 = within >> 4;
          float xp = __shfl_xor(x, 16);
          float posf = (float)(axis == 0 ? (tpos >> 6) : (tpos & 63));
          float inv = __builtin_amdgcn_exp2f(-(float)fi * 0.830482023721841f);
          float rev = posf * inv * 0.15915494309189535f;
          rev -= rintf(rev);
          float cs = __builtin_amdgcn_cosf(rev), sn = __builtin_amdgcn_sinf(rev);
          float x1 = isx2 ? xp : x, x2 = isx2 ? x : xp;
          kp = isx2 ? (x1 * sn + x2 * cs) : (x1 * cs - x2 * sn);
        }
      } else {
        const size_t ci = (size_t)(cb * 1 + j) * 512 + ci0 + rl;
        float2 cv = *(const float2*)(p.cache_ckv + ci * 128 + lane * 2);
        c0 = cv.x; c1 = cv.y;
        kp = p.cache_kpe[ci * 64 + lane];
      }
      const size_t kr = (size_t)(kvrow0 + rl);
      unsigned pk = (unsigned)f2bf(c0) | ((unsigned)f2bf(c1) << 16);
      *(unsigned*)(Kb + kr * 192 + lane * 2) = pk;
      Kb[kr * 192 + 128 + lane] = f2bf(kp);
      *(unsigned*)(tile + rl * 136 + lane * 2) = pk;
    }
    __syncthreads();
    {
      const int d = tid >> 2, part = tid & 3;
      u16x8 o0, o1;
#pragma unroll
      for (int e = 0; e < 16; ++e) {
        int s = part * 16 + e;
        int blk = s >> 5, sl = s & 31;
        int kgq = sl >> 3, sub = (sl >> 2) & 1, jj = sl & 3;
        int kap = sub * 16 + kgq * 4 + jj;
        u16 v = tile[(blk * 32 + kap) * 136 + d];
        if (e < 8) o0[e] = v; else o1[e - 8] = v;
      }
      u16* dst = VT + vtbase + ((size_t)(pos0 >> 6) * 128 + d) * 64 + part * 16;
      *(u16x8*)(dst) = o0;
      *(u16x8*)(dst + 8) = o1;
    }
    __syncthreads();
  }
}

__device__ __forceinline__ void ph_qgemm(const Params& p, char* lds, int bid, int nb) {
  const u16* qan = (const u16*)(p.ws + OFF_QAN);
  const u16* w = (const u16*)(p.ws + W_WQ);
  u16* q = (u16*)(p.ws + OFF_A);
  const float SC = 0.07216878364870322f * 1.4426950408889634f;
  for (int l = (bid >> 3); l < 48 * 3; l += (nb >> 3)) {
    const int mt = l / 3, nt = (bid & 7) * 3 + l % 3;
    const int m0 = mt * 256, n0 = nt * 128;
    f32x4 acc[4][4];
    gemm_loop<4, 2, true, true>(lds, 4,
        [&](int r, int k) { return qan + ((size_t)(mt * 4) * 256 + r) * 64 + k; },
        [&](int r, int k) { return w + ((size_t)(nt * 4) * 128 + r) * 64 + k; }, acc, 256 * 64, 128 * 64);
    const int lane = threadIdx.x & 63, wid = threadIdx.x >> 6;
    const int wr = wid >> 1, wc = wid & 1, fr = lane & 15, fq = lane >> 4;
    const int cb = n0 + wc * 64;
    const bool rope = (m0 >= 8192) && ((cb % 192) == 128);
#pragma unroll
    for (int mi = 0; mi < 4; ++mi) {
      const int row = m0 + wr * 64 + mi * 16 + fr;
      f32x4 v[4];
#pragma unroll
      for (int ni = 0; ni < 4; ++ni) v[ni] = acc[mi][ni];
      if (rope) {
        const int tpos = (row - 8192) & 2047;
#pragma unroll
        for (int ax = 0; ax < 2; ++ax) {
          const float posf = (float)(ax == 0 ? (tpos >> 6) : (tpos & 63));
#pragma unroll
          for (int jj = 0; jj < 4; ++jj) {
            const int fi = fq * 4 + jj;
            float inv = __builtin_amdgcn_exp2f(-(float)fi * 0.830482023721841f);
            float rev = posf * inv * 0.15915494309189535f;
            rev -= rintf(rev);
            float cs = __builtin_amdgcn_cosf(rev), sn = __builtin_amdgcn_sinf(rev);
            float x1 = v[ax * 2][jj], x2 = v[ax * 2 + 1][jj];
            v[ax * 2][jj] = x1 * cs - x2 * sn;
            v[ax * 2 + 1][jj] = x1 * sn + x2 * cs;
          }
        }
      }
#pragma unroll
      for (int ni = 0; ni < 4; ++ni) {
        f32x4 o = v[ni];
        o[0] *= SC; o[1] *= SC; o[2] *= SC; o[3] *= SC;
        *(u16x4*)(q + (size_t)row * 3072 + cb + ni * 16 + fq * 4) = pack4(o);
      }
    }
  }
}

__device__ __forceinline__ void ph_attn(const Params& p, char* lds, int bid, int nb) {
  const int tid = threadIdx.x, lane = tid & 63, wid = tid >> 6, fr = lane & 15, fq = lane >> 4;
  const u16* q = (const u16*)(p.ws + OFF_A);
  const u16* Kb = (const u16*)(p.ws + OFF_KB);
  const u16* VT = (const u16*)(p.ws + OFF_VT);
  u16* ol = (u16*)(p.ws + OFF_C);
  for (int it = bid; it < 768; it += nb) {
    int h, tokq0, kvbase, Lk; size_t vtbase;
    if (it < 256) { int b = it >> 7, qt = (it >> 4) & 7; h = it & 15; tokq0 = 8192 + b * 2048 + qt * 256;
                    kvbase = 8192 + b * 2560; Lk = 2560; vtbase = (size_t)32 * 128 * 256 + (size_t)b * 128 * 2560; }
    else { int r = it - 256; int b = r >> 4; h = r & 15; tokq0 = b * 256; kvbase = b * 256; Lk = 256;
           vtbase = (size_t)b * 128 * 256; }
    const int nkt = Lk >> 6;
    const u16* vt = VT + vtbase;
    bf16x8 qf[2][6];
#pragma unroll
    for (int qs = 0; qs < 2; ++qs)
#pragma unroll
      for (int ks = 0; ks < 6; ++ks)
        qf[qs][ks] = *(const bf16x8*)(q + (size_t)(tokq0 + wid * 32 + qs * 16 + fr) * 3072 + h * 192 + ks * 32 + fq * 8);
    f32x4 O[8][2];
#pragma unroll
    for (int d = 0; d < 8; ++d) { O[d][0] = f32x4{0, 0, 0, 0}; O[d][1] = f32x4{0, 0, 0, 0}; }
    float mrun[2] = {-1e30f, -1e30f}, lrun[2] = {0.f, 0.f};

    int koff[3], voff[2];
#pragma unroll
    for (int i = 0; i < 3; ++i) {
      int idx = tid + i * 512;
      int r = idx / 24, pos = idx - r * 24;
      int kc = (pos & ~7) | ((pos ^ r) & 7);
      koff[i] = r * 192 + kc * 8;
    }
#pragma unroll
    for (int i = 0; i < 2; ++i) {
      int idx = tid + i * 512;
      int d = idx >> 3, pos = idx & 7;
      voff[i] = d * 64 + ((pos ^ (d & 7)) * 8);
    }
    const u16* kbase = Kb + (size_t)kvbase * 192;
    auto glds_kv = [&](int i, int kt, int buf) {
      char* base = lds + buf * 40960 + tid * 16;
      if (i < 3) glds16(kbase + kt * (64 * 192) + koff[i], base + i * 8192);
      else glds16(vt + kt * (128 * 64) + voff[i - 3], base + 24576 + (i - 3) * 8192);
    };
#pragma unroll
    for (int i = 0; i < 5; ++i) glds_kv(i, 0, 0);
    for (int kt = 0; kt < nkt; ++kt) {
      const int cur = kt & 1;
      WAIT_VM(0);
      BARRIER();
      const bool pfn = kt + 1 < nkt;
      const char* kb = lds + cur * 40960;
      const char* vb = kb + 24576;
      f32x4 s[4][2];
#pragma unroll
      for (int sub = 0; sub < 4; ++sub) { s[sub][0] = f32x4{0, 0, 0, 0}; s[sub][1] = f32x4{0, 0, 0, 0}; }
      {
        auto kaddr = [&](int idx) {
          const int ks = idx >> 2, sub = idx & 3;
          const int coff = ((ks >> 1) * 8 + ((((ks & 1) * 4 + fq) ^ fr) & 7)) * 16;
          return (const bf16x8*)(kb + (sub * 16 + fr) * 384 + coff);
        };
        bf16x8 kf[3];
        kf[0] = *kaddr(0); kf[1] = *kaddr(1);
#pragma unroll
        for (int idx = 0; idx < 24; ++idx) {
          const int ks = idx >> 2, sub = idx & 3;
          if (idx + 2 < 24) kf[(idx + 2) % 3] = *kaddr(idx + 2);
          s[sub][0] = __builtin_amdgcn_mfma_f32_16x16x32_bf16(kf[idx % 3], qf[0][ks], s[sub][0], 0, 0, 0);
          s[sub][1] = __builtin_amdgcn_mfma_f32_16x16x32_bf16(kf[idx % 3], qf[1][ks], s[sub][1], 0, 0, 0);
          if (sub == 3 && ks < 5) { if (pfn) glds_kv(ks, kt + 1, cur ^ 1); }
          __builtin_amdgcn_sched_barrier(0);
        }
      }
      bf16x8 pf[2][2];
#pragma unroll
      for (int qs = 0; qs < 2; ++qs) {
        float mx = s[0][qs][0];
#pragma unroll
        for (int sub = 0; sub < 4; ++sub)
#pragma unroll
          for (int jj = 0; jj < 4; ++jj) mx = fmaxf(mx, s[sub][qs][jj]);
        mx = fmaxf(mx, __shfl_xor(mx, 16));
        mx = fmaxf(mx, __shfl_xor(mx, 32));
        const float mnew = fmaxf(mrun[qs], mx);
        const float alpha = __builtin_amdgcn_exp2f(mrun[qs] - mnew);
        mrun[qs] = mnew;
        float ps = 0.f;
#pragma unroll
        for (int sub = 0; sub < 4; ++sub)
#pragma unroll
          for (int jj = 0; jj < 4; ++jj) {
            float e = __builtin_amdgcn_exp2f(s[sub][qs][jj] - mnew);
            s[sub][qs][jj] = e;
            ps += e;
          }
        lrun[qs] = lrun[qs] * alpha + ps;
#pragma unroll
        for (int d = 0; d < 8; ++d) { O[d][qs][0] *= alpha; O[d][qs][1] *= alpha; O[d][qs][2] *= alpha; O[d][qs][3] *= alpha; }
#pragma unroll
        for (int kbk = 0; kbk < 2; ++kbk) {
          u32x4_t w = {pack2bf(s[kbk * 2][qs][0], s[kbk * 2][qs][1]), pack2bf(s[kbk * 2][qs][2], s[kbk * 2][qs][3]),
                       pack2bf(s[kbk * 2 + 1][qs][0], s[kbk * 2 + 1][qs][1]), pack2bf(s[kbk * 2 + 1][qs][2], s[kbk * 2 + 1][qs][3])};
          pf[kbk][qs] = __builtin_bit_cast(bf16x8, w);
        }
      }
      {
        auto vaddr = [&](int idx) {
          const int d = idx >> 1, kbk = idx & 1;
          return (const bf16x8*)(vb + (d * 16 + fr) * 128 + (((kbk * 4 + fq) ^ (fr & 7)) << 4));
        };
        bf16x8 vf[3];
        vf[0] = *vaddr(0); vf[1] = *vaddr(1);
#pragma unroll
        for (int idx = 0; idx < 16; ++idx) {
          const int d = idx >> 1, kbk = idx & 1;
          if (idx + 2 < 16) vf[(idx + 2) % 3] = *vaddr(idx + 2);
          O[d][0] = __builtin_amdgcn_mfma_f32_16x16x32_bf16(vf[idx % 3], pf[kbk][0], O[d][0], 0, 0, 0);
          O[d][1] = __builtin_amdgcn_mfma_f32_16x16x32_bf16(vf[idx % 3], pf[kbk][1], O[d][1], 0, 0, 0);
          __builtin_amdgcn_sched_barrier(0);
        }
      }
    }
    BARRIER();
#pragma unroll
    for (int qs = 0; qs < 2; ++qs) {
      float l = lrun[qs];
      l += __shfl_xor(l, 16);
      l += __shfl_xor(l, 32);
      const float il = 1.f / l;
      const int tok = tokq0 + wid * 32 + qs * 16 + fr;
#pragma unroll
      for (int d = 0; d < 8; ++d) {
        f32x4 o = O[d][qs];
        o[0] *= il; o[1] *= il; o[2] *= il; o[3] *= il;
        *(u16x4*)(ol + blkA(tok, h * 128 + d * 16 + fq * 4, 32)) = pack4(o);
      }
    }
  }
}

__device__ __forceinline__ void ph_oexp(const Params& p, char* lds, int bid, int nb) {
  const u16* ol = (const u16*)(p.ws + OFF_C);
  const u16* w = (const u16*)(p.ws + W_WUV);
  const u16* zb = (const u16*)(p.ws + OFF_B);
  u16* mo = (u16*)(p.ws + OFF_A);
  for (int l = (bid >> 3); l < 48 * 2; l += (nb >> 3)) {
    const int mt = l / 2, nt = (bid & 7) * 2 + l % 2;
    const int m0 = mt * 256, n0 = nt * 128;
    f32x4 acc[4][4];
    gemm_loop<4, 2, true, true>(lds, 2,
        [&](int r, int k) { return ol + ((size_t)(mt * 32 + nt * 2) * 256 + r) * 64 + k; },
        [&](int r, int k) { return w + ((size_t)(nt * 2) * 128 + r) * 64 + k; }, acc, 256 * 64, 128 * 64);
    EPI_LOOP(4, 2) {
      const int row = EPI_ROW(m0), col = EPI_COL(n0);
      f32x4 v = acc[mi][ni];
      u16x4 zv = *(const u16x4*)(zb + (size_t)row * 2048 + col);
      v[0] *= bf2f(zv[0]); v[1] *= bf2f(zv[1]); v[2] *= bf2f(zv[2]); v[3] *= bf2f(zv[3]);
      *(u16x4*)(mo + blkA(row, col, 32)) = pack4(v);
    }
  }
}

__device__ __forceinline__ void ph_final(const Params& p, int bid, int nb) {
  const int lane = threadIdx.x & 63, wid = threadIdx.x >> 6;
  for (int row = bid * 8 + wid; row < NT_TOK; row += nb * 8) {
    float* x = p.out + (size_t)row * 1024;
    float4 v[4];
    float ss = 0.f;
#pragma unroll
    for (int q = 0; q < 4; ++q) {
      v[q] = *(const float4*)(x + q * 256 + lane * 4);
      ss += v[q].x * v[q].x + v[q].y * v[q].y + v[q].z * v[q].z + v[q].w * v[q].w;
    }
    ss = wave_sum(ss);
    const float rstd = rsqrtf(ss * (1.f / 1024.f) + 1e-6f);
#pragma unroll
    for (int q = 0; q < 4; ++q) {
      float4 g = *(const float4*)(p.final_g + q * 256 + lane * 4);
      float4 o;
      o.x = v[q].x * rstd * g.x; o.y = v[q].y * rstd * g.y; o.z = v[q].z * rstd * g.z; o.w = v[q].w * rstd * g.w;
      *(float4*)(x + q * 256 + lane * 4) = o;
    }
  }
}

#define XB_TMO      128
#define XB_XCNT(j)  (256  + 64 * (j))
#define XB_XSUB(j)  (1280 + 64 * (j))
#define XB_XGEN(j)  (2304 + 64 * (j))
#define XB_TOP      3328
#define XB_TOPGEN   3392
#define XCD_BAR_WORDS 3456
#define XB_SPIN_CAP (1u << 18)
#define LAS __attribute__((address_space(3)))

__device__ __forceinline__ unsigned xb_ld(unsigned* p)              { return __hip_atomic_load(p, __ATOMIC_RELAXED, __HIP_MEMORY_SCOPE_AGENT); }
__device__ __forceinline__ unsigned xb_add(unsigned* p, unsigned v) { return __hip_atomic_fetch_add(p, v, __ATOMIC_RELAXED, __HIP_MEMORY_SCOPE_AGENT); }
__device__ __forceinline__ unsigned xb_xcc_id() { return (unsigned)__builtin_amdgcn_s_getreg((3 << 11) | 20) & 0xFu; }
#define XB_SPIN(cond, bar) do { unsigned _sp = 0; while (cond) { __builtin_amdgcn_s_sleep(1); \
    if ((++_sp & 255u) == 0u) { if (xb_ld(&(bar)[XB_TMO])) break; if (_sp > XB_SPIN_CAP) { atomicAdd(&(bar)[XB_TMO], 1u); break; } } } } while (0)

struct XcdBarrier {
    unsigned* bar; unsigned x;
    volatile LAS unsigned* st;
};

__device__ __forceinline__ XcdBarrier xcd_barrier_post(unsigned* bar, volatile LAS unsigned* st) {
    XcdBarrier b; b.bar = bar; b.x = xb_xcc_id(); b.st = st;
    if (threadIdx.x == 0) (void)xb_add(&bar[XB_XCNT(b.x)], 1u);
    return b;
}
__device__ __forceinline__ void xcd_barrier_complete(unsigned* bar, unsigned x, unsigned& nloc, unsigned& nx) {
    const unsigned G = gridDim.x * gridDim.y * gridDim.z;
    unsigned sum, cnt, mine, sp = 0u;
    for (;;) {
        sum = 0u; cnt = 0u; mine = 0u;
#pragma unroll
        for (unsigned j = 0; j < 16; ++j) { const unsigned c = xb_ld(&bar[XB_XCNT(j)]); sum += c; cnt += (c > 0u) ? 1u : 0u; mine = (j == x) ? c : mine; }
        if (sum == G) break;
        __builtin_amdgcn_s_sleep(1);
        if ((++sp & 255u) == 0u) { if (xb_ld(&bar[XB_TMO])) break; if (sp > XB_SPIN_CAP) { atomicAdd(&bar[XB_TMO], 1u); break; } }
    }
    nloc = mine > 0u ? mine : 1u; nx = cnt > 0u ? cnt : 1u;
}

__device__ __forceinline__ void xcd_barrier(const XcdBarrier& b) {
    asm volatile("s_waitcnt vmcnt(0)" ::: "memory");
    __syncthreads();
    if (threadIdx.x == 0) {
        unsigned* bar = b.bar;
        __builtin_amdgcn_s_waitcnt(0);
        unsigned nloc = b.st[0], nx = b.st[1];
        if (nloc == 0u) { xcd_barrier_complete(bar, b.x, nloc, nx); b.st[0] = nloc; b.st[1] = nx; }
        const unsigned old = xb_add(&bar[XB_XSUB(b.x)], 1u);
        const unsigned gen = old / nloc;
        if (old + 1u == (gen + 1u) * nloc) {
            __builtin_amdgcn_fence(__ATOMIC_RELEASE, "agent");
            asm volatile("s_waitcnt vmcnt(0)" ::: "memory");
            const unsigned og = xb_add(&bar[XB_TOP], 1u);
            const unsigned tg = og / nx;
            if (og + 1u == (tg + 1u) * nx) xb_add(&bar[XB_TOPGEN], 1u);
            else XB_SPIN(xb_ld(&bar[XB_TOPGEN]) == tg, bar);
            __builtin_amdgcn_fence(__ATOMIC_ACQUIRE, "agent");
            xb_add(&bar[XB_XGEN(b.x)], 1u);
            asm volatile("s_waitcnt vmcnt(0)" ::: "memory");
        } else {
            XB_SPIN(xb_ld(&bar[XB_XGEN(b.x)]) == gen, bar);
            __builtin_amdgcn_fence(__ATOMIC_ACQUIRE, "agent");
            asm volatile("s_waitcnt vmcnt(0)" ::: "memory");
        }
    }
    __syncthreads();
}


#define N_PHASES 26
template <int ph>
__device__ __forceinline__ void run_phase(const Params& p, char* lds, int bid, int nb) {
  switch (ph) {
    case 0: ph_prep(p, 0, true, false, lds, bid, nb); break;
    case 1: ph_norm(p, 0, lds, bid, nb); break;
    case 2: ph_inproj(p, lds, bid, nb); break;
    case 3: ph_s5g1scan(p, 0, lds, bid, nb); break;
    case 4: ph_s5g3(p, lds, bid, nb); break;
    case 5: ph_glu(p, 0, lds, bid, nb); break;
    case 6: ph_out(p, 0, (const u16*)(p.ws + OFF_C), lds, bid, nb); break;
    case 7: ph_prep(p, 1, false, true, lds, bid, nb); break;
    case 8: ph_inproj(p, lds, bid, nb); break;
    case 9: ph_pool(p, bid, nb); break;
    case 10: ph_poolmm(p, 0, lds, bid, nb); break;
    case 11: ph_out(p, 1, (const u16*)(p.ws + OFF_C), lds, bid, nb); break;
    case 12: ph_prep(p, 2, false, true, lds, bid, nb); break;
    case 13: ph_inproj_mla(p, lds, bid, nb); break;
    case 14: ph_mlanorm(p, 0, lds, bid, nb); break;
    case 15: ph_qgemm(p, lds, bid, nb); break;
    case 16: ph_attn(p, lds, bid, nb); break;
    case 17: ph_oexp(p, lds, bid, nb); break;
    case 18: ph_out(p, 2, (const u16*)(p.ws + OFF_A), lds, bid, nb); break;
    case 19: ph_prep(p, 3, false, true, lds, bid, nb); break;
    case 20: ph_inproj(p, lds, bid, nb); break;
    case 21: ph_s5g1scan(p, 1, lds, bid, nb); break;
    case 22: ph_s5g3(p, lds, bid, nb); break;
    case 23: ph_glu(p, 1, lds, bid, nb); break;
    case 24: ph_out(p, 3, (const u16*)(p.ws + OFF_C), lds, bid, nb); break;
    case 25: ph_final(p, bid, nb); break;
    default: break;
  }
}

template <int PH>
__device__ __forceinline__ void run_all(const Params& p, char* lds, cg::grid_group& grid, const XcdBarrier& xb, int bid, int nb) {
  if constexpr (PH < N_PHASES) {
    run_phase<PH>(p, lds, bid, nb);
#ifdef DUP_PHASE
    if constexpr (PH == DUP_PHASE) { xcd_barrier(xb); run_phase<PH>(p, lds, bid, nb); }
#endif
    if constexpr (PH + 1 < N_PHASES) {
      if constexpr (PH == 0) grid.sync(); else xcd_barrier(xb);
      run_all<PH + 1>(p, lds, grid, xb, bid, nb);
    }
  }
}

#if MK_SINGLE
__global__ void __launch_bounds__(512) k_mega(Params p) {
  __shared__ __attribute__((aligned(16))) char lds[LDS_BYTES];
  __shared__ uint4 xb_words;
  __shared__ int s_vbid;
  cg::grid_group grid = cg::this_grid();
  unsigned* bar = (unsigned*)(p.ws + OFF_BAR);
  if (threadIdx.x == 0) {
    xb_words = make_uint4(0u, 0u, 0u, 0u);
    const unsigned x = xb_xcc_id() & 7u;
    const unsigned j = atomicAdd(&bar[XCD_BAR_WORDS + 64 * x], 1u);
    s_vbid = (int)(j * 8u + x);
  }
  __syncthreads();
  XcdBarrier xb = xcd_barrier_post(bar, (volatile LAS unsigned*)&xb_words);
  const int nb = gridDim.x;
  run_phase<0>(p, lds, blockIdx.x, nb);
  xcd_barrier(xb);
  int vb = s_vbid;
  {
    bool ok = (nb & 7) == 0;
#pragma unroll
    for (int x = 0; x < 8; ++x) ok = ok && (xb_ld(&bar[XCD_BAR_WORDS + 64 * x]) == (unsigned)(nb >> 3));
    if (!ok) vb = blockIdx.x;
  }
  run_all<1>(p, lds, grid, xb, vb, nb);
}
#else
template <int PH>
__global__ void __launch_bounds__(512) __attribute__((amdgpu_waves_per_eu(2, 2))) k_phase(Params p) {
  __shared__ __attribute__((aligned(16))) char lds[LDS_BYTES];
  run_phase<PH>(p, lds, blockIdx.x, gridDim.x);
}
template <int PH>
static void launch_all(const Params& p, hipStream_t stream) {
  if constexpr (PH < N_PHASES) {
    k_phase<PH><<<256, 512, 0, stream>>>(p);
    launch_all<PH + 1>(p, stream);
  }
}
#endif

extern "C" void kernel_launch(void* const* d_in, const int* in_sizes, int n_in, void* d_out, int out_size,
                              void* d_ws, size_t ws_size, hipStream_t stream) {
  Params p{};
  const float** f = (const float**)&p;
  for (int i = 0; i < 34; ++i) f[i] = (const float*)d_in[i];
  p.out = (float*)d_out;
  p.ws = (char*)d_ws;
#if MK_SINGLE
  static int grid_blocks = 0;
  if (!grid_blocks) {
    int dev = 0, cus = 0, per_cu = 0;
    (void)hipGetDevice(&dev);
    (void)hipDeviceGetAttribute(&cus, hipDeviceAttributeMultiprocessorCount, dev);
    (void)hipOccupancyMaxActiveBlocksPerMultiprocessor(&per_cu, k_mega, 512, 0);
    if (per_cu > 1) per_cu = 1;
    grid_blocks = cus * per_cu;
    if (grid_blocks <= 0) grid_blocks = 256;
  }
  (void)hipMemsetAsync((char*)d_ws + OFF_BAR, 0, (XCD_BAR_WORDS + 8 * 64) * 4, stream);
  void* args[] = {&p};
  hipError_t e = hipLaunchCooperativeKernel((void*)k_mega, dim3(grid_blocks), dim3(512), args, 0, stream);
  if (e != hipSuccess) fprintf(stderr, "cooperative launch failed: %s (grid %d)\n", hipGetErrorString(e), grid_blocks);
#else
  launch_all<0>(p, stream);
#endif
}
```

```cpp
#include <hip/hip_runtime.h>
#include <hip/hip_cooperative_groups.h>
#include <cstdio>
namespace cg = cooperative_groups;

#ifndef MK_SINGLE
#define MK_SINGLE 1
#endif

typedef unsigned short u16;
using bf16x8 = __attribute__((ext_vector_type(8))) short;
using f32x4  = __attribute__((ext_vector_type(4))) float;
using u16x4  = __attribute__((ext_vector_type(4))) unsigned short;
using u16x8  = __attribute__((ext_vector_type(8))) unsigned short;

struct Params {
  const float *x_prompt, *x_sample, *st_re, *st_im, *cache_ckv, *cache_kpe, *c, *c_ctx;
  const float *norm_g, *ada_w, *ada_b, *final_g;
  const float *s5_w_in, *s5_lam_re, *s5_lam_im, *s5_log_step, *s5_b_re, *s5_b_im, *s5_c_re, *s5_c_im;
  const float *s5_d, *s5_glu_w, *s5_glu_b, *s5_w_out;
  const float *pool_w_in, *pool_w, *pool_scale, *pool_w_out;
  const float *mla_w_in, *mla_q_norm, *mla_wq_b, *mla_kv_norm, *mla_wkv_b, *mla_w_out;
  float* out;
  char* ws;
};

constexpr size_t MiB = 1ull << 20;
constexpr size_t OFF_W = 0, OFF_A = 20 * MiB, OFF_B = 116 * MiB, OFF_C = 164 * MiB, OFF_M = 212 * MiB,
                 OFF_H = 228 * MiB;
constexpr size_t OFF_BAR = OFF_M + 512 * 1024;
constexpr size_t OFF_MOD = OFF_M, OFF_QAN = OFF_M + 1 * MiB, OFF_KB = OFF_M + 7 * MiB, OFF_VT = OFF_M + 12 * MiB;
constexpr size_t W_WIN = OFF_W, W_GLU = OFF_W + 8 * MiB, W_POOLW = OFF_W + 8 * MiB, W_WQ = OFF_W + 6 * MiB,
                 W_WUV = OFF_W + 8 * MiB, W_WOUT = OFF_W + 16 * MiB;
constexpr size_t A_QA = OFF_A + 72 * MiB, A_CKVF = OFF_A + 84 * MiB, A_KPEF = OFF_A + 90 * MiB;
constexpr size_t B_WST = OFF_B, B_WBIG = OFF_B + 16 * MiB;

constexpr int OUT_RE = 12582912, OUT_IM = 13631488, OUT_CKV = 14680064, OUT_KPE = 15728640;

#define NT_TOK 12288
#define LDS_BYTES 147456

typedef float f32x2_t __attribute__((ext_vector_type(2)));
typedef __bf16 bf16x2_t __attribute__((ext_vector_type(2)));
typedef unsigned u32x2_t __attribute__((ext_vector_type(2)));
typedef unsigned u32x4_t __attribute__((ext_vector_type(4)));
__device__ __forceinline__ unsigned pack2bf(float a, float b) {
  f32x2_t v = {a, b};
  bf16x2_t r = __builtin_convertvector(v, bf16x2_t);
  return __builtin_bit_cast(unsigned, r);
}
__device__ __forceinline__ u16 f2bf(float f) { return (u16)(pack2bf(f, 0.f) & 0xffffu); }
__device__ __forceinline__ float bf2f(u16 h) { return __uint_as_float(((unsigned)h) << 16); }
__device__ __forceinline__ float frcp(float x) { return __builtin_amdgcn_rcpf(x); }
__device__ __forceinline__ float fsigmoid(float x) { return frcp(1.f + __builtin_amdgcn_exp2f(-1.4426950408889634f * x)); }
__device__ __forceinline__ float fsilu(float x) { return x * fsigmoid(x); }
__device__ __forceinline__ float fgelu(float x) {
  float y = 0.7978845608028654f * (x + 0.044715f * x * x * x);
  return x * fsigmoid(2.f * y);
}
__device__ __forceinline__ float2 cis_rev(double rev) {
  double f = rev - rint(rev);
  float ff = (float)f;
  return make_float2(__builtin_amdgcn_cosf(ff), __builtin_amdgcn_sinf(ff));
}
__device__ __forceinline__ float wave_sum(float v) {
#pragma unroll
  for (int o = 32; o > 0; o >>= 1) v += __shfl_xor(v, o);
  return v;
}
__device__ __forceinline__ int cond_of_row(int row) { return row < 8192 ? 0 : 1 + ((row - 8192) >> 11); }
__device__ __forceinline__ u16x4 pack4(f32x4 v) {
  u32x2_t w = {pack2bf(v[0], v[1]), pack2bf(v[2], v[3])};
  return __builtin_bit_cast(u16x4, w);
}
__device__ __forceinline__ u16x8 pack8(const float* a) {
  u32x4_t w = {pack2bf(a[0], a[1]), pack2bf(a[2], a[3]), pack2bf(a[4], a[5]), pack2bf(a[6], a[7])};
  return __builtin_bit_cast(u16x8, w);
}

__device__ __forceinline__ size_t blkA(int row, int k, int KT) { return ((size_t)((row >> 8) * KT + (k >> 6)) * 256 + (row & 255)) * 64 + (k & 63); }
__device__ __forceinline__ size_t blkB(int n, int k, int KT) { return ((size_t)((n >> 7) * KT + (k >> 6)) * 128 + (n & 127)) * 64 + (k & 63); }
__device__ __forceinline__ size_t ugaddr(int tok, int ch) { return ((size_t)((ch >> 4) * 768 + (tok >> 4))) * 256 + (tok & 15) * 16 + (ch & 15); }
__device__ __forceinline__ size_t xaddr(int row, int g, int col) { return ((((size_t)g * 6 + (row >> 7)) * 4 + (col >> 6)) * 128 + (row & 127)) * 64 + (col & 63); }

#define WAIT_VM(n) asm volatile("s_waitcnt vmcnt(" #n ")" ::: "memory")
#define BARRIER()                        \
  do {                                   \
    asm volatile("" ::: "memory");       \
    __builtin_amdgcn_s_barrier();        \
    asm volatile("" ::: "memory");       \
  } while (0)

__device__ __forceinline__ void glds16(const void* g, char* l) {
  __builtin_amdgcn_global_load_lds((const unsigned*)g, (unsigned*)l, 16, 0, 0);
}

template <int WM, int WN, bool LINA, bool LINB, int MI = 4, class AF, class BF>
__device__ __forceinline__ void gemm_loop(char* lds, int nk, AF af, BF bf, f32x4 (&acc)[MI][4], int ksa = 64, int ksb = 64) {
  constexpr int BM = WM * MI * 16, BN = WN * 64;
  constexpr int NA = BM / 64, NB = BN / 64, NG = NA + NB;
  constexpr int STG = (BM + BN) * 128;
  static_assert(3 * STG <= LDS_BYTES, "lds");
  static_assert(NG <= 2 * MI, "glds slots");
  const int tid = threadIdx.x, lane = tid & 63, wid = tid >> 6;
  const int wr = wid / WN, wc = wid % WN, fr = lane & 15, fq = lane >> 4;
  const int srow = tid >> 3;
  const int skc = ((tid & 7) ^ (srow & 7)) * 8;
#pragma unroll
  for (int mi = 0; mi < MI; ++mi)
#pragma unroll
    for (int ni = 0; ni < 4; ++ni) acc[mi][ni] = f32x4{0.f, 0.f, 0.f, 0.f};

  const u16* pa[NA];
  const u16* pb[NB];
  if constexpr (LINA) {
#pragma unroll
    for (int i = 0; i < NA; ++i) pa[i] = af(srow + i * 64, skc);
  }
  if constexpr (LINB) {
#pragma unroll
    for (int i = 0; i < NB; ++i) pb[i] = bf(srow + i * 64, skc);
  }
  auto glds_one = [&](int i, int kt, char* base) {
    if (i < NA)
      glds16(LINA ? pa[i] + kt * ksa : af(srow + i * 64, kt * 64 + skc), base + i * 8192);
    else
      glds16(LINB ? pb[i - NA] + kt * ksb : bf(srow + (i - NA) * 64, kt * 64 + skc),
             base + BM * 128 + (i - NA) * 8192);
  };
  auto stage = [&](int kt, int buf) {
    char* base = lds + buf * STG + tid * 16;
#pragma unroll
    for (int i = 0; i < NG; ++i) glds_one(i, kt, base);
  };
  constexpr int H1 = NG / 2;
  stage(0, 0);
  if (nk > 1) stage(1, 1);
  if (nk > 1) { asm volatile("s_waitcnt vmcnt(%0)" ::"n"(NG) : "memory"); } else { WAIT_VM(0); }
  BARRIER();
  int cur = 0;
  const int rowoffA = (wr * (MI * 16) + fr) * 128, rowoffB = BM * 128 + (wc * 64 + fr) * 128;
  const int off0 = ((0 + fq) ^ (fr & 7)) << 4, off1 = ((4 + fq) ^ (fr & 7)) << 4;
  bf16x8 a0[MI], b0[4], a1[MI], b1[4];
#pragma unroll
  for (int mi = 0; mi < MI; ++mi) a0[mi] = *(const bf16x8*)(lds + rowoffA + mi * 2048 + off0);
#pragma unroll
  for (int ni = 0; ni < 4; ++ni) b0[ni] = *(const bf16x8*)(lds + rowoffB + ni * 2048 + off0);
  for (int kt = 0; kt < nk; ++kt) {
    const bool pf = kt + 2 < nk;
    const int nxt = cur == 2 ? 0 : cur + 1;
    char* nbase = lds + (cur >= 1 ? cur - 1 : 2) * STG + tid * 16;
    const char* sa = lds + cur * STG + rowoffA;
    const char* sb = lds + cur * STG + rowoffB;
#pragma unroll
    for (int m2 = 0; m2 < MI; ++m2) a1[m2] = *(const bf16x8*)(sa + m2 * 2048 + off1);
#pragma unroll
    for (int n2 = 0; n2 < 4; ++n2) b1[n2] = *(const bf16x8*)(sb + n2 * 2048 + off1);
    __builtin_amdgcn_sched_barrier(0);
#pragma unroll
    for (int g = 0; g < MI; ++g) {
#pragma unroll
      for (int ni = 0; ni < 4; ++ni)
        acc[g][ni] = __builtin_amdgcn_mfma_f32_16x16x32_bf16(b0[ni], a0[g], acc[g][ni], 0, 0, 0);
      __builtin_amdgcn_sched_barrier(0);
      if (g < H1) { if (pf) glds_one(g, kt + 2, nbase); }
      __builtin_amdgcn_sched_barrier(0);
    }
    asm volatile("s_waitcnt lgkmcnt(0)" ::: "memory");
    if (pf) { asm volatile("s_waitcnt vmcnt(%0)" ::"n"(H1) : "memory"); } else { WAIT_VM(0); }
    BARRIER();
    if (kt + 1 < nk) {
      const char* na = lds + nxt * STG + rowoffA;
      const char* nbp = lds + nxt * STG + rowoffB;
#pragma unroll
      for (int m2 = 0; m2 < MI; ++m2) a0[m2] = *(const bf16x8*)(na + m2 * 2048 + off0);
#pragma unroll
      for (int n2 = 0; n2 < 4; ++n2) b0[n2] = *(const bf16x8*)(nbp + n2 * 2048 + off0);
    }
    __builtin_amdgcn_sched_barrier(0);
#pragma unroll
    for (int g = 0; g < MI; ++g) {
#pragma unroll
      for (int ni = 0; ni < 4; ++ni)
        acc[g][ni] = __builtin_amdgcn_mfma_f32_16x16x32_bf16(b1[ni], a1[g], acc[g][ni], 0, 0, 0);
      __builtin_amdgcn_sched_barrier(0);
      if (H1 + g < NG) { if (pf) glds_one(H1 + g, kt + 2, nbase); }
      __builtin_amdgcn_sched_barrier(0);
    }
    cur = nxt;
  }
}

struct NoSeg { __device__ const u16* operator()(int, int) const { return nullptr; } };
template <int MI, bool SEG2 = false, class AF, class BF, class AF2 = NoSeg>
__device__ __forceinline__ void gemm_loop2(char* lds, int nk, AF af, BF bf, f32x4 (&acc)[MI][4], int ksa, int ksb,
                                           AF2 af2 = NoSeg(), int ksa2 = 0, int ksplit = 1 << 30) {
  constexpr int BM = 2 * MI * 16, BN = 256;
  constexpr int NA = BM / 64, NB = BN / 64, NG = NA + NB;
  constexpr int STG = (BM + BN) * 128;
  static_assert(2 * STG + 2048 <= LDS_BYTES, "lds");
  static_assert(NG < 2 * MI, "glds slots");
  const int tid = threadIdx.x, lane = tid & 63, wid = tid >> 6;
  const int wr = wid >> 2, wc = wid & 3, fr = lane & 15, fq = lane >> 4;
  const int srow = tid >> 3;
  const int skc = ((tid & 7) ^ (srow & 7)) * 8;
#pragma unroll
  for (int mi = 0; mi < MI; ++mi)
#pragma unroll
    for (int ni = 0; ni < 4; ++ni) acc[mi][ni] = f32x4{0.f, 0.f, 0.f, 0.f};
  const u16* pa[NA];
  const u16* pa2[NA];
  const u16* pb[NB];
#pragma unroll
  for (int i = 0; i < NA; ++i) pa[i] = af(srow + i * 64, skc);
  if constexpr (SEG2) {
#pragma unroll
    for (int i = 0; i < NA; ++i) pa2[i] = af2(srow + i * 64, skc);
  }
#pragma unroll
  for (int i = 0; i < NB; ++i) pb[i] = bf(srow + i * 64, skc);
  auto glds_one = [&](int i, int kt, char* base) {
    if (i < NA) {
      if (SEG2 && kt >= ksplit) glds16(pa2[i] + (kt - ksplit) * ksa2, base + i * 8192);
      else glds16(pa[i] + kt * ksa, base + i * 8192);
    } else glds16(pb[i - NA] + kt * ksb, base + BM * 128 + (i - NA) * 8192);
  };
  const int pidx = tid < BM + BN ? tid : BM + BN - 1;
  const u16* ppf = pidx < BM ? af(pidx, 0) : bf(pidx - BM, 0);
  const int pstride = pidx < BM ? ksa : ksb;
  char* pdummy = lds + 2 * STG + tid * 4;
  auto prefetch = [&](int kt) {
    int k2 = kt < nk ? kt : nk - 1;
    if (SEG2) k2 = k2 < ksplit ? k2 : ksplit - 1;
    __builtin_amdgcn_global_load_lds((const unsigned*)(ppf + (size_t)k2 * pstride), (unsigned*)pdummy, 4, 0, 0);
  };
  {
    char* base = lds + tid * 16;
#pragma unroll
    for (int i = 0; i < NG; ++i) glds_one(i, 0, base);
    prefetch(2);
  }
  const int rowoffA = (wr * (MI * 16) + fr) * 128, rowoffB = BM * 128 + (wc * 64 + fr) * 128;
  for (int kt = 0; kt < nk; ++kt) {
    const int cur = kt & 1;
    WAIT_VM(1);
    BARRIER();
    const bool pf = kt + 1 < nk;
    char* nbase = lds + (cur ^ 1) * STG + tid * 16;
    const char* sa = lds + cur * STG + rowoffA;
    const char* sb = lds + cur * STG + rowoffB;
#pragma unroll
    for (int ks = 0; ks < 2; ++ks) {
      const int off = ((ks * 4 + fq) ^ (fr & 7)) << 4;
      bf16x8 a[MI], b[4];
#pragma unroll
      for (int mi = 0; mi < MI; ++mi) a[mi] = *(const bf16x8*)(sa + mi * 2048 + off);
#pragma unroll
      for (int ni = 0; ni < 4; ++ni) b[ni] = *(const bf16x8*)(sb + ni * 2048 + off);
      __builtin_amdgcn_sched_barrier(0);
#pragma unroll
      for (int g = 0; g < MI; ++g) {
#pragma unroll
        for (int ni = 0; ni < 4; ++ni)
          acc[g][ni] = __builtin_amdgcn_mfma_f32_16x16x32_bf16(b[ni], a[g], acc[g][ni], 0, 0, 0);
        __builtin_amdgcn_sched_barrier(0);
        if (ks * MI + g < NG) { if (pf) glds_one(ks * MI + g, kt + 1, nbase); }
        if (ks * MI + g == NG) prefetch(kt + 3);
        __builtin_amdgcn_sched_barrier(0);
      }
    }
  }
  BARRIER();
}

#define EPI2_LOOP(MI_)                                                           \
  const int _lane = threadIdx.x & 63, _wid = threadIdx.x >> 6;                   \
  const int _wr = _wid >> 2, _wc = _wid & 3, _fr = _lane & 15, _fq = _lane >> 4; \
  _Pragma("unroll") for (int mi = 0; mi < (MI_); ++mi) _Pragma("unroll") for (int ni = 0; ni < 4; ++ni)
#define EPI2_ROW(m0, MI_) ((m0) + _wr * ((MI_) * 16) + mi * 16 + _fr)
#define EPI2_COL(n0) ((n0) + _wc * 64 + ni * 16 + _fq * 4)

#define EPI_LOOP(WM_, WN_)                                                       \
  const int _lane = threadIdx.x & 63, _wid = threadIdx.x >> 6;                   \
  const int _wr = _wid / (WN_), _wc = _wid % (WN_), _fr = _lane & 15, _fq = _lane >> 4; \
  _Pragma("unroll") for (int mi = 0; mi < 4; ++mi) _Pragma("unroll") for (int ni = 0; ni < 4; ++ni)
#define EPI_ROW(m0) ((m0) + _wr * 64 + mi * 16 + _fr)
#define EPI_COL(n0) ((n0) + _wc * 64 + ni * 16 + _fq * 4)

__device__ __forceinline__ void ada_item(const Params& p, int item, char* lds) {
  const int tid = threadIdx.x;
  const int layer = item / 48, n0 = (item % 48) * 64;
  float* sc = (float*)lds;
  float* red = sc + 3072;
  for (int i = tid; i < 3072; i += 512) {
    int cond = i >> 10, k = i & 1023;
    float v = cond == 0 ? p.c_ctx[k] : p.c[(cond - 1) * 1024 + k];
    sc[i] = fsilu(v);
  }
  __syncthreads();
  const int cq = tid & 15, kg = tid >> 4;
  float a[3][4];
#pragma unroll
  for (int c = 0; c < 3; ++c)
#pragma unroll
    for (int e = 0; e < 4; ++e) a[c][e] = 0.f;
  const float* w = p.ada_w + (size_t)layer * 1024 * 3072 + (size_t)(kg * 32) * 3072 + n0 + cq * 4;
#pragma unroll 8
  for (int k = 0; k < 32; ++k) {
    float4 wv = *(const float4*)(w + (size_t)k * 3072);
#pragma unroll
    for (int c = 0; c < 3; ++c) {
      float s = sc[c * 1024 + kg * 32 + k];
      a[c][0] += s * wv.x; a[c][1] += s * wv.y; a[c][2] += s * wv.z; a[c][3] += s * wv.w;
    }
  }
#pragma unroll
  for (int c = 0; c < 3; ++c)
#pragma unroll
    for (int e = 0; e < 4; ++e) red[(kg * 3 + c) * 64 + cq * 4 + e] = a[c][e];
  __syncthreads();
  if (tid < 192) {
    int cond = tid >> 6, nn = tid & 63;
    float sum = 0.f;
#pragma unroll 8
    for (int g = 0; g < 32; ++g) sum += red[(g * 3 + cond) * 64 + nn];
    sum += p.ada_b[layer * 3072 + n0 + nn];
    ((float*)(p.ws + OFF_MOD))[(layer * 3 + cond) * 3072 + n0 + nn] = sum;
  }
  __syncthreads();
}

template <int KR>
__device__ __forceinline__ void conv_tile(const float* src, int ld, int k0, int n0, u16* dst, int ldd, int drow0, char* lds, int blkKT = 0) {
  float* t = (float*)lds;
  const int tid = threadIdx.x;
  float4 v[KR / 32];
#pragma unroll
  for (int i = 0; i < KR / 32; ++i) {
    int kk = (tid >> 4) + i * 32, n4 = (tid & 15) * 4;
    v[i] = *(const float4*)(src + (size_t)(k0 + kk) * ld + n0 + n4);
  }
#pragma unroll
  for (int i = 0; i < KR / 32; ++i) {
    int kk = (tid >> 4) + i * 32, n4 = (tid & 15) * 4;
    t[kk * 65 + n4 + 0] = v[i].x; t[kk * 65 + n4 + 1] = v[i].y; t[kk * 65 + n4 + 2] = v[i].z; t[kk * 65 + n4 + 3] = v[i].w;
  }
  __syncthreads();
#pragma unroll
  for (int r = 0; r < KR / 64; ++r) {
    int i = tid >> 3, kc = (tid & 7) * 8 + r * 64;
    float tv[8];
#pragma unroll
    for (int q = 0; q < 8; ++q) tv[q] = t[(kc + q) * 65 + i];
    u16x8 o = pack8(tv);
    if (blkKT) {
      const int n = drow0 + i;
      *(u16x8*)(dst + ((size_t)((n >> 7) * blkKT + ((k0 + kc) >> 6)) * 128 + (n & 127)) * 64 + (kc & 63)) = o;
    } else {
      *(u16x8*)(dst + (size_t)(drow0 + i) * ldd + k0 + kc) = o;
    }
  }
  __syncthreads();
}

__device__ __forceinline__ void conv_item(const Params& p, int layer, int it, char* lds) {
  const int kind = layer % 3, j = layer / 3;
  if (kind == 0) {
    if (it < 256) {
      int kt = it >> 6, nt = it & 63;
      conv_tile<256>(p.s5_w_in + (size_t)j * 1024 * 4096, 4096, kt * 256, nt * 64, (u16*)(p.ws + W_WIN), 1024, nt * 64, lds, 16);
    } else if (it < 512) {
      int t = it - 256, kt = t >> 5, nt = t & 31;
      conv_tile<256>(p.s5_glu_w + (size_t)j * 2048 * 2048, 2048, kt * 256, nt * 64, (u16*)(p.ws + W_GLU), 2048, nt * 64, lds, 32);
    } else {
      int t = it - 512, kt = t >> 4, nt = t & 15;
      conv_tile<256>(p.s5_w_out + (size_t)j * 2048 * 1024, 1024, kt * 256, nt * 64, (u16*)(p.ws + W_WOUT), 2048, nt * 64, lds, 32);
    }
  } else if (kind == 1) {
    if (it < 256) {
      int kt = it >> 6, nt = it & 63;
      conv_tile<256>(p.pool_w_in + (size_t)j * 1024 * 4096, 4096, kt * 256, nt * 64, (u16*)(p.ws + W_WIN), 1024, nt * 64, lds, 16);
    } else if (it < 320) {
      int t = it - 256, g = t >> 4, r = t & 15, kt = r >> 3, nt = r & 7;
      conv_tile<256>(p.pool_w + ((size_t)j * 4 + g) * 512 * 512, 512, kt * 256, nt * 64, (u16*)(p.ws + W_POOLW), 512,
                g * 512 + nt * 64, lds, 8);
    } else {
      int t = it - 320, kt = t >> 4, nt = t & 15;
      conv_tile<256>(p.pool_w_out + (size_t)j * 2048 * 1024, 1024, kt * 256, nt * 64, (u16*)(p.ws + W_WOUT), 2048, nt * 64, lds, 32);
    }
  } else {
    if (it < 156) {
      int kt = it / 39, nt = it % 39;
      conv_tile<256>(p.mla_w_in + (size_t)j * 1024 * 2496, 2496, kt * 256, nt * 64, (u16*)(p.ws + W_WIN), 1024, nt * 64, lds, 16);
    } else if (it < 172) {
      int h = it - 156, nt = h * 3 + 2;
      conv_tile<256>(p.mla_wq_b + (size_t)j * 256 * 3072, 3072, 0, nt * 64, (u16*)(p.ws + W_WQ), 256, nt * 64, lds, 4);
    } else if (it < 204) {
      int q = it - 172, h = q >> 1, half = q & 1, nt = h * 4 + 2 + half;
      conv_tile<128>(p.mla_wkv_b + (size_t)j * 128 * 4096, 4096, 0, nt * 64, (u16*)(p.ws + W_WUV), 128,
                h * 128 + half * 64, lds, 2);
    } else {
      int t = it - 204, kt = t >> 4, nt = t & 15;
      conv_tile<256>(p.mla_w_out + (size_t)j * 2048 * 1024, 1024, kt * 256, nt * 64, (u16*)(p.ws + W_WOUT), 2048, nt * 64, lds, 32);
    }
  }
}
__device__ __forceinline__ int conv_count(int layer) {
  const int kind = layer % 3;
  return kind == 0 ? 640 : (kind == 1 ? 448 : 332);
}

__device__ __forceinline__ const float* x_row(const Params& p, int layer, int row) {
  if (layer == 0) return row < 8192 ? p.x_prompt + (size_t)row * 1024 : p.x_sample + (size_t)(row - 8192) * 1024;
  return p.out + (size_t)row * 1024;
}

__device__ __forceinline__ void norm_item(const Params& p, int layer, int item, char* lds) {
  const int tid = threadIdx.x, lane = tid & 63, wid = tid >> 6;
  float* ma = (float*)lds;
  float* mb = ma + 1024;
  const int row0 = item * 32;
  const int cond = cond_of_row(row0);
  const float* mod = (const float*)(p.ws + OFF_MOD) + (size_t)(layer * 3 + cond) * 3072;
  for (int i = tid; i < 1024; i += 512) {
    ma[i] = p.norm_g[layer * 1024 + i] * (1.f + mod[1024 + i]);
    mb[i] = mod[i];
  }
  __syncthreads();
  u16* h = (u16*)(p.ws + OFF_H);
  float4 v[4][4];
#pragma unroll
  for (int i = 0; i < 4; ++i) {
    const float* x = x_row(p, layer, row0 + wid * 4 + i);
#pragma unroll
    for (int q = 0; q < 4; ++q) v[i][q] = *(const float4*)(x + q * 256 + lane * 4);
  }
#pragma unroll
  for (int i = 0; i < 4; ++i) {
    const int row = row0 + wid * 4 + i;
    float ss = 0.f;
#pragma unroll
    for (int q = 0; q < 4; ++q)
      ss += v[i][q].x * v[i][q].x + v[i][q].y * v[i][q].y + v[i][q].z * v[i][q].z + v[i][q].w * v[i][q].w;
    ss = wave_sum(ss);
    const float rstd = rsqrtf(ss * (1.f / 1024.f) + 1e-6f);
#pragma unroll
    for (int q = 0; q < 4; ++q) {
      const int c = q * 256 + lane * 4;
      float4 a = *(const float4*)(ma + c), bq = *(const float4*)(mb + c);
      f32x4 ov = {v[i][q].x * rstd * a.x + bq.x, v[i][q].y * rstd * a.y + bq.y, v[i][q].z * rstd * a.z + bq.z, v[i][q].w * rstd * a.w + bq.w};
      *(u16x4*)(h + ((size_t)((row >> 8) * 16 + (c >> 6)) * 256 + (row & 255)) * 64 + (c & 63)) = pack4(ov);
    }
  }
  __syncthreads();
}

__device__ __forceinline__ void derive_item(const Params& p, int j, int item, char* lds) {
  const int tid = threadIdx.x;
  const int g = item >> 2, qu = item & 3;
  float2* pw = (float2*)lds;
  float2* bb = pw + 2 * 17 * 64;
  float2* cc = bb + 2 * 64 * 16;
  float* kt = (float*)(cc + 2 * 16 * 64);
  for (int i = tid; i < 2 * 17 * 64; i += 512) {
    int pp = i & 63, k = (i >> 6) % 17, dir = i / (17 * 64);
    int li = ((j * 2 + dir) * 128 + g) * 64 + pp;
    float lr = p.s5_lam_re[li], lim = p.s5_lam_im[li];
    float st = __expf(p.s5_log_step[(j * 2 + dir) * 128 + g]);
    float mag = __expf((float)k * lr * st);
    float2 cs = cis_rev((double)k * (double)lim * (double)st * 0.15915494309189535);
    pw[i] = make_float2(mag * cs.x, mag * cs.y);
  }
  for (int i = tid; i < 2 * 16 * 64; i += 512) {
    int pp = i & 63, c = (i >> 6) & 15, dir = i >> 10;
    size_t ci = ((size_t)((j * 2 + dir) * 128 + g) * 16 + c) * 64 + pp;
    cc[i] = make_float2(p.s5_c_re[ci], p.s5_c_im[ci]);
  }
  __syncthreads();
  for (int i = tid; i < 2 * 64 * 16; i += 512) {
    int c = i & 15, pp = (i >> 4) & 63, dir = i >> 10;
    int li = ((j * 2 + dir) * 128 + g) * 64 + pp;
    float lr = p.s5_lam_re[li], lim = p.s5_lam_im[li];
    float2 lb = pw[(dir * 17 + 1) * 64 + pp];
    float nr = lb.x - 1.f, ni = lb.y;
    float den = 1.f / (lr * lr + lim * lim);
    float cr = (nr * lr + ni * lim) * den, ci = (ni * lr - nr * lim) * den;
    size_t bi = ((size_t)li) * 16 + c;
    float br = p.s5_b_re[bi], bim = p.s5_b_im[bi];
    bb[i] = make_float2(cr * br - ci * bim, cr * bim + ci * br);
  }
  __syncthreads();
  for (int o = tid; o < 2048; o += 512) {
    int c2 = o & 15, cq = (o >> 4) & 3, lag = (o >> 6) & 15, dir = o >> 10;
    int c = qu * 4 + cq;
    float acc = 0.f;
    for (int pp = 0; pp < 64; ++pp) {
      float2 C = cc[(dir * 16 + c) * 64 + pp], P = pw[(dir * 17 + lag) * 64 + pp], B = bb[(dir * 64 + pp) * 16 + c2];
      float cpx = C.x * P.x - C.y * P.y, cpy = C.x * P.y + C.y * P.x;
      acc += cpx * B.x - cpy * B.y;
    }
    kt[o] = acc;
  }
  __syncthreads();
  u16* wbig = (u16*)(p.ws + B_WBIG) + (size_t)g * 256 * 512;
  for (int q = tid; q < 64 * 64; q += 512) {
    int rowi = q >> 6, k0 = (q & 63) * 8;
    int t = rowi >> 2, cq = rowi & 3, c = qu * 4 + cq, o = t * 16 + c;
    float tv[8];
    if (k0 < 256) {
      int s = k0 >> 4, c20 = k0 & 15;
      float dsk = p.s5_d[j * 2048 + g * 16 + c];
#pragma unroll
      for (int e = 0; e < 8; ++e) {
        int c2 = c20 + e;
        float val = 0.f;
        if (s <= t) val += kt[((0 * 16 + (t - s)) * 4 + cq) * 16 + c2];
        if (s >= t) val += kt[((1 * 16 + (s - t)) * 4 + cq) * 16 + c2];
        if (s == t && c2 == c) val += dsk;
        tv[e] = val;
      }
    } else {
      int dir = k0 >= 384 ? 1 : 0;
      int kk = k0 - 256 - dir * 128;
      int ri = kk >> 6, p0 = kk & 63;
      int e_pow = dir == 0 ? t + 1 : 16 - t;
#pragma unroll
      for (int e = 0; e < 8; ++e) {
        int pp = p0 + e;
        float2 C = cc[(dir * 16 + c) * 64 + pp], P = pw[(dir * 17 + e_pow) * 64 + pp];
        tv[e] = ri == 0 ? (C.x * P.x - C.y * P.y) : -(C.x * P.y + C.y * P.x);
      }
    }
    *(u16x8*)(wbig + blkB(o, k0, 8)) = pack8(tv);
  }
  u16* wst = (u16*)(p.ws + B_WST) + (size_t)g * 256 * 256;
  for (int q = tid; q < 64 * 32; q += 512) {
    int rowi = q >> 5, k0 = (q & 31) * 8;
    int dir = rowi >> 5, ri = (rowi >> 4) & 1, pp = qu * 16 + (rowi & 15);
    int o = dir * 128 + ri * 64 + pp;
    int s = k0 >> 4, c20 = k0 & 15;
    int e_pow = dir == 0 ? 15 - s : s;
    float2 P = pw[(dir * 17 + e_pow) * 64 + pp];
    float tv[8];
#pragma unroll
    for (int e = 0; e < 8; ++e) {
      float2 B = bb[(dir * 64 + pp) * 16 + c20 + e];
      tv[e] = ri == 0 ? (P.x * B.x - P.y * B.y) : (P.x * B.y + P.y * B.x);
    }
    *(u16x8*)(wst + blkB(o, k0, 4)) = pack8(tv);
  }
  __syncthreads();
}

__device__ __forceinline__ void wqabs_item(const Params& p, int item, char* lds) {
  const int tid = threadIdx.x;
  const int h = item >> 3, l0 = (item & 7) * 16;
  float* bs = (float*)lds;
  {
    int li = tid >> 5, d4 = (tid & 31) * 4;
    *(float4*)(bs + li * 128 + d4) = *(const float4*)(p.mla_wkv_b + (size_t)(l0 + li) * 4096 + h * 256 + d4);
  }
  __syncthreads();
  const int r = tid & 255, lh = tid >> 8;
  float acc[8];
#pragma unroll
  for (int i = 0; i < 8; ++i) acc[i] = 0.f;
  const float* arow = p.mla_wq_b + (size_t)r * 3072 + h * 192;
  for (int d4 = 0; d4 < 32; ++d4) {
    float4 a = *(const float4*)(arow + d4 * 4);
#pragma unroll
    for (int i = 0; i < 8; ++i) {
      float4 b = *(const float4*)(bs + (lh * 8 + i) * 128 + d4 * 4);
      acc[i] += a.x * b.x + a.y * b.y + a.z * b.z + a.w * b.w;
    }
  }
  u16* wq = (u16*)(p.ws + W_WQ);
#pragma unroll
  for (int i = 0; i < 8; ++i) wq[blkB(h * 192 + l0 + lh * 8 + i, r, 4)] = f2bf(acc[i]);
  __syncthreads();
}

__device__ __forceinline__ void ph_prep(const Params& p, int layer, bool with_ada, bool with_norm, char* lds, int bid, int nb) {
  const int kind = layer % 3, j = layer / 3;
  const int n_special = kind == 0 ? 512 : (kind == 2 ? 128 : 0);
  const int n_ada = with_ada ? 192 : 0;
  const int n_conv = conv_count(layer);
  const int n_norm = with_norm ? 384 : 0;
  const int total = n_special + n_ada + n_conv + n_norm;
  for (int it = bid; it < total; it += nb) {
    int t = it;
    if (t < n_special) {
      if (kind == 0) derive_item(p, j, t, lds); else wqabs_item(p, t, lds);
      continue;
    }
    t -= n_special;
    if (t < n_ada) { ada_item(p, t, lds); continue; }
    t -= n_ada;
    if (t < n_norm) { norm_item(p, layer, t, lds); continue; }
    t -= n_norm;
    conv_item(p, layer, t, lds);
  }
}
__device__ __forceinline__ void ph_norm(const Params& p, int layer, char* lds, int bid, int nb) {
  for (int it = bid; it < 384; it += nb) norm_item(p, layer, it, lds);
}

__device__ __forceinline__ void tile_mn(int t, int MT, int NT, int& mt, int& nt) {
  int per = 8 * NT;
  int grp = t / per, r = t % per;
  int gm = MT - grp * 8; gm = gm > 8 ? 8 : gm;
  mt = grp * 8 + r % gm; nt = r / gm;
}

__device__ __forceinline__ void ph_inproj(const Params& p, char* lds, int bid, int nb) {
  const u16* h = (const u16*)(p.ws + OFF_H);
  const u16* w = (const u16*)(p.ws + W_WIN);
  u16* uz = (u16*)(p.ws + OFF_A);
  for (int l = (bid >> 3); l < 96; l += (nb >> 3)) {
    const int xi = (bid & 7) >> 2, xj = bid & 3;
    const int mt = xi * 24 + (l >> 2), nt = xj * 4 + (l & 3);
    const int m0 = mt * 256, n0 = nt * 256;
    f32x4 acc[8][4];
    gemm_loop2<8>(lds, 16,
        [&](int r, int k) { return h + blkA(m0 + r, k, 16); },
        [&](int r, int k) { return w + blkB(n0 + r, k, 16); }, acc, 256 * 64, 128 * 64);
    EPI2_LOOP(8) {
      const int row = EPI2_ROW(m0, 8), col = EPI2_COL(n0);
      f32x4 v = acc[mi][ni];
      if (col >= 2048) {
        v[0] = fsilu(v[0]); v[1] = fsilu(v[1]); v[2] = fsilu(v[2]); v[3] = fsilu(v[3]);
        *(u16x4*)(uz + (size_t)NT_TOK * 2048 + (size_t)row * 2048 + (col - 2048)) = pack4(v);
      } else {
        *(u16x4*)(uz + ugaddr(row, col)) = pack4(v);
      }
    }
  }
}

__device__ __forceinline__ void ph_s5g1scan(const Params& p, int j, char* lds, int bid, int nb) {
  const int tid = threadIdx.x;
  const u16* uz = (const u16*)(p.ws + OFF_A);
  u16* X = (u16*)(p.ws + OFF_C);
  float* S = (float*)lds;
  for (int t = bid; t < 768; t += nb) {
    const int g = t / 6, mt = t % 6;
    const int m0 = mt * 128;
    const u16* w = (const u16*)(p.ws + B_WST) + (size_t)g * 65536;
    f32x4 acc[4][4];
    gemm_loop2<4>(lds, 4,
        [&](int r, int k) { return uz + ((size_t)(g * 768 + m0 + r)) * 256 + k; },
        [&](int r, int k) { return w + blkB(r, k, 4); }, acc, 64, 128 * 64);
    WAIT_VM(0);
    BARRIER();
    {
      EPI2_LOOP(4) {
        const int row = EPI2_ROW(0, 4), col = EPI2_COL(0);
        *(f32x4*)(S + row * 260 + col) = acc[mi][ni];
      }
    }
    __syncthreads();
    const bool sample = mt >= 4;
    const int ntask = sample ? 128 : 1024;
    for (int task = tid; task < ntask; task += 512) {
      const int seq = sample ? 0 : (task >> 7), dir = (task >> 6) & 1, pp = task & 63;
      const int nc = sample ? 128 : 16, rl0 = seq * 16;
      const int li = ((j * 2 + dir) * 128 + g) * 64 + pp;
      const float lr = p.s5_lam_re[li], lim = p.s5_lam_im[li];
      const float st = __expf(p.s5_log_step[(j * 2 + dir) * 128 + g]);
      const float mag = __expf(16.f * lr * st);
      const float2 cs = cis_rev(16.0 * (double)lim * (double)st * 0.15915494309189535);
      const float ar = mag * cs.x, ai = mag * cs.y;
      float pr = 0.f, pi = 0.f;
      const int b = sample ? (mt - 4) : (mt * 8 + seq);
      if (sample) {
        size_t si = ((size_t)((b * 2 + j) * 2 + dir) * 128 + g) * 64 + pp;
        pr = p.st_re[si]; pi = p.st_im[si];
      }
      const int col = dir * 128 + pp;
      u16* xb = X + xaddr(m0 + rl0, g, col);
      const float* sb = S + rl0 * 260 + col;
      if (dir == 0) {
#pragma unroll 4
        for (int c = 0; c < nc; ++c) {
          const float sr = sb[c * 260], si = sb[c * 260 + 64];
          xb[c * 64] = f2bf(pr); xb[c * 64 + 8192] = f2bf(pi);
          const float nr = ar * pr - ai * pi + sr, ni = ar * pi + ai * pr + si;
          pr = nr; pi = ni;
        }
      } else {
#pragma unroll 4
        for (int c = nc - 1; c >= 0; --c) {
          const float sr = sb[c * 260], si = sb[c * 260 + 64];
          xb[c * 64] = f2bf(pr); xb[c * 64 + 8192] = f2bf(pi);
          const float nr = ar * pr - ai * pi + sr, ni = ar * pi + ai * pr + si;
          pr = nr; pi = ni;
        }
      }
      if (!sample) {
        size_t oi = ((size_t)((b * 2 + j) * 2 + dir) * 128 + g) * 64 + pp;
        p.out[OUT_RE + oi] = pr;
        p.out[OUT_IM + oi] = pi;
      }
    }
    __syncthreads();
  }
}

__device__ __forceinline__ void ph_s5g3(const Params& p, char* lds, int bid, int nb) {
  u16* uz = (u16*)(p.ws + OFF_A);
  const u16* X = (const u16*)(p.ws + OFF_C);
  for (int t = bid; t < 768; t += nb) {
    const int g = t / 6, mt = t % 6;
    const int m0 = mt * 128;
    const u16* w = (const u16*)(p.ws + B_WBIG) + (size_t)g * 131072;
    f32x4 acc[4][4];
    gemm_loop2<4, true>(lds, 8,
        [&](int r, int k) { return (const u16*)(uz + ((size_t)(g * 768 + m0 + r)) * 256 + k); },
        [&](int r, int k) { return w + blkB(r, k, 8); }, acc, 64, 128 * 64,
        [&](int r, int k) { return X + xaddr(m0 + r, g, k); }, 128 * 64, 4);
    EPI2_LOOP(4) {
      const int row = EPI2_ROW(m0, 4), col = EPI2_COL(0);
      f32x4 v = acc[mi][ni];
      v[0] = fgelu(v[0]); v[1] = fgelu(v[1]); v[2] = fgelu(v[2]); v[3] = fgelu(v[3]);
      *(u16x4*)(uz + ((size_t)(g * 768 + row)) * 256 + col) = pack4(v);
    }
  }
}

__device__ __forceinline__ void ph_glu(const Params& p, int j, char* lds, int bid, int nb) {
  const u16* uz = (const u16*)(p.ws + OFF_A);
  const u16* w = (const u16*)(p.ws + W_GLU);
  u16* m = (u16*)(p.ws + OFF_C);
  for (int l = (bid >> 3); l < 64; l += (nb >> 3)) {
    const int xi = (bid & 7) >> 2, xj = bid & 3;
    const int mt = xi * 32 + (l >> 1), nt = xj * 2 + (l & 1);
    const int m0 = mt * 192, n0 = nt * 256;
    f32x4 acc[6][4];
    gemm_loop2<6>(lds, 32,
        [&](int r, int k) { return uz + ugaddr(m0 + r, k); },
        [&](int r, int k) { return w + blkB(n0 + r, k, 32); }, acc, 4 * 768 * 256, 128 * 64);
    EPI2_LOOP(6) {
      const int row = EPI2_ROW(m0, 6), col = EPI2_COL(n0);
      f32x4 v = acc[mi][ni];
      float4 gb = *(const float4*)(p.s5_glu_b + j * 2048 + col);
      u16x4 yv = *(const u16x4*)(uz + ugaddr(row, col));
      u16x4 zv = *(const u16x4*)(uz + (size_t)NT_TOK * 2048 + (size_t)row * 2048 + col);
      f32x4 o;
      o[0] = bf2f(yv[0]) * fsigmoid(v[0] + gb.x) * bf2f(zv[0]);
      o[1] = bf2f(yv[1]) * fsigmoid(v[1] + gb.y) * bf2f(zv[1]);
      o[2] = bf2f(yv[2]) * fsigmoid(v[2] + gb.z) * bf2f(zv[2]);
      o[3] = bf2f(yv[3]) * fsigmoid(v[3] + gb.w) * bf2f(zv[3]);
      *(u16x4*)(m + blkA(row, col, 32)) = pack4(o);
    }
  }
}

__device__ __forceinline__ void ph_out(const Params& p, int layer, const u16* m, char* lds, int bid, int nb) {
  const u16* w = (const u16*)(p.ws + W_WOUT);
  const float* mod = (const float*)(p.ws + OFF_MOD);
  for (int t = bid; t < 256; t += nb) {
    const int mt = (t & 7) * 8 + (t >> 5), nt = (t >> 3) & 3;
    const int m0 = mt * 192, n0 = nt * 256;
    f32x4 acc[6][4];
    gemm_loop2<6>(lds, 32,
        [&](int r, int k) { return m + blkA(m0 + r, k, 32); },
        [&](int r, int k) { return w + blkB(n0 + r, k, 32); }, acc, 256 * 64, 128 * 64);
    const int lane = threadIdx.x & 63, wid = threadIdx.x >> 6;
    const int wr = wid >> 2, wc = wid & 3, fr = lane & 15, fq = lane >> 4;
#pragma unroll
    for (int mi = 0; mi < 6; ++mi) {
      const int row = m0 + wr * 96 + mi * 16 + fr;
      const float* gate = mod + (size_t)(layer * 3 + cond_of_row(row)) * 3072 + 2048;
      const float* xo_p = x_row(p, layer, row);
#pragma unroll
      for (int ni = 0; ni < 4; ++ni) {
        const int col = n0 + wc * 64 + ni * 16 + fq * 4;
        f32x4 v = acc[mi][ni];
        float4 gt = *(const float4*)(gate + col);
        float4 xo = *(const float4*)(xo_p + col);
        float4 o;
        o.x = xo.x + gt.x * v[0]; o.y = xo.y + gt.y * v[1]; o.z = xo.z + gt.z * v[2]; o.w = xo.w + gt.w * v[3];
        *(float4*)(p.out + (size_t)row * 1024 + col) = o;
      }
    }
  }
}

template <int WIN>
__device__ __forceinline__ void pool_unit(const u16* uz, u16* pb, int g, int tok, int half) {
  int t, L, base;
  if (tok < 8192) { L = 256; t = tok & 255; base = tok - t; }
  else { L = 2048; t = (tok - 8192) & 2047; base = tok - t; }
  constexpr int lo = WIN / 2;
  const int ch0 = g * 16 + half * 8;
  float acc[8];
#pragma unroll
  for (int e = 0; e < 8; ++e) acc[e] = 0.f;
  u16x8 self;
#pragma unroll
  for (int i = 0; i < WIN; ++i) {
    const int sp = t - lo + i;
    const bool valid = sp >= 0 && sp < L;
    const int sc = sp < 0 ? 0 : (sp >= L ? L - 1 : sp);
    u16x8 v = *(const u16x8*)(uz + ugaddr(base + sc, ch0));
    if (i == lo) self = v;
    const float wgt = valid ? 1.f : 0.f;
#pragma unroll
    for (int e = 0; e < 8; ++e) acc[e] += wgt * bf2f(v[e]);
  }
  int s0 = t - lo; if (s0 < 0) s0 = 0;
  int s1 = t - lo + WIN; if (s1 > L) s1 = L;
  const float inv = 1.f / (float)(s1 - s0);
  u16x8 o;
#pragma unroll
  for (int e = 0; e < 8; ++e) o[e] = f2bf(acc[e] * inv - bf2f(self[e]));
  *(u16x8*)(pb + blkA(tok, ch0, 32)) = o;
}
__device__ __forceinline__ void ph_pool(const Params& p, int bid, int nb) {
  const u16* uz = (const u16*)(p.ws + OFF_A);
  u16* pb = (u16*)(p.ws + OFF_B);
  const int lane = threadIdx.x & 63, wid = threadIdx.x >> 6;
  for (int u = bid * 8 + wid; u < 128 * 384; u += nb * 8) {
    const int g = u / 384, run = u % 384;
    const int tok = run * 32 + (lane >> 1), half = lane & 1;
    const int gi = g >> 5;
    if (gi == 0) pool_unit<2>(uz, pb, g, tok, half);
    else if (gi == 1) pool_unit<4>(uz, pb, g, tok, half);
    else if (gi == 2) pool_unit<8>(uz, pb, g, tok, half);
    else pool_unit<16>(uz, pb, g, tok, half);
  }
}

__device__ __forceinline__ void ph_poolmm(const Params& p, int j, char* lds, int bid, int nb) {
  const u16* pb = (const u16*)(p.ws + OFF_B);
  const u16* w = (const u16*)(p.ws + W_POOLW);
  const u16* uz = (const u16*)(p.ws + OFF_A);
  u16* m = (u16*)(p.ws + OFF_C);
  for (int l = (bid >> 3); l < 48 * 2; l += (nb >> 3)) {
    const int mt = l / 2, nt = (bid & 7) * 2 + l % 2;
    const int m0 = mt * 256, n0 = nt * 128, gi = n0 >> 9;
    f32x4 acc[4][4];
    gemm_loop<4, 2, true, true>(lds, 8,
        [&](int r, int k) { return pb + ((size_t)(mt * 32 + gi * 8) * 256 + r) * 64 + k; },
        [&](int r, int k) { return w + ((size_t)(nt * 8) * 128 + r) * 64 + k; }, acc, 256 * 64, 128 * 64);
    EPI_LOOP(4, 2) {
      const int row = EPI_ROW(m0), col = EPI_COL(n0);
      f32x4 v = acc[mi][ni];
      float4 sc = *(const float4*)(p.pool_scale + j * 2048 + col);
      u16x4 zv = *(const u16x4*)(uz + (size_t)NT_TOK * 2048 + (size_t)row * 2048 + col);
      f32x4 o;
      o[0] = v[0] * sc.x * bf2f(zv[0]); o[1] = v[1] * sc.y * bf2f(zv[1]);
      o[2] = v[2] * sc.z * bf2f(zv[2]); o[3] = v[3] * sc.w * bf2f(zv[3]);
      *(u16x4*)(m + blkA(row, col, 32)) = pack4(o);
    }
  }
}

__device__ __forceinline__ void ph_inproj_mla(const Params& p, char* lds, int bid, int nb) {
  const u16* h = (const u16*)(p.ws + OFF_H);
  const u16* w = (const u16*)(p.ws + W_WIN);
  float* qa = (float*)(p.ws + A_QA);
  float* ckvf = (float*)(p.ws + A_CKVF);
  float* kpef = (float*)(p.ws + A_KPEF);
  u16* zb = (u16*)(p.ws + OFF_B);
  for (int t = bid; t < 480; t += nb) {
    const int x = t & 7, l = t >> 3;
    const int mt = x * 6 + l / 10, nt = l % 10;
    const int m0 = mt * 256, n0 = nt * 256;
    f32x4 acc[8][4];
    gemm_loop2<8>(lds, 16,
        [&](int r, int k) { return h + blkA(m0 + r, k, 16); },
        [&](int r, int k) { int n = n0 + r; n = n > 2495 ? 2495 : n; return w + blkB(n, k, 16); }, acc, 256 * 64, 128 * 64);
    EPI2_LOOP(8) {
      const int row = EPI2_ROW(m0, 8), col = EPI2_COL(n0);
      f32x4 v = acc[mi][ni];
      if (col < 256) {
        *(f32x4*)(qa + (size_t)row * 256 + col) = v;
      } else if (col < 384) {
        *(f32x4*)(ckvf + (size_t)row * 128 + (col - 256)) = v;
      } else if (col < 448) {
        *(f32x4*)(kpef + (size_t)row * 64 + (col - 384)) = v;
      } else if (col < 2496) {
        v[0] = fsilu(v[0]); v[1] = fsilu(v[1]); v[2] = fsilu(v[2]); v[3] = fsilu(v[3]);
        *(u16x4*)(zb + (size_t)row * 2048 + (col - 448)) = pack4(v);
      }
    }
  }
}

__device__ __forceinline__ int vt_slot(int pos) {
  int k = pos & 31;
  return (pos & ~31) | (((k >> 2) & 3) * 8 + (k >> 4) * 4 + (k & 3));
}

__device__ __forceinline__ void ph_mlanorm(const Params& p, int j, char* lds, int bid, int nb) {
  const int tid = threadIdx.x, lane = tid & 63, wid = tid >> 6;
  const float* qa = (const float*)(p.ws + A_QA);
  const float* ckvf = (const float*)(p.ws + A_CKVF);
  const float* kpef = (const float*)(p.ws + A_KPEF);
  u16* qan = (u16*)(p.ws + OFF_QAN);
  u16* Kb = (u16*)(p.ws + OFF_KB);
  u16* VT = (u16*)(p.ws + OFF_VT);
  u16* tile = (u16*)lds;
  for (int it = bid; it < 208; it += nb) {
    const bool cache = it >= 192;
    int kvrow0, pos0, Lk; size_t vtbase;
    int tok0 = 0, cb = 0, ci0 = 0;
    bool sample = false;
    if (!cache) {
      tok0 = it * 64;
      if (tok0 < 8192) { int b = tok0 >> 8; pos0 = tok0 & 255; kvrow0 = tok0; Lk = 256; vtbase = (size_t)b * 128 * 256; }
      else { sample = true; int b = (tok0 - 8192) >> 11; int t0 = (tok0 - 8192) & 2047; pos0 = 512 + t0;
             kvrow0 = 8192 + b * 2560 + pos0; Lk = 2560; vtbase = (size_t)32 * 128 * 256 + (size_t)b * 128 * 2560; }
    } else {
      int q = it - 192; cb = q >> 3; ci0 = (q & 7) * 64; pos0 = ci0;
      kvrow0 = 8192 + cb * 2560 + pos0; Lk = 2560; vtbase = (size_t)32 * 128 * 256 + (size_t)cb * 128 * 2560;
    }
#pragma unroll 1
    for (int i = 0; i < 8; ++i) {
      const int rl = wid * 8 + i;
      float c0, c1, kp;
      if (!cache) {
        const int tok = tok0 + rl;
        float4 qv = *(const float4*)(qa + (size_t)tok * 256 + lane * 4);
        float ss = wave_sum(qv.x * qv.x + qv.y * qv.y + qv.z * qv.z + qv.w * qv.w);
        float rs = rsqrtf(ss * (1.f / 256.f) + 1e-6f);
        float4 qg = *(const float4*)(p.mla_q_norm + j * 256 + lane * 4);
        u16x4 qo;
        qo[0] = f2bf(qv.x * rs * qg.x); qo[1] = f2bf(qv.y * rs * qg.y);
        qo[2] = f2bf(qv.z * rs * qg.z); qo[3] = f2bf(qv.w * rs * qg.w);
        *(u16x4*)(qan + blkA(tok, lane * 4, 4)) = qo;
        float2 cv = *(const float2*)(ckvf + (size_t)tok * 128 + lane * 2);
        float s2 = wave_sum(cv.x * cv.x + cv.y * cv.y);
        float r2 = rsqrtf(s2 * (1.f / 128.f) + 1e-6f);
        float2 kg = *(const float2*)(p.mla_kv_norm + j * 128 + lane * 2);
        c0 = cv.x * r2 * kg.x; c1 = cv.y * r2 * kg.y;
        float x = kpef[(size_t)tok * 64 + lane];
        if (!sample) {
          *(float2*)(p.out + OUT_CKV + (size_t)tok * 128 + lane * 2) = make_float2(c0, c1);
          p.out[OUT_KPE + (size_t)tok * 64 + lane] = x;
          kp = x;
        } else {
          const int tpos = (tok - 8192) & 2047;
          const int axis = lane >> 5, within = lane & 31, fi = within & 15, isx2 = within >> 4;
          float xp = __shfl_xor(x, 16);
          float posf = (float)(axis == 0 ? (tpos >> 6) : (tpos & 63));
          float inv = __builtin_amdgcn_exp2f(-(float)fi * 0.830482023721841f);
          float rev = posf * inv * 0.15915494309189535f;
          rev -= rintf(rev);
          float cs = __builtin_amdgcn_cosf(rev), sn = __builtin_amdgcn_sinf(rev);
          float x1 = isx2 ? xp : x, x2 = isx2 ? x : xp;
          kp = isx2 ? (x1 * sn + x2 * cs) : (x1 * cs - x2 * sn);
        }
      } else {
        const size_t ci = (size_t)(cb * 1 + j) * 512 + ci0 + rl;
        float2 cv = *(const float2*)(p.cache_ckv + ci * 128 + lane * 2);
        c0 = cv.x; c1 = cv.y;
        kp = p.cache_kpe[ci * 64 + lane];
      }
      const size_t kr = (size_t)(kvrow0 + rl);
      unsigned pk = (unsigned)f2bf(c0) | ((unsigned)f2bf(c1) << 16);
      *(unsigned*)(Kb + kr * 192 + lane * 2) = pk;
      Kb[kr * 192 + 128 + lane] = f2bf(kp);
      *(unsigned*)(tile + rl * 136 + lane * 2) = pk;
    }
    __syncthreads();
    {
      const int d = tid >> 2, part = tid & 3;
      u16x8 o0, o1;
#pragma unroll
      for (int e = 0; e < 16; ++e) {
        int s = part * 16 + e;
        int blk = s >> 5, sl = s & 31;
        int kgq = sl >> 3, sub = (sl >> 2) & 1, jj = sl & 3;
        int kap = sub * 16 + kgq * 4 + jj;
        u16 v = tile[(blk * 32 + kap) * 136 + d];
        if (e < 8) o0[e] = v; else o1[e - 8] = v;
      }
      u16* dst = VT + vtbase + ((size_t)(pos0 >> 6) * 128 + d) * 64 + part * 16;
      *(u16x8*)(dst) = o0;
      *(u16x8*)(dst + 8) = o1;
    }
    __syncthreads();
  }
}

__device__ __forceinline__ void ph_qgemm(const Params& p, char* lds, int bid, int nb) {
  const u16* qan = (const u16*)(p.ws + OFF_QAN);
  const u16* w = (const u16*)(p.ws + W_WQ);
  u16* q = (u16*)(p.ws + OFF_A);
  const float SC = 0.07216878364870322f * 1.4426950408889634f;
  for (int l = (bid >> 3); l < 48 * 3; l += (nb >> 3)) {
    const int mt = l / 3, nt = (bid & 7) * 3 + l % 3;
    const int m0 = mt * 256, n0 = nt * 128;
    f32x4 acc[4][4];
    gemm_loop<4, 2, true, true>(lds, 4,
        [&](int r, int k) { return qan + ((size_t)(mt * 4) * 256 + r) * 64 + k; },
        [&](int r, int k) { return w + ((size_t)(nt * 4) * 128 + r) * 64 + k; }, acc, 256 * 64, 128 * 64);
    const int lane = threadIdx.x & 63, wid = threadIdx.x >> 6;
    const int wr = wid >> 1, wc = wid & 1, fr = lane & 15, fq = lane >> 4;
    const int cb = n0 + wc * 64;
    const bool rope = (m0 >= 8192) && ((cb % 192) == 128);
#pragma unroll
    for (int mi = 0; mi < 4; ++mi) {
      const int row = m0 + wr * 64 + mi * 16 + fr;
      f32x4 v[4];
#pragma unroll
      for (int ni = 0; ni < 4; ++ni) v[ni] = acc[mi][ni];
      if (rope) {
        const int tpos = (row - 8192) & 2047;
#pragma unroll
        for (int ax = 0; ax < 2; ++ax) {
          const float posf = (float)(ax == 0 ? (tpos >> 6) : (tpos & 63));
#pragma unroll
          for (int jj = 0; jj < 4; ++jj) {
            const int fi = fq * 4 + jj;
            float inv = __builtin_amdgcn_exp2f(-(float)fi * 0.830482023721841f);
            float rev = posf * inv * 0.15915494309189535f;
            rev -= rintf(rev);
            float cs = __builtin_amdgcn_cosf(rev), sn = __builtin_amdgcn_sinf(rev);
            float x1 = v[ax * 2][jj], x2 = v[ax * 2 + 1][jj];
            v[ax * 2][jj] = x1 * cs - x2 * sn;
            v[ax * 2 + 1][jj] = x1 * sn + x2 * cs;
          }
        }
      }
#pragma unroll
      for (int ni = 0; ni < 4; ++ni) {
        f32x4 o = v[ni];
        o[0] *= SC; o[1] *= SC; o[2] *= SC; o[3] *= SC;
        *(u16x4*)(q + (size_t)row * 3072 + cb + ni * 16 + fq * 4) = pack4(o);
      }
    }
  }
}

__device__ __forceinline__ void ph_attn(const Params& p, char* lds, int bid, int nb) {
  const int tid = threadIdx.x, lane = tid & 63, wid = tid >> 6, fr = lane & 15, fq = lane >> 4;
  const u16* q = (const u16*)(p.ws + OFF_A);
  const u16* Kb = (const u16*)(p.ws + OFF_KB);
  const u16* VT = (const u16*)(p.ws + OFF_VT);
  u16* ol = (u16*)(p.ws + OFF_C);
  for (int it = bid; it < 768; it += nb) {
    int h, tokq0, kvbase, Lk; size_t vtbase;
    if (it < 256) { int b = it >> 7, qt = (it >> 4) & 7; h = it & 15; tokq0 = 8192 + b * 2048 + qt * 256;
                    kvbase = 8192 + b * 2560; Lk = 2560; vtbase = (size_t)32 * 128 * 256 + (size_t)b * 128 * 2560; }
    else { int r = it - 256; int b = r >> 4; h = r & 15; tokq0 = b * 256; kvbase = b * 256; Lk = 256;
           vtbase = (size_t)b * 128 * 256; }
    const int nkt = Lk >> 6;
    const u16* vt = VT + vtbase;
    bf16x8 qf[2][6];
#pragma unroll
    for (int qs = 0; qs < 2; ++qs)
#pragma unroll
      for (int ks = 0; ks < 6; ++ks)
        qf[qs][ks] = *(const bf16x8*)(q + (size_t)(tokq0 + wid * 32 + qs * 16 + fr) * 3072 + h * 192 + ks * 32 + fq * 8);
    f32x4 O[8][2];
#pragma unroll
    for (int d = 0; d < 8; ++d) { O[d][0] = f32x4{0, 0, 0, 0}; O[d][1] = f32x4{0, 0, 0, 0}; }
    float mrun[2] = {-1e30f, -1e30f}, lrun[2] = {0.f, 0.f};

    int koff[3], voff[2];
#pragma unroll
    for (int i = 0; i < 3; ++i) {
      int idx = tid + i * 512;
      int r = idx / 24, pos = idx - r * 24;
      int kc = (pos & ~7) | ((pos ^ r) & 7);
      koff[i] = r * 192 + kc * 8;
    }
#pragma unroll
    for (int i = 0; i < 2; ++i) {
      int idx = tid + i * 512;
      int d = idx >> 3, pos = idx & 7;
      voff[i] = d * 64 + ((pos ^ (d & 7)) * 8);
    }
    const u16* kbase = Kb + (size_t)kvbase * 192;
    auto glds_kv = [&](int i, int kt, int buf) {
      char* base = lds + buf * 40960 + tid * 16;
      if (i < 3) glds16(kbase + kt * (64 * 192) + koff[i], base + i * 8192);
      else glds16(vt + kt * (128 * 64) + voff[i - 3], base + 24576 + (i - 3) * 8192);
    };
#pragma unroll
    for (int i = 0; i < 5; ++i) glds_kv(i, 0, 0);
    for (int kt = 0; kt < nkt; ++kt) {
      const int cur = kt & 1;
      WAIT_VM(0);
      BARRIER();
      const bool pfn = kt + 1 < nkt;
      const char* kb = lds + cur * 40960;
      const char* vb = kb + 24576;
      f32x4 s[4][2];
#pragma unroll
      for (int sub = 0; sub < 4; ++sub) { s[sub][0] = f32x4{0, 0, 0, 0}; s[sub][1] = f32x4{0, 0, 0, 0}; }
      {
        auto kaddr = [&](int idx) {
          const int ks = idx >> 2, sub = idx & 3;
          const int coff = ((ks >> 1) * 8 + ((((ks & 1) * 4 + fq) ^ fr) & 7)) * 16;
          return (const bf16x8*)(kb + (sub * 16 + fr) * 384 + coff);
        };
        bf16x8 kf[3];
        kf[0] = *kaddr(0); kf[1] = *kaddr(1);
#pragma unroll
        for (int idx = 0; idx < 24; ++idx) {
          const int ks = idx >> 2, sub = idx & 3;
          if (idx + 2 < 24) kf[(idx + 2) % 3] = *kaddr(idx + 2);
          s[sub][0] = __builtin_amdgcn_mfma_f32_16x16x32_bf16(kf[idx % 3], qf[0][ks], s[sub][0], 0, 0, 0);
          s[sub][1] = __builtin_amdgcn_mfma_f32_16x16x32_bf16(kf[idx % 3], qf[1][ks], s[sub][1], 0, 0, 0);
          if (sub == 3 && ks < 5) { if (pfn) glds_kv(ks, kt + 1, cur ^ 1); }
          __builtin_amdgcn_sched_barrier(0);
        }
      }
      bf16x8 pf[2][2];
#pragma unroll
      for (int qs = 0; qs < 2; ++qs) {
        float mx = s[0][qs][0];
#pragma unroll
        for (int sub = 0; sub < 4; ++sub)
#pragma unroll
          for (int jj = 0; jj < 4; ++jj) mx = fmaxf(mx, s[sub][qs][jj]);
        mx = fmaxf(mx, __shfl_xor(mx, 16));
        mx = fmaxf(mx, __shfl_xor(mx, 32));
        const float mnew = fmaxf(mrun[qs], mx);
        const float alpha = __builtin_amdgcn_exp2f(mrun[qs] - mnew);
        mrun[qs] = mnew;
        float ps = 0.f;
#pragma unroll
        for (int sub = 0; sub < 4; ++sub)
#pragma unroll
          for (int jj = 0; jj < 4; ++jj) {
            float e = __builtin_amdgcn_exp2f(s[sub][qs][jj] - mnew);
            s[sub][qs][jj] = e;
            ps += e;
          }
        lrun[qs] = lrun[qs] * alpha + ps;
#pragma unroll
        for (int d = 0; d < 8; ++d) { O[d][qs][0] *= alpha; O[d][qs][1] *= alpha; O[d][qs][2] *= alpha; O[d][qs][3] *= alpha; }
#pragma unroll
        for (int kbk = 0; kbk < 2; ++kbk) {
          u32x4_t w = {pack2bf(s[kbk * 2][qs][0], s[kbk * 2][qs][1]), pack2bf(s[kbk * 2][qs][2], s[kbk * 2][qs][3]),
                       pack2bf(s[kbk * 2 + 1][qs][0], s[kbk * 2 + 1][qs][1]), pack2bf(s[kbk * 2 + 1][qs][2], s[kbk * 2 + 1][qs][3])};
          pf[kbk][qs] = __builtin_bit_cast(bf16x8, w);
        }
      }
      {
        auto vaddr = [&](int idx) {
          const int d = idx >> 1, kbk = idx & 1;
          return (const bf16x8*)(vb + (d * 16 + fr) * 128 + (((kbk * 4 + fq) ^ (fr & 7)) << 4));
        };
        bf16x8 vf[3];
        vf[0] = *vaddr(0); vf[1] = *vaddr(1);
#pragma unroll
        for (int idx = 0; idx < 16; ++idx) {
          const int d = idx >> 1, kbk = idx & 1;
          if (idx + 2 < 16) vf[(idx + 2) % 3] = *vaddr(idx + 2);
          O[d][0] = __builtin_amdgcn_mfma_f32_16x16x32_bf16(vf[idx % 3], pf[kbk][0], O[d][0], 0, 0, 0);
          O[d][1] = __builtin_amdgcn_mfma_f32_16x16x32_bf16(vf[idx % 3], pf[kbk][1], O[d][1], 0, 0, 0);
          __builtin_amdgcn_sched_barrier(0);
        }
      }
    }
    BARRIER();
#pragma unroll
    for (int qs = 0; qs < 2; ++qs) {
      float l = lrun[qs];
      l += __shfl_xor(l, 16);
      l += __shfl_xor(l, 32);
      const float il = 1.f / l;
      const int tok = tokq0 + wid * 32 + qs * 16 + fr;
#pragma unroll
      for (int d = 0; d < 8; ++d) {
        f32x4 o = O[d][qs];
        o[0] *= il; o[1] *= il; o[2] *= il; o[3] *= il;
        *(u16x4*)(ol + blkA(tok, h * 128 + d * 16 + fq * 4, 32)) = pack4(o);
      }
    }
  }
}

__device__ __forceinline__ void ph_oexp(const Params& p, char* lds, int bid, int nb) {
  const u16* ol = (const u16*)(p.ws + OFF_C);
  const u16* w = (const u16*)(p.ws + W_WUV);
  const u16* zb = (const u16*)(p.ws + OFF_B);
  u16* mo = (u16*)(p.ws + OFF_A);
  for (int l = (bid >> 3); l < 48 * 2; l += (nb >> 3)) {
    const int mt = l / 2, nt = (bid & 7) * 2 + l % 2;
    const int m0 = mt * 256, n0 = nt * 128;
    f32x4 acc[4][4];
    gemm_loop<4, 2, true, true>(lds, 2,
        [&](int r, int k) { return ol + ((size_t)(mt * 32 + nt * 2) * 256 + r) * 64 + k; },
        [&](int r, int k) { return w + ((size_t)(nt * 2) * 128 + r) * 64 + k; }, acc, 256 * 64, 128 * 64);
    EPI_LOOP(4, 2) {
      const int row = EPI_ROW(m0), col = EPI_COL(n0);
      f32x4 v = acc[mi][ni];
      u16x4 zv = *(const u16x4*)(zb + (size_t)row * 2048 + col);
      v[0] *= bf2f(zv[0]); v[1] *= bf2f(zv[1]); v[2] *= bf2f(zv[2]); v[3] *= bf2f(zv[3]);
      *(u16x4*)(mo + blkA(row, col, 32)) = pack4(v);
    }
  }
}

__device__ __forceinline__ void ph_final(const Params& p, int bid, int nb) {
  const int lane = threadIdx.x & 63, wid = threadIdx.x >> 6;
  for (int r0 = (bid * 8 + wid) * 3; r0 < NT_TOK; r0 += nb * 8 * 3) {
    float4 v[3][4];
#pragma unroll
    for (int i = 0; i < 3; ++i)
#pragma unroll
      for (int q = 0; q < 4; ++q) v[i][q] = *(const float4*)(p.out + (size_t)(r0 + i) * 1024 + q * 256 + lane * 4);
#pragma unroll
    for (int i = 0; i < 3; ++i) {
      float* x = p.out + (size_t)(r0 + i) * 1024;
      float ss = 0.f;
#pragma unroll
      for (int q = 0; q < 4; ++q)
        ss += v[i][q].x * v[i][q].x + v[i][q].y * v[i][q].y + v[i][q].z * v[i][q].z + v[i][q].w * v[i][q].w;
      ss = wave_sum(ss);
      const float rstd = rsqrtf(ss * (1.f / 1024.f) + 1e-6f);
#pragma unroll
      for (int q = 0; q < 4; ++q) {
        float4 g = *(const float4*)(p.final_g + q * 256 + lane * 4);
        float4 o;
        o.x = v[i][q].x * rstd * g.x; o.y = v[i][q].y * rstd * g.y; o.z = v[i][q].z * rstd * g.z; o.w = v[i][q].w * rstd * g.w;
        *(float4*)(x + q * 256 + lane * 4) = o;
      }
    }
  }
}

#define XB_TMO      128
#define XB_XCNT(j)  (256  + 64 * (j))
#define XB_XSUB(j)  (1280 + 64 * (j))
#define XB_XGEN(j)  (2304 + 64 * (j))
#define XB_TOP      3328
#define XB_TOPGEN   3392
#define XCD_BAR_WORDS 3456
#define XB_SPIN_CAP (1u << 18)
#define LAS __attribute__((address_space(3)))

__device__ __forceinline__ unsigned xb_ld(unsigned* p)              { return __hip_atomic_load(p, __ATOMIC_RELAXED, __HIP_MEMORY_SCOPE_AGENT); }
__device__ __forceinline__ unsigned xb_add(unsigned* p, unsigned v) { return __hip_atomic_fetch_add(p, v, __ATOMIC_RELAXED, __HIP_MEMORY_SCOPE_AGENT); }
__device__ __forceinline__ unsigned xb_xcc_id() { return (unsigned)__builtin_amdgcn_s_getreg((3 << 11) | 20) & 0xFu; }
#define XB_SPIN(cond, bar) do { unsigned _sp = 0; while (cond) { __builtin_amdgcn_s_sleep(1); \
    if ((++_sp & 255u) == 0u) { if (xb_ld(&(bar)[XB_TMO])) break; if (_sp > XB_SPIN_CAP) { atomicAdd(&(bar)[XB_TMO], 1u); break; } } } } while (0)

struct XcdBarrier {
    unsigned* bar; unsigned x;
    volatile LAS unsigned* st;
};

__device__ __forceinline__ XcdBarrier xcd_barrier_post(unsigned* bar, volatile LAS unsigned* st) {
    XcdBarrier b; b.bar = bar; b.x = xb_xcc_id(); b.st = st;
    if (threadIdx.x == 0) (void)xb_add(&bar[XB_XCNT(b.x)], 1u);
    return b;
}
__device__ __forceinline__ void xcd_barrier_complete(unsigned* bar, unsigned x, unsigned& nloc, unsigned& nx) {
    const unsigned G = gridDim.x * gridDim.y * gridDim.z;
    unsigned sum, cnt, mine, sp = 0u;
    for (;;) {
        sum = 0u; cnt = 0u; mine = 0u;
#pragma unroll
        for (unsigned j = 0; j < 16; ++j) { const unsigned c = xb_ld(&bar[XB_XCNT(j)]); sum += c; cnt += (c > 0u) ? 1u : 0u; mine = (j == x) ? c : mine; }
        if (sum == G) break;
        __builtin_amdgcn_s_sleep(1);
        if ((++sp & 255u) == 0u) { if (xb_ld(&bar[XB_TMO])) break; if (sp > XB_SPIN_CAP) { atomicAdd(&bar[XB_TMO], 1u); break; } }
    }
    nloc = mine > 0u ? mine : 1u; nx = cnt > 0u ? cnt : 1u;
}

__device__ __forceinline__ void xcd_barrier(const XcdBarrier& b) {
    asm volatile("s_waitcnt vmcnt(0)" ::: "memory");
    __syncthreads();
    if (threadIdx.x == 0) {
        unsigned* bar = b.bar;
        __builtin_amdgcn_s_waitcnt(0);
        unsigned nloc = b.st[0], nx = b.st[1];
        if (nloc == 0u) { xcd_barrier_complete(bar, b.x, nloc, nx); b.st[0] = nloc; b.st[1] = nx; }
        const unsigned old = xb_add(&bar[XB_XSUB(b.x)], 1u);
        const unsigned gen = old / nloc;
        if (old + 1u == (gen + 1u) * nloc) {
            __builtin_amdgcn_fence(__ATOMIC_RELEASE, "agent");
            asm volatile("s_waitcnt vmcnt(0)" ::: "memory");
            const unsigned og = xb_add(&bar[XB_TOP], 1u);
            const unsigned tg = og / nx;
            if (og + 1u == (tg + 1u) * nx) xb_add(&bar[XB_TOPGEN], 1u);
            else XB_SPIN(xb_ld(&bar[XB_TOPGEN]) == tg, bar);
            __builtin_amdgcn_fence(__ATOMIC_ACQUIRE, "agent");
            xb_add(&bar[XB_XGEN(b.x)], 1u);
            asm volatile("s_waitcnt vmcnt(0)" ::: "memory");
        } else {
            XB_SPIN(xb_ld(&bar[XB_XGEN(b.x)]) == gen, bar);
            __builtin_amdgcn_fence(__ATOMIC_ACQUIRE, "agent");
            asm volatile("s_waitcnt vmcnt(0)" ::: "memory");
        }
    }
    __syncthreads();
}


#define N_PHASES 26
template <int ph>
__device__ __forceinline__ void run_phase(const Params& p, char* lds, int bid, int nb) {
  switch (ph) {
    case 0: ph_prep(p, 0, true, false, lds, bid, nb); break;
    case 1: ph_norm(p, 0, lds, bid, nb); break;
    case 2: ph_inproj(p, lds, bid, nb); break;
    case 3: ph_s5g1scan(p, 0, lds, bid, nb); break;
    case 4: ph_s5g3(p, lds, bid, nb); break;
    case 5: ph_glu(p, 0, lds, bid, nb); break;
    case 6: ph_out(p, 0, (const u16*)(p.ws + OFF_C), lds, bid, nb); break;
    case 7: ph_prep(p, 1, false, true, lds, bid, nb); break;
    case 8: ph_inproj(p, lds, bid, nb); break;
    case 9: ph_pool(p, bid, nb); break;
    case 10: ph_poolmm(p, 0, lds, bid, nb); break;
    case 11: ph_out(p, 1, (const u16*)(p.ws + OFF_C), lds, bid, nb); break;
    case 12: ph_prep(p, 2, false, true, lds, bid, nb); break;
    case 13: ph_inproj_mla(p, lds, bid, nb); break;
    case 14: ph_mlanorm(p, 0, lds, bid, nb); break;
    case 15: ph_qgemm(p, lds, bid, nb); break;
    case 16: ph_attn(p, lds, bid, nb); break;
    case 17: ph_oexp(p, lds, bid, nb); break;
    case 18: ph_out(p, 2, (const u16*)(p.ws + OFF_A), lds, bid, nb); break;
    case 19: ph_prep(p, 3, false, true, lds, bid, nb); break;
    case 20: ph_inproj(p, lds, bid, nb); break;
    case 21: ph_s5g1scan(p, 1, lds, bid, nb); break;
    case 22: ph_s5g3(p, lds, bid, nb); break;
    case 23: ph_glu(p, 1, lds, bid, nb); break;
    case 24: ph_out(p, 3, (const u16*)(p.ws + OFF_C), lds, bid, nb); break;
    case 25: ph_final(p, bid, nb); break;
    default: break;
  }
}

template <int PH>
__device__ __forceinline__ void run_all(const Params& p, char* lds, cg::grid_group& grid, const XcdBarrier& xb, int bid, int nb) {
  if constexpr (PH < N_PHASES) {
    run_phase<PH>(p, lds, bid, nb);
#ifdef DUP_PHASE
    if constexpr (PH == DUP_PHASE) { xcd_barrier(xb); run_phase<PH>(p, lds, bid, nb); }
#endif
    if constexpr (PH + 1 < N_PHASES) {
      if constexpr (PH == 0) grid.sync(); else xcd_barrier(xb);
      run_all<PH + 1>(p, lds, grid, xb, bid, nb);
    }
  }
}

#if MK_SINGLE
__global__ void __launch_bounds__(512) k_mega(Params p) {
  __shared__ __attribute__((aligned(16))) char lds[LDS_BYTES];
  __shared__ uint4 xb_words;
  __shared__ int s_vbid;
  cg::grid_group grid = cg::this_grid();
  unsigned* bar = (unsigned*)(p.ws + OFF_BAR);
  if (threadIdx.x == 0) {
    xb_words = make_uint4(0u, 0u, 0u, 0u);
    const unsigned x = xb_xcc_id() & 7u;
    const unsigned j = atomicAdd(&bar[XCD_BAR_WORDS + 64 * x], 1u);
    s_vbid = (int)(j * 8u + x);
  }
  __syncthreads();
  XcdBarrier xb = xcd_barrier_post(bar, (volatile LAS unsigned*)&xb_words);
  const int nb = gridDim.x;
  run_phase<0>(p, lds, blockIdx.x, nb);
  xcd_barrier(xb);
  int vb = s_vbid;
  {
    bool ok = (nb & 7) == 0;
#pragma unroll
    for (int x = 0; x < 8; ++x) ok = ok && (xb_ld(&bar[XCD_BAR_WORDS + 64 * x]) == (unsigned)(nb >> 3));
    if (!ok) vb = blockIdx.x;
  }
  run_all<1>(p, lds, grid, xb, vb, nb);
}
#else
template <int PH>
__global__ void __launch_bounds__(512) __attribute__((amdgpu_waves_per_eu(2, 2))) k_phase(Params p) {
  __shared__ __attribute__((aligned(16))) char lds[LDS_BYTES];
  run_phase<PH>(p, lds, blockIdx.x, gridDim.x);
}
template <int PH>
static void launch_all(const Params& p, hipStream_t stream) {
  if constexpr (PH < N_PHASES) {
    k_phase<PH><<<256, 512, 0, stream>>>(p);
    launch_all<PH + 1>(p, stream);
  }
}
#endif

extern "C" void kernel_launch(void* const* d_in, const int* in_sizes, int n_in, void* d_out, int out_size,
                              void* d_ws, size_t ws_size, hipStream_t stream) {
  Params p{};
  const float** f = (const float**)&p;
  for (int i = 0; i < 34; ++i) f[i] = (const float*)d_in[i];
  p.out = (float*)d_out;
  p.ws = (char*)d_ws;
#if MK_SINGLE
  static int grid_blocks = 0;
  if (!grid_blocks) {
    int dev = 0, cus = 0, per_cu = 0;
    (void)hipGetDevice(&dev);
    (void)hipDeviceGetAttribute(&cus, hipDeviceAttributeMultiprocessorCount, dev);
    (void)hipOccupancyMaxActiveBlocksPerMultiprocessor(&per_cu, k_mega, 512, 0);
    if (per_cu > 1) per_cu = 1;
    grid_blocks = cus * per_cu;
    if (grid_blocks <= 0) grid_blocks = 256;
  }
  (void)hipMemsetAsync((char*)d_ws + OFF_BAR, 0, (XCD_BAR_WORDS + 8 * 64) * 4, stream);
  void* args[] = {&p};
  hipError_t e = hipLaunchCooperativeKernel((void*)k_mega, dim3(grid_blocks), dim3(512), args, 0, stream);
  if (e != hipSuccess) fprintf(stderr, "cooperative launch failed: %s (grid %d)\n", hipGetErrorString(e), grid_blocks);
#else
  launch_all<0>(p, stream);
#endif
}
```
